# Optimizing an MI355X kernel written in HIP

```python
import math
import jax
import jax.numpy as jnp
from jax import lax
import numpy as np

D_MODEL = 2048
BATCH = 4
SEQ = 4096
DEPTH = 2

HEAD_DIM = 128
ROPE_THETA = 10000.0
NORM_EPS = 1e-6

SWA_Q_HEADS = 8
SWA_KV_HEADS = 2
SWA_GROUP = SWA_Q_HEADS // SWA_KV_HEADS
SWA_WINDOW = 128
SWA_BLOCK = 128

NSA_Q_HEADS = 8
NSA_KV_HEADS = 2
NSA_GROUP = NSA_Q_HEADS // NSA_KV_HEADS
CMP_LEN = 32
CMP_STRIDE = 16
CMP_HIDDEN = 256
SEL_LEN = 64
SEL_TOPK = 16
NSA_WINDOW = 512
NSA_BLOCK = 128
SEL_QUERY_CHUNK = 64

D_FF = 7168
N_EXPERTS = 8
TOP_K = 2
N_DENSE = (DEPTH + 1) // 2
N_MOE = DEPTH // 2

A_WIDTH = SWA_Q_HEADS * HEAD_DIM
A_KV = SWA_KV_HEADS * HEAD_DIM
B_WIDTH = NSA_Q_HEADS * HEAD_DIM
B_KV = NSA_KV_HEADS * HEAD_DIM
N_BRANCHES = 2
IN_SIZES = (A_WIDTH, A_KV, A_KV, B_WIDTH, B_KV, B_KV, B_KV, B_KV, B_KV, B_KV, NSA_Q_HEADS * 3, N_BRANCHES * D_MODEL)
IN_DIM = sum(IN_SIZES)
IN_SPLIT_POINTS = tuple(np.cumsum(IN_SIZES)[:-1].tolist())

ATTN_SCALE = HEAD_DIM ** -0.5
NEG_INF = -1e30
FORCED_SCORE = 1e9

kernel_name = 'hybrid_swa_sink_nsa_moe_block'


def rms_norm(x, g):
    xf = x.astype(jnp.float32)
    y = xf * lax.rsqrt(jnp.mean(xf * xf, axis=-1, keepdims=True) + NORM_EPS)
    return (y * g.astype(jnp.float32)).astype(x.dtype)


def rope_tables(seq):
    inv = 1.0 / (ROPE_THETA ** (jnp.arange(0, HEAD_DIM, 2, dtype=jnp.float32) / HEAD_DIM))
    ang = jnp.arange(seq, dtype=jnp.float32)[:, None] * inv[None, :]
    return jnp.cos(ang), jnp.sin(ang)


def apply_rope(x, cos, sin):
    x1, x2 = jnp.split(x.astype(jnp.float32), 2, axis=-1)
    c = cos[None, :, None, :]
    s = sin[None, :, None, :]
    return jnp.concatenate([x1 * c - x2 * s, x2 * c + x1 * s], axis=-1).astype(x.dtype)


def masked_softmax(s, mask, sink=None):
    s = jnp.where(mask, s.astype(jnp.float32), NEG_INF)
    m = jnp.max(s, axis=-1, keepdims=True)
    if sink is not None:
        m = jnp.maximum(m, sink)
    p = jnp.exp(s - m) * mask
    denom = jnp.sum(p, axis=-1, keepdims=True)
    if sink is not None:
        denom = denom + jnp.exp(sink - m)
    return p / jnp.maximum(denom, 1e-30)


def banded_attention(q, k, v, window, blk, sink=None):
    b, t, g, r, dh = q.shape
    nb = window // blk
    nblk = t // blk
    qb = q.reshape(b, nblk, blk, g, r, dh)
    pad = ((0, 0), (nb * blk, 0), (0, 0), (0, 0))
    kp = jnp.pad(k, pad).reshape(b, nblk + nb, blk, g, dh)
    vp = jnp.pad(v, pad).reshape(b, nblk + nb, blk, g, dh)
    kw = jnp.concatenate([kp[:, j:j + nblk] for j in range(nb + 1)], axis=2)
    vw = jnp.concatenate([vp[:, j:j + nblk] for j in range(nb + 1)], axis=2)
    qpos = jnp.arange(nblk)[:, None] * blk + jnp.arange(blk)[None, :]
    kpos = jnp.arange(nblk)[:, None] * blk - nb * blk + jnp.arange((nb + 1) * blk)[None, :]
    diff = qpos[:, :, None] - kpos[:, None, :]
    mask = (diff >= 0) & (diff < window) & (kpos[:, None, :] >= 0)
    s = jnp.einsum('bnqgrd,bnkgd->bngrqk', qb, kw) * ATTN_SCALE
    p = masked_softmax(s, mask[None, :, None, None], sink)
    o = jnp.einsum('bngrqk,bnkgd->bnqgrd', p.astype(v.dtype), vw)
    return o.reshape(b, t, g, r, dh)


def compress(x, pe, w1, w2):
    b, t, g, dh = x.shape
    nc = (t - CMP_LEN) // CMP_STRIDE + 1
    idx = jnp.arange(nc)[:, None] * CMP_STRIDE + jnp.arange(CMP_LEN)[None, :]
    blocks = x[:, idx] + pe[None, None, :, None, :].astype(x.dtype)
    blocks = jnp.transpose(blocks, (0, 1, 3, 2, 4)).reshape(b, nc, g, CMP_LEN * dh)
    return jax.nn.silu(blocks @ w1) @ w2


def nsa_attention(q, k_c, v_c, k_s, v_s, k_w, v_w, gate_logits, pe_k, pe_v, wk1, wk2, wv1, wv2):
    b, t, g, r, dh = q.shape
    tpos = jnp.arange(t)

    kc = compress(k_c, pe_k, wk1, wk2)
    vc = compress(v_c, pe_v, wv1, wv2)
    nc = kc.shape[1]
    cmp_start = jnp.arange(nc) * CMP_STRIDE
    cmask = (cmp_start + CMP_LEN - 1)[None, :] <= tpos[:, None]
    s_c = jnp.einsum('btgrd,bcgd->bgrtc', q, kc) * ATTN_SCALE
    p_c = masked_softmax(s_c, cmask)
    o_cmp = jnp.einsum('bgrtc,bcgd->btgrd', p_c.astype(vc.dtype), vc)

    ns = t // SEL_LEN
    n_sel = min(SEL_TOPK, ns)
    sel_start = jnp.arange(ns) * SEL_LEN
    overlap = jnp.clip(jnp.minimum(cmp_start[:, None] + CMP_LEN, sel_start[None, :] + SEL_LEN)
                       - jnp.maximum(cmp_start[:, None], sel_start[None, :]), 0)
    imp = jnp.einsum('bgrtc,cs->bgts', p_c, overlap.astype(jnp.float32) / CMP_LEN)
    blk_t = tpos // SEL_LEN
    sidx = jnp.arange(ns)
    valid = sel_start[None, :] <= tpos[:, None]
    forced = (sidx[None, :] == 0) | (sidx[None, :] == blk_t[:, None]) | (sidx[None, :] == blk_t[:, None] - 1)
    imp = jnp.where(forced, FORCED_SCORE, imp)
    imp = jnp.where(valid, imp, NEG_INF)
    top_v, top_i = lax.top_k(imp, n_sel)
    top_ok = top_v > 0.5 * NEG_INF

    ks_blocks = jnp.transpose(k_s.reshape(b, ns, SEL_LEN, g, dh), (0, 3, 1, 2, 4))
    vs_blocks = jnp.transpose(v_s.reshape(b, ns, SEL_LEN, g, dh), (0, 3, 1, 2, 4))
    qc_n = SEL_QUERY_CHUNK
    nq = t // qc_n
    q_ch = jnp.moveaxis(q.reshape(b, nq, qc_n, g, r, dh), 1, 0)
    i_ch = jnp.moveaxis(top_i.reshape(b, g, nq, qc_n, n_sel), 2, 0)
    ok_ch = jnp.moveaxis(top_ok.reshape(b, g, nq, qc_n, n_sel), 2, 0)
    p_ch = tpos.reshape(nq, qc_n)
    gather = jax.vmap(jax.vmap(lambda blocks, ix: blocks[ix]))

    def sel_chunk(args):
        q_i, idx_i, ok_i, pos_i = args
        kg = gather(ks_blocks, idx_i).reshape(b, g, qc_n, n_sel * SEL_LEN, dh)
        vg = gather(vs_blocks, idx_i).reshape(b, g, qc_n, n_sel * SEL_LEN, dh)
        kpos = idx_i[..., None] * SEL_LEN + jnp.arange(SEL_LEN)
        mask = ((kpos <= pos_i[None, None, :, None, None]) & ok_i[..., None]).reshape(b, g, qc_n, n_sel * SEL_LEN)
        s = jnp.einsum('bqgrd,bgqkd->bgrqk', q_i, kg) * ATTN_SCALE
        p = masked_softmax(s, mask[:, :, None])
        return jnp.einsum('bgrqk,bgqkd->bqgrd', p.astype(vg.dtype), vg)

    o_sel = lax.map(sel_chunk, (q_ch, i_ch, ok_ch, p_ch))
    o_sel = jnp.moveaxis(o_sel, 0, 1).reshape(b, t, g, r, dh)

    o_win = banded_attention(q, k_w, v_w, NSA_WINDOW, NSA_BLOCK)

    gt = jax.nn.sigmoid(gate_logits).reshape(b, t, g, r, 3)
    return gt[..., 0, None] * o_cmp + gt[..., 1, None] * o_sel + gt[..., 2, None] * o_win


def hybrid_mixer(h, w_in, sinks, pe_k, pe_v, wk1, wk2, wv1, wv2, w_up_a, w_up_b, w_o, cos, sin):
    b, t, _ = h.shape
    parts = jnp.split(h @ w_in, IN_SPLIT_POINTS, axis=-1)
    a_q, a_k, a_v, n_q, n_kc, n_vc, n_ks, n_vs, n_kw, n_vw, n_gate, m_gate = parts

    def heads(z):
        return z.reshape(b, t, -1, HEAD_DIM)

    def rot(z):
        return apply_rope(heads(z), cos, sin)

    qa = rot(a_q).reshape(b, t, SWA_KV_HEADS, SWA_GROUP, HEAD_DIM)
    sink = sinks.astype(jnp.float32).reshape(SWA_KV_HEADS, SWA_GROUP)[None, None, :, :, None, None]
    o_a = banded_attention(qa, rot(a_k), heads(a_v), SWA_WINDOW, SWA_BLOCK, sink)

    qb = rot(n_q).reshape(b, t, NSA_KV_HEADS, NSA_GROUP, HEAD_DIM)
    o_b = nsa_attention(qb, rot(n_kc), heads(n_vc), rot(n_ks), heads(n_vs), rot(n_kw), heads(n_vw),
                        n_gate, pe_k, pe_v, wk1, wk2, wv1, wv2)

    y_a = o_a.reshape(b, t, A_WIDTH) @ w_up_a
    y_b = o_b.reshape(b, t, B_WIDTH) @ w_up_b
    gm = jax.nn.sigmoid(m_gate).reshape(b, t, N_BRANCHES, D_MODEL)
    return (gm[:, :, 0] * y_a + gm[:, :, 1] * y_b) @ w_o


def swiglu(h, wg, wu, wd):
    return (jax.nn.silu(h @ wg) * (h @ wu)) @ wd


def moe_swiglu(h, w_router, wg, wu, wd):
    b, t, d = h.shape
    hf = h.reshape(b * t, d)
    logits = (hf @ w_router).astype(jnp.float32)
    top_l, top_e = lax.top_k(logits, TOP_K)
    w = jax.nn.softmax(top_l, axis=-1)
    comb = jnp.sum(jax.nn.one_hot(top_e, N_EXPERTS, dtype=jnp.float32) * w[..., None], axis=1)
    y = jnp.zeros_like(hf)
    for e in range(N_EXPERTS):
        y = y + comb[:, e:e + 1].astype(hf.dtype) * swiglu(hf, wg[e], wu[e], wd[e])
    return y.reshape(b, t, d)


def setup_inputs(seed: int = 0) -> dict:
    key = jax.random.key(seed)
    ks = jax.random.split(key, 22)
    d = D_MODEL

    def nrm(k, shape, scale):
        return jax.random.normal(k, shape, jnp.float32) * scale

    return {
        'x': nrm(ks[0], (BATCH, SEQ, d), 1.0),
        'attn_norm': 1.0 + nrm(ks[1], (DEPTH, d), 0.05),
        'w_in': nrm(ks[2], (DEPTH, d, IN_DIM), d ** -0.5),
        'attn_sinks': nrm(ks[3], (DEPTH, SWA_Q_HEADS), 0.5),
        'cmp_pe_k': nrm(ks[4], (DEPTH, CMP_LEN, HEAD_DIM), 0.1),
        'cmp_pe_v': nrm(ks[5], (DEPTH, CMP_LEN, HEAD_DIM), 0.1),
        'cmp_wk1': nrm(ks[6], (DEPTH, CMP_LEN * HEAD_DIM, CMP_HIDDEN), (CMP_LEN * HEAD_DIM) ** -0.5),
        'cmp_wk2': nrm(ks[7], (DEPTH, CMP_HIDDEN, HEAD_DIM), CMP_HIDDEN ** -0.5),
        'cmp_wv1': nrm(ks[8], (DEPTH, CMP_LEN * HEAD_DIM, CMP_HIDDEN), (CMP_LEN * HEAD_DIM) ** -0.5),
        'cmp_wv2': nrm(ks[9], (DEPTH, CMP_HIDDEN, HEAD_DIM), CMP_HIDDEN ** -0.5),
        'w_up_a': nrm(ks[10], (DEPTH, A_WIDTH, d), A_WIDTH ** -0.5),
        'w_up_b': nrm(ks[11], (DEPTH, B_WIDTH, d), B_WIDTH ** -0.5),
        'w_o': nrm(ks[12], (DEPTH, d, d), d ** -0.5),
        'ffn_norm': 1.0 + nrm(ks[13], (DEPTH, d), 0.05),
        'dense_w_gate': nrm(ks[14], (N_DENSE, d, D_FF), d ** -0.5),
        'dense_w_up': nrm(ks[15], (N_DENSE, d, D_FF), d ** -0.5),
        'dense_w_down': nrm(ks[16], (N_DENSE, D_FF, d), D_FF ** -0.5),
        'router_w': nrm(ks[17], (N_MOE, d, N_EXPERTS), d ** -0.5),
        'moe_w_gate': nrm(ks[18], (N_MOE, N_EXPERTS, d, D_FF), d ** -0.5),
        'moe_w_up': nrm(ks[19], (N_MOE, N_EXPERTS, d, D_FF), d ** -0.5),
        'moe_w_down': nrm(ks[20], (N_MOE, N_EXPERTS, D_FF, d), D_FF ** -0.5),
        'final_norm': 1.0 + nrm(ks[21], (d,), 0.05),
    }


def reference(x, attn_norm, w_in, attn_sinks, cmp_pe_k, cmp_pe_v, cmp_wk1, cmp_wk2, cmp_wv1, cmp_wv2,
              w_up_a, w_up_b, w_o, ffn_norm, dense_w_gate, dense_w_up, dense_w_down,
              router_w, moe_w_gate, moe_w_up, moe_w_down, final_norm):
    cos, sin = rope_tables(x.shape[1])
    for layer in range(DEPTH):
        h = rms_norm(x, attn_norm[layer])
        x = x + hybrid_mixer(h, w_in[layer], attn_sinks[layer], cmp_pe_k[layer], cmp_pe_v[layer],
                             cmp_wk1[layer], cmp_wk2[layer], cmp_wv1[layer], cmp_wv2[layer],
                             w_up_a[layer], w_up_b[layer], w_o[layer], cos, sin)
        h = rms_norm(x, ffn_norm[layer])
        i = layer // 2
        if layer % 2 == 0:
            x = x + swiglu(h, dense_w_gate[i], dense_w_up[i], dense_w_down[i])
        else:
            x = x + moe_swiglu(h, router_w[i], moe_w_gate[i], moe_w_up[i], moe_w_down[i])
    return rms_norm(x, final_norm)
```

```cpp
#include <hip/hip_runtime.h>
#include <cstdio>
#include <cstdint>

#define LAS __attribute__((address_space(3)))
#define GAS __attribute__((address_space(1)))
typedef unsigned short bf16_t;
typedef short bf16x8 __attribute__((ext_vector_type(8)));
typedef short s16x4 __attribute__((ext_vector_type(4)));
typedef float f32x4 __attribute__((ext_vector_type(4)));
typedef float f32x2 __attribute__((ext_vector_type(2)));
typedef float f32x16 __attribute__((ext_vector_type(16)));
typedef unsigned u32x4 __attribute__((ext_vector_type(4)));
typedef unsigned u32x2 __attribute__((ext_vector_type(2)));

constexpr int NB = 4, T = 4096, D = 2048, M = NB * T, HD = 128, FF = 7168, NE = 8;
constexpr int IN_DIM = 8216, NIN = 8448;
constexpr int NCMP = 255, CMPH = 256;
constexpr float NORM_EPS = 1e-6f;
constexpr int MAXSLOT = 34816;
constexpr int YT_ROWS = 31 * 256;

constexpr size_t MiB = 1u << 20;
constexpr size_t WS_CTL = 0, CTL_ZERO_BYTES = 2 * MiB;
constexpr int CW_TMO = 0, CW_QUEUE = 1024, CW_ECNT = 2048, CW_BAR = 4096;
constexpr size_t WS_RSQ = 1 * MiB;
constexpr size_t WS_ROPE = 2 * MiB;
constexpr size_t WS_MISC = 4 * MiB;
constexpr size_t WS_CBIAS = 512 * 1024;
constexpr float CB_SCALE = 1099511627776.0f;
constexpr size_t WS_LTOK = WS_MISC + 64 * 1024;
constexpr size_t WS_LW = WS_LTOK + (size_t)NE * M * 4;
constexpr size_t WS_SLOT = WS_LW + (size_t)NE * M * 4;
constexpr size_t WS_W = 6 * MiB;
constexpr size_t SZ_WIN = (size_t)NIN * D * 2, SZ_W1 = (size_t)CMPH * 4096 * 2, SZ_W2 = (size_t)256 * 256 * 2, SZ_WUP = (size_t)D * 1024 * 2, SZ_WO = (size_t)D * D * 2;
constexpr size_t SZ_WGU = (size_t)2 * FF * D * 2, SZ_WD = (size_t)D * FF * 2;
constexpr size_t SZ_WGU8 = (size_t)2 * FF * D, SZ_WD8 = (size_t)D * FF;
constexpr float WGU8_SCALE = 32.0f, WD8_SCALE = 64.0f, WIN8_SCALE = 32.0f, WUP8_SCALE = 32.0f, WO8_SCALE = 32.0f, O8_SCALE = 16.0f, Z8_SCALE = 16.0f;
constexpr size_t WS_WIN = WS_W;
constexpr size_t WS_W1 = WS_WIN + 2 * SZ_WIN;
constexpr size_t WS_W2 = WS_W1 + 4 * SZ_W1;
constexpr size_t WS_WUP = WS_W2 + 4 * SZ_W2;
constexpr size_t WS_WO = WS_WUP + 4 * SZ_WUP;
constexpr size_t WS_WGUD = WS_WO + 2 * SZ_WO;
constexpr size_t WS_WDD = WS_WGUD + SZ_WGU;
constexpr size_t WS_WGUM = WS_WDD + SZ_WD;
constexpr size_t WS_WDM = WS_WGUM + 8 * SZ_WGU8;
constexpr size_t WS_X8 = WS_WDM + 8 * SZ_WD8;
constexpr size_t WS_XR = WS_X8 + (size_t)M * D;
constexpr size_t WS_XBF = WS_XR + (size_t)M * D * 4;
constexpr size_t WS_YS = WS_XBF + (size_t)M * D * 2;
constexpr size_t WS_BIG = WS_YS + (size_t)MAXSLOT * D * 2;
constexpr size_t SZ_BIG = (size_t)MAXSLOT * FF * 2;
constexpr size_t WS_END = WS_BIG + SZ_BIG;
constexpr size_t BG_QKV = 0;
constexpr size_t BG_GM = BG_QKV + (size_t)M * 4096 * 2;
constexpr size_t BG_NG = BG_GM + (size_t)M * 4096 * 2;
constexpr size_t BG_KCB = BG_NG + (size_t)M * 32 * 2;
constexpr size_t BG_VCB = BG_KCB + (size_t)M * 256 * 2 + 65536;
constexpr size_t BG_HC = BG_VCB + (size_t)M * 256 * 2 + 65536;
constexpr size_t BG_KCMP = BG_HC + (size_t)2 * 2048 * 256 * 2;
constexpr size_t BG_VCMP = BG_KCMP + (size_t)8 * 256 * 128 * 2;
constexpr size_t BG_OA = BG_VCMP + (size_t)8 * 256 * 128 * 2;
constexpr size_t BG_OB = BG_OA + (size_t)M * 1024 * 2;
constexpr size_t BG_Z = BG_OB + (size_t)M * 1024 * 2;
constexpr size_t BG_END = BG_Z + (size_t)M * D * 2;
static_assert(BG_END <= SZ_BIG, "attention-phase tensors fit the aliased region");
constexpr size_t BG_YT = 256 * MiB;
static_assert((size_t)MAXSLOT * FF <= BG_YT && BG_YT + (size_t)4 * YT_ROWS * D * 2 <= SZ_BIG, "tail partials fit");
static_assert(WS_SLOT + (size_t)M * 8 <= WS_W, "misc region");

constexpr int LDS_K = 0, LDS_V = 65536, LDS_WSCR = 131072  , LDS_IMP = LDS_WSCR + 2048  , LDS_SELM = LDS_IMP + 64 * 65 * 4  ;
constexpr int LDS_MISC = LDS_SELM + 512;
constexpr int LDS_BYTES = LDS_MISC + 256;
static_assert(LDS_BYTES <= 163840, "LDS");
static_assert(LDS_WSCR + 32 * 528 <= LDS_MISC, "epilogue slab fits beside the GEMM buffers");
constexpr int NWAVES = 8, NTHREADS = 512;

#define RLX_AGENT __ATOMIC_RELAXED, __HIP_MEMORY_SCOPE_AGENT
#define LDS_WAIT() asm volatile("s_waitcnt lgkmcnt(0)" ::: "memory")
#define VM_WAIT() asm volatile("s_waitcnt vmcnt(0)" ::: "memory")

typedef __bf16 bf16x2_t __attribute__((ext_vector_type(2)));
__device__ __forceinline__ unsigned cvt_pk_bf16(float lo, float hi) { f32x2 v = {lo, hi}; bf16x2_t b = __builtin_convertvector(v, bf16x2_t); return __builtin_bit_cast(unsigned, b); }
__device__ __forceinline__ float bf_lo(unsigned w) { return __uint_as_float(w << 16); }
__device__ __forceinline__ float bf_hi(unsigned w) { return __uint_as_float(w & 0xffff0000u); }
__device__ __forceinline__ float bf2f(bf16_t b) { return __uint_as_float(((unsigned)b) << 16); }
__device__ __forceinline__ float fast_sigmoid(float x) { return __builtin_amdgcn_rcpf(1.0f + __builtin_amdgcn_exp2f(-1.4426950408889634f * x)); }
__device__ __forceinline__ int opaque_tid() { int t; asm volatile("v_mov_b32 %0, %1" : "=v"(t) : "v"((int)threadIdx.x)); return t; }
typedef unsigned long long u64;
typedef int v8i __attribute__((ext_vector_type(8)));
typedef int v4i __attribute__((ext_vector_type(4)));
__device__ __forceinline__ unsigned cvt4_fp8(float a, float b, float c, float d) { unsigned w = 0u; w = __builtin_amdgcn_cvt_pk_fp8_f32(a, b, w, false); w = __builtin_amdgcn_cvt_pk_fp8_f32(c, d, w, true); return w; }
constexpr float RSQ_SCALE = 1048576.0f;
__device__ __forceinline__ float rstd_of(const u64* rsq, int row) { return rsqrtf((float)rsq[row] * (1.0f / (RSQ_SCALE * D)) + NORM_EPS); }
__device__ __forceinline__ float wave_sum(float v) {
#pragma unroll
    for (int o = 1; o < 64; o <<= 1) v += __shfl_xor(v, o);
    return v;
}

#define XB_TMO      128
#define XB_XCNT(j)  (256  + 64 * (j))
#define XB_XSUB(j)  (1280 + 64 * (j))
#define XB_XGEN(j)  (2304 + 64 * (j))
#define XB_TOP      3328
#define XB_TOPGEN   3392
#define XCD_BAR_WORDS 3456
#define XB_SPIN_CAP (1u << 18)
__device__ __forceinline__ unsigned xb_ld(unsigned* p)              { return __hip_atomic_load(p, __ATOMIC_RELAXED, __HIP_MEMORY_SCOPE_AGENT); }
__device__ __forceinline__ unsigned xb_add(unsigned* p, unsigned v) { return __hip_atomic_fetch_add(p, v, __ATOMIC_RELAXED, __HIP_MEMORY_SCOPE_AGENT); }
__device__ __forceinline__ unsigned xb_xcc_id() { return (unsigned)__builtin_amdgcn_s_getreg((3 << 11) | 20) & 0xFu; }
#define XB_SPIN(cond, bar) do { unsigned _sp = 0; while (cond) { __builtin_amdgcn_s_sleep(1); \
    if ((++_sp & 255u) == 0u) { if (xb_ld(&(bar)[XB_TMO])) break; if (_sp > XB_SPIN_CAP) { atomicAdd(&(bar)[XB_TMO], 1u); break; } } } } while (0)
struct XcdBarrier { unsigned* bar; unsigned x; volatile LAS unsigned* st; };
__device__ __forceinline__ XcdBarrier xcd_barrier_post(unsigned* bar, volatile LAS unsigned* st) {
    XcdBarrier b; b.bar = bar; b.x = xb_xcc_id(); b.st = st;
    if (threadIdx.x == 0) (void)xb_add(&bar[XB_XCNT(b.x)], 1u);
    return b;
}
__device__ __forceinline__ void xcd_barrier_complete(unsigned* bar, unsigned x, unsigned& nloc, unsigned& nx) {
    const unsigned G = gridDim.x * gridDim.y * gridDim.z;
    unsigned sum, cnt, mine, sp = 0u;
    for (;;) {
        sum = 0u; cnt = 0u; mine = 0u;
#pragma unroll
        for (unsigned j = 0; j < 16; ++j) { const unsigned c = xb_ld(&bar[XB_XCNT(j)]); sum += c; cnt += (c > 0u) ? 1u : 0u; mine = (j == x) ? c : mine; }
        if (sum == G) break;
        __builtin_amdgcn_s_sleep(1);
        if ((++sp & 255u) == 0u) { if (xb_ld(&bar[XB_TMO])) break; if (sp > XB_SPIN_CAP) { atomicAdd(&bar[XB_TMO], 1u); break; } }
    }
    nloc = mine > 0u ? mine : 1u; nx = cnt > 0u ? cnt : 1u;
}
__device__ __forceinline__ void xcd_barrier(const XcdBarrier& b) {
    asm volatile("s_waitcnt vmcnt(0)" ::: "memory");
    __syncthreads();
    if (threadIdx.x == 0) {
        unsigned* bar = b.bar;
        __builtin_amdgcn_s_waitcnt(0);
        unsigned nloc = b.st[0], nx = b.st[1];
        if (nloc == 0u) { xcd_barrier_complete(bar, b.x, nloc, nx); b.st[0] = nloc; b.st[1] = nx; }
        const unsigned old = xb_add(&bar[XB_XSUB(b.x)], 1u);
        const unsigned gen = old / nloc;
        if (old + 1u == (gen + 1u) * nloc) {
            __builtin_amdgcn_fence(__ATOMIC_RELEASE, "agent");
            asm volatile("s_waitcnt vmcnt(0)" ::: "memory");
            const unsigned og = xb_add(&bar[XB_TOP], 1u);
            const unsigned tg = og / nx;
            if (og + 1u == (tg + 1u) * nx) xb_add(&bar[XB_TOPGEN], 1u);
            else XB_SPIN(xb_ld(&bar[XB_TOPGEN]) == tg, bar);
            __builtin_amdgcn_fence(__ATOMIC_ACQUIRE, "agent");
            xb_add(&bar[XB_XGEN(b.x)], 1u);
            asm volatile("s_waitcnt vmcnt(0)" ::: "memory");
        } else {
            XB_SPIN(xb_ld(&bar[XB_XGEN(b.x)]) == gen, bar);
            __builtin_amdgcn_fence(__ATOMIC_ACQUIRE, "agent");
            asm volatile("s_waitcnt vmcnt(0)" ::: "memory");
        }
    }
    __syncthreads();
}

namespace pg8 {
constexpr int BM = 256, BK = 64, HALF = 128, HTB = HALF * BK * 2, STAGE_BYTES = 8 * HTB, NXCD = 8, WGM = 4;
__host__ __device__ __forceinline__ int lds_byte(int r, int c) { const int st = (r >> 4) * 2 + (c >> 5), rr = r & 15, cc = c & 31, ob = rr * 64 + cc * 2; return st * 1024 + (ob ^ (((ob >> 9) & 1) << 5)); }
__host__ __device__ __forceinline__ void stage_rc(int b, int& R, int& C) { const int st = b / 1024, sb = b % 1024, swz = sb ^ (((sb >> 9) & 1) << 5); R = (st >> 1) * 16 + swz / 64; C = (st & 1) * 32 + (swz % 64) / 2; }
__host__ __device__ __forceinline__ int perm32(int rho) { const int n = rho >> 4, i = rho & 15; return 8 * (i >> 2) + 4 * n + (i & 3); }

struct Unit { int pm, pn, aux; };
typedef f32x4 Acc[2][2][4][2];

__device__ __forceinline__ bool static_tile(int L, int nM, int nN, int& pm, int& pn) {
    const int nwg = nM * nN; if (L >= nwg) return false;
    int wgid = L; { const int q = nwg / NXCD, r = nwg % NXCD, xcd = wgid % NXCD, off = wgid / NXCD; wgid = (xcd < r ? xcd * (q + 1) : r * (q + 1) + (xcd - r) * q) + off; }
    const int nig = WGM * nN, gid = wgid / nig, fm = gid * WGM, gsz = (nM - fm) < WGM ? (nM - fm) : WGM;
    pm = fm + ((wgid % nig) % gsz); pn = (wgid % nig) / gsz; return true;
}

__device__ __forceinline__ void glds_s(const void* sbase, unsigned voff, unsigned lds_dst) { unsigned keep;
    asm volatile("s_mov_b32 %0, m0\n\ts_mov_b32 m0, %3\n\ts_nop 0\n\tglobal_load_lds_dwordx4 %1, %2\n\ts_mov_b32 m0, %0" : "=&s"(keep) : "v"(voff), "s"(sbase), "s"(lds_dst) : "memory"); }
__device__ __forceinline__ const char* uni_ptr(const char* p) { const unsigned long long v = (unsigned long long)p; const unsigned lo = __builtin_amdgcn_readfirstlane((unsigned)v), hi = __builtin_amdgcn_readfirstlane((unsigned)(v >> 32));
    return (const char*)(GAS const char*)(((unsigned long long)hi << 32) | lo); }
template <bool FP8, class Epi, class Sched>
__device__ __forceinline__ void gemm_phase(LAS unsigned char* lds, const int Kb, const Sched& S, const Epi& E) {
    const int tid = opaque_tid(), wid = __builtin_amdgcn_readfirstlane(tid >> 6), lane = tid & 63, wr = wid >> 2, wc = wid & 3, fr = lane & 15, fq = lane >> 4;
    const int nt = Kb / 128;
    int Rr[2], Cc[2]; unsigned voffB[2];
#pragma unroll
    for (int i = 0; i < 2; ++i) { stage_rc(tid * 16 + i * 8192, Rr[i], Cc[i]); const int Rb = Epi::PERM ? ((Rr[i] & ~31) + perm32(Rr[i] & 31)) : Rr[i];
        voffB[i] = (unsigned)(Rb * S.ldb() + Cc[i] * 2); }
    const size_t kstep = (size_t)(BK * 2);
    const size_t hstepB = (size_t)HALF * S.ldb();
    const unsigned ldsw = (unsigned)wid * 1024u;
    const unsigned ldsb = (unsigned)__builtin_amdgcn_readfirstlane((int)((unsigned)(uintptr_t)lds + ldsw));
    const int aoff = lds_byte(wr * 64 + fr, fq * 8), boff = lds_byte(wc * 32 + fr, fq * 8);
#define PG8_SA(b, h) (((b) * 2 + (h)) * HTB)
#define PG8_SB(b, h) ((4 + (b) * 2 + (h)) * HTB)
#define PG8_STAGE(bufoff, gbase, voff) do { const void* sb_ = (const void*)(gbase); _Pragma("unroll") for (int _i = 0; _i < 2; ++_i) \
        glds_s(sb_, (voff)[_i], ldsb + (unsigned)((bufoff) + _i * 8192)); } while (0)
#define PG8_LD8(p_) __builtin_shufflevector(*(const LAS v4i*)(p_), *(const LAS v4i*)((p_) + 1024), 0, 1, 2, 3, 4, 5, 6, 7)
#define PG8_LDA(dst, b, h) do { _Pragma("unroll") for (int m = 0; m < 4; ++m) dst[m] = PG8_LD8(lds + PG8_SA(b, h) + aoff + m * 2048); } while (0)
#define PG8_LDB(dst, b, h) do { _Pragma("unroll") for (int n = 0; n < 2; ++n) dst[n] = PG8_LD8(lds + PG8_SB(b, h) + boff + n * 2048); } while (0)
#define PG8_H(v_, k_) __builtin_bit_cast(bf16x8, __builtin_shufflevector(v_, v_, 4 * (k_), 4 * (k_) + 1, 4 * (k_) + 2, 4 * (k_) + 3))
#define PG8_MMA(ai, bj, At, Bt) do { __builtin_amdgcn_s_setprio(1); _Pragma("unroll") for (int m = 0; m < 4; ++m) _Pragma("unroll") for (int n = 0; n < 2; ++n) { \
        if constexpr (FP8) asm volatile("v_mfma_f32_16x16x128_f8f6f4 %0, %1, %2, %0" : "+v"(acc[ai][bj][m][n]) : "v"(Bt[n]), "v"(At[m]));   \
        else { acc[ai][bj][m][n] = __builtin_amdgcn_mfma_f32_16x16x32_bf16(PG8_H(Bt[n], 0), PG8_H(At[m], 0), acc[ai][bj][m][n], 0, 0, 0); \
               acc[ai][bj][m][n] = __builtin_amdgcn_mfma_f32_16x16x32_bf16(PG8_H(Bt[n], 1), PG8_H(At[m], 1), acc[ai][bj][m][n], 0, 0, 0); } } \
        __builtin_amdgcn_s_setprio(0); } while (0)
#define PG8_WAIT_V(n) asm volatile("s_waitcnt vmcnt(" #n ")" ::: "memory")
#define PG8_WAIT_L(n) asm volatile("s_waitcnt lgkmcnt(" #n ")" ::: "memory")
#define PG8_BAR __builtin_amdgcn_s_barrier()
#define PG8_SCHED __builtin_amdgcn_sched_barrier(0)
    Unit cur, nxt; int ui = 0;
    if (!S.next(0, cur)) return;
    Acc acc;
#pragma unroll
    for (int a = 0; a < 2; ++a)
#pragma unroll
        for (int b = 0; b < 2; ++b)
#pragma unroll
            for (int m = 0; m < 4; ++m)
#pragma unroll
                for (int n = 0; n < 2; ++n) acc[a][b][m][n] = (f32x4){0.f, 0.f, 0.f, 0.f};
    v8i At[4], B0[2], B1[2]; const int one8 = 0x7F7F7F7F;
    unsigned vA[2][2], vAn[2][2];
    S.a_off(cur, Rr, Cc, vA);
    const char* cA = uni_ptr(S.a_base(cur)); const char* cB = uni_ptr(S.b_base(cur));
    PG8_STAGE(PG8_SB(0, 0), cB, voffB); PG8_STAGE(PG8_SB(0, 1), cB + hstepB, voffB); PG8_STAGE(PG8_SA(0, 0), cA, vA[0]); PG8_STAGE(PG8_SA(0, 1), cA, vA[1]);
    if (wr == 1) PG8_BAR;
    PG8_WAIT_V(2); PG8_BAR;
    PG8_STAGE(PG8_SB(1, 0), cB + kstep, voffB); PG8_STAGE(PG8_SA(1, 0), cA + kstep, vA[0]); PG8_STAGE(PG8_SB(1, 1), cB + hstepB + kstep, voffB);
    PG8_WAIT_V(6); PG8_BAR;
    for (;;) {
        const bool has_next = S.next(ui + 1, nxt);
        const char* nA = cA; const char* nB = cB;
#pragma unroll
        for (int h = 0; h < 2; ++h)
#pragma unroll
            for (int i = 0; i < 2; ++i) vAn[h][i] = vA[h][i];
        if (has_next) { nA = uni_ptr(S.a_base(nxt)); nB = uni_ptr(S.b_base(nxt)); if (Sched::VARIES) S.a_off(nxt, Rr, Cc, vAn); }
        for (int t = 0; t < nt; t += 2) {
            const bool last = (t == nt - 2);
            const char* a1 = cA + (size_t)(t + 1) * kstep;
            const char* a2 = last ? nA : cA + (size_t)(t + 2) * kstep; const char* b2 = last ? nB : cB + (size_t)(t + 2) * kstep;
            const char* a3 = a2 + kstep; const char* b3 = b2 + kstep;
            unsigned v2[2][2];
#pragma unroll
            for (int h = 0; h < 2; ++h)
#pragma unroll
                for (int i = 0; i < 2; ++i) v2[h][i] = (Sched::VARIES && last) ? vAn[h][i] : vA[h][i];
            PG8_LDB(B0, 0, 0); PG8_LDB(B1, 0, 1); PG8_SCHED; PG8_LDA(At, 0, 0); PG8_STAGE(PG8_SA(1, 1), a1, vA[1]);
            PG8_WAIT_V(8); PG8_WAIT_L(0); PG8_BAR; PG8_MMA(0, 0, At, B0); PG8_MMA(0, 1, At, B1); PG8_BAR; PG8_SCHED;
            PG8_LDA(At, 0, 1); PG8_STAGE(PG8_SB(0, 0), b2, voffB); PG8_STAGE(PG8_SB(0, 1), b2 + hstepB, voffB); PG8_STAGE(PG8_SA(0, 0), a2, v2[0]);
            PG8_WAIT_V(8); PG8_WAIT_L(0); PG8_BAR; PG8_MMA(1, 0, At, B0); PG8_MMA(1, 1, At, B1); PG8_BAR; PG8_SCHED;
            PG8_LDB(B0, 1, 0); PG8_LDB(B1, 1, 1); PG8_SCHED; PG8_LDA(At, 1, 0); PG8_STAGE(PG8_SA(0, 1), a2, v2[1]);
            PG8_WAIT_V(8); PG8_WAIT_L(0); PG8_BAR; PG8_MMA(0, 0, At, B0); PG8_MMA(0, 1, At, B1); PG8_BAR; PG8_SCHED;
            PG8_LDA(At, 1, 1); PG8_STAGE(PG8_SB(1, 0), b3, voffB); PG8_STAGE(PG8_SB(1, 1), b3 + hstepB, voffB); PG8_STAGE(PG8_SA(1, 0), a3, v2[0]);
            PG8_WAIT_V(8); PG8_WAIT_L(0); PG8_BAR; PG8_MMA(1, 0, At, B0); PG8_MMA(1, 1, At, B1); PG8_BAR; PG8_SCHED;
        }
        if (wr == 0) PG8_BAR;
        if constexpr (FP8) asm volatile("s_nop 15\n\ts_nop 15" ::: "memory");
        E(acc, cur, wr, wc, fr, fq);
        if (!has_next) break;
        if (!E.keep(cur)) {
#pragma unroll
            for (int a = 0; a < 2; ++a)
#pragma unroll
                for (int b = 0; b < 2; ++b)
#pragma unroll
                    for (int m = 0; m < 4; ++m)
#pragma unroll
                        for (int n = 0; n < 2; ++n) acc[a][b][m][n] = (f32x4){0.f, 0.f, 0.f, 0.f};
        }
        cur = nxt; cA = nA; cB = nB; ++ui;
#pragma unroll
        for (int h = 0; h < 2; ++h)
#pragma unroll
            for (int i = 0; i < 2; ++i) vA[h][i] = vAn[h][i];
        if (wr == 1) PG8_BAR;
    }
    PG8_WAIT_V(0);
    PG8_BAR;
#undef PG8_SA
#undef PG8_SB
#undef PG8_STAGE
#undef PG8_LDA
#undef PG8_LDB
#undef PG8_MMA
#undef PG8_WAIT_V
#undef PG8_WAIT_L
#undef PG8_BAR
#undef PG8_SCHED
}

struct SchedDense {
    static constexpr bool VARIES = false;
    const void* A; const void* Bt; int lda, ldb_, nM, nN, G, c;
    __device__ __forceinline__ int ldb() const { return ldb_; }
    __device__ __forceinline__ bool next(int i, Unit& u) const { u.aux = 0; return static_tile(i * G + c, nM, nN, u.pm, u.pn); }
    __device__ __forceinline__ const char* a_base(const Unit& u) const { return (const char*)A + (size_t)u.pm * BM * lda; }
    __device__ __forceinline__ const char* b_base(const Unit& u) const { return (const char*)Bt + (size_t)u.pn * BM * ldb_; }
    __device__ __forceinline__ void a_off(const Unit&, const int (&R)[2], const int (&C)[2], unsigned (&vo)[2][2]) const {
#pragma unroll
        for (int h = 0; h < 2; ++h)
#pragma unroll
            for (int i = 0; i < 2; ++i) vo[h][i] = (unsigned)((h * HALF + R[i]) * lda + C[i] * 2); }
};
struct SchedOne {
    static constexpr bool VARIES = false;
    const void* A; const void* Bt; int lda, ldb_, pm, pn;
    __device__ __forceinline__ int ldb() const { return ldb_; }
    __device__ __forceinline__ bool next(int i, Unit& u) const { u.aux = 0; u.pm = pm; u.pn = pn; return i == 0; }
    __device__ __forceinline__ const char* a_base(const Unit& u) const { return (const char*)A + (size_t)u.pm * BM * lda; }
    __device__ __forceinline__ const char* b_base(const Unit& u) const { return (const char*)Bt + (size_t)u.pn * BM * ldb_; }
    __device__ __forceinline__ void a_off(const Unit&, const int (&R)[2], const int (&C)[2], unsigned (&vo)[2][2]) const {
#pragma unroll
        for (int h = 0; h < 2; ++h)
#pragma unroll
            for (int i = 0; i < 2; ++i) vo[h][i] = (unsigned)((h * HALF + R[i]) * lda + C[i] * 2); }
};
struct SchedSeg2 {
    static constexpr bool VARIES = false;
    const void* A0; const void* B0; const void* A1; const void* B1; int ld, nM, nN, G, c;
    __device__ __forceinline__ int ldb() const { return ld; }
    __device__ __forceinline__ bool next(int i, Unit& u) const { u.aux = i & 1; return static_tile((i >> 1) * G + c, nM, nN, u.pm, u.pn); }
    __device__ __forceinline__ const char* a_base(const Unit& u) const { return (const char*)(u.aux ? A1 : A0) + (size_t)u.pm * BM * ld; }
    __device__ __forceinline__ const char* b_base(const Unit& u) const { return (const char*)(u.aux ? B1 : B0) + (size_t)u.pn * BM * ld; }
    __device__ __forceinline__ void a_off(const Unit&, const int (&R)[2], const int (&C)[2], unsigned (&vo)[2][2]) const {
#pragma unroll
        for (int h = 0; h < 2; ++h)
#pragma unroll
            for (int i = 0; i < 2; ++i) vo[h][i] = (unsigned)((h * HALF + R[i]) * ld + C[i] * 2); }
};
template <bool GATHER> struct SchedMoE {
    static constexpr bool VARIES = GATHER;
    const void* A; const void* Bt; const int* ltok; int lda, ldb_, nN, G, c; size_t bstride; const volatile LAS unsigned* misc; int nm_word;
    __device__ __forceinline__ int ldb() const { return ldb_; }
    __device__ __forceinline__ bool next(int i, Unit& u) const {
        const int nM = (int)misc[nm_word]; if (!static_tile(i * G + c, nM, nN, u.pm, u.pn)) return false;
        int e = 0;
#pragma unroll
        for (int j = 1; j < NE; ++j) e += ((int)misc[16 + j] <= u.pm) ? 1 : 0;
        u.aux = e; return true; }
    __device__ __forceinline__ const char* a_base(const Unit& u) const { return GATHER ? (const char*)A : (const char*)A + (size_t)u.pm * BM * lda; }
    __device__ __forceinline__ const char* b_base(const Unit& u) const { return (const char*)Bt + (size_t)u.aux * bstride + (size_t)u.pn * BM * ldb_; }
    __device__ __forceinline__ void a_off(const Unit& u, const int (&R)[2], const int (&C)[2], unsigned (&vo)[2][2]) const {
        if (GATHER) {
            const int cnt = (int)misc[8 + u.aux], r0 = (u.pm - (int)misc[16 + u.aux]) * BM;
#pragma unroll
            for (int h = 0; h < 2; ++h)
#pragma unroll
                for (int i = 0; i < 2; ++i) { const int r = r0 + h * HALF + R[i]; const int tok = r < cnt ? ltok[u.aux * M + r] : 0; vo[h][i] = (unsigned)(tok * lda + C[i] * 2); }
        } else {
#pragma unroll
            for (int h = 0; h < 2; ++h)
#pragma unroll
                for (int i = 0; i < 2; ++i) vo[h][i] = (unsigned)((h * HALF + R[i]) * lda + C[i] * 2);
        } }
};

struct SchedMoETail {
    static constexpr bool VARIES = false;
    const void* A; const void* Bt; int lda, ldb_, nN, c, kpart; size_t bstride; const volatile LAS unsigned* misc;
    __device__ __forceinline__ int ldb() const { return ldb_; }
    __device__ __forceinline__ bool next(int i, Unit& u) const {
        const int S = (int)misc[26], Tm = (int)misc[25], nt = ((int)misc[24] - Tm) * nN;
        if (i != 0 || c >= nt * S) return false;
        const int j = c / S, part = c - j * S; u.pm = Tm + j / nN; u.pn = j % nN;
        int e = 0;
#pragma unroll
        for (int q = 1; q < NE; ++q) e += ((int)misc[16 + q] <= u.pm) ? 1 : 0;
        u.aux = e | (part << 8); return true; }
    __device__ __forceinline__ const char* a_base(const Unit& u) const { return (const char*)A + (size_t)u.pm * BM * lda + (size_t)(u.aux >> 8) * kpart; }
    __device__ __forceinline__ const char* b_base(const Unit& u) const { return (const char*)Bt + (size_t)(u.aux & 255) * bstride + (size_t)u.pn * BM * ldb_ + (size_t)(u.aux >> 8) * kpart; }
    __device__ __forceinline__ void a_off(const Unit&, const int (&R)[2], const int (&C)[2], unsigned (&vo)[2][2]) const {
#pragma unroll
        for (int h = 0; h < 2; ++h)
#pragma unroll
            for (int i = 0; i < 2; ++i) vo[h][i] = (unsigned)((h * HALF + R[i]) * lda + C[i] * 2); }
};

struct EpiIn {
    static constexpr bool PERM = true;
    bf16_t* QKV; bf16_t* KCb; bf16_t* VCb; bf16_t* GMb; bf16_t* NGb; const u64* rsq; const float* cosT; const float* sinT; float wscale;
    LAS unsigned char* slab;
    __device__ __forceinline__ bool keep(const Unit&) const { return false; }
    __device__ __forceinline__ void operator()(const Acc& acc, const Unit& u, int wr, int wc, int fr, int fq) const {
        const int pn = u.pn, row0 = u.pm * BM + wr * 64 + fr;
        u64 rq[2][4];
#pragma unroll
        for (int ai = 0; ai < 2; ++ai)
#pragma unroll
            for (int m = 0; m < 4; ++m) rq[ai][m] = rsq[row0 + ai * HALF + m * 16];
        const float sc = (1.0f / (RSQ_SCALE * D));
        if (pn < 32) {
            const int wid = wr * 4 + wc, lane = fq * 16 + fr;
            LAS unsigned char* wrow = slab + (wr * 16 + fr) * 528;
            const int sr = wid * 4 + (lane >> 5), cb = (lane & 31) * 16;
            const LAS unsigned char* rp = slab + sr * 528 + cb;
            const int trow = (sr >> 4) * 64 + (sr & 15);
            const bool rope = pn < 16 && ((0x57DF >> pn) & 1); const int d0 = 16 * wc + 4 * fq;
            f32x4 csa[8], sna[8];
#pragma unroll
            for (int g = 0; g < 8; ++g) { csa[g] = f32x4{1.f, 1.f, 1.f, 1.f}; sna[g] = f32x4{0.f, 0.f, 0.f, 0.f}; }
            if (rope) {
#pragma unroll
                for (int g = 0; g < 8; ++g) { const int t = (row0 + (g >> 2) * HALF + (g & 3) * 16) & (T - 1); csa[g] = *(const f32x4*)(cosT + t * 64 + d0); sna[g] = *(const f32x4*)(sinT + t * 64 + d0); } }
#pragma unroll
            for (int g = 0; g < 8; ++g) { const int ai = g >> 2, m = g & 3; const f32x4 cs = csa[g], sn = sna[g];
                const float rstd = rsqrtf((float)rq[ai][m] * sc + NORM_EPS) * wscale;
#pragma unroll
                for (int bj = 0; bj < 2; ++bj) { const f32x4 v0 = acc[ai][bj][m][0] * rstd, v1 = acc[ai][bj][m][1] * rstd;
                    if (pn < 16) { const f32x4 o1 = v0 * cs - v1 * sn, o2 = v1 * cs + v0 * sn;
                        u32x2 w1, w2; w1.x = cvt_pk_bf16(o1[0], o1[1]); w1.y = cvt_pk_bf16(o1[2], o1[3]); w2.x = cvt_pk_bf16(o2[0], o2[1]); w2.y = cvt_pk_bf16(o2[2], o2[3]);
                        *(LAS u32x2*)(wrow + (bj * HD + d0) * 2) = w1; *(LAS u32x2*)(wrow + (bj * HD + 64 + d0) * 2) = w2; }
                    else { u32x4 w;
                        w.x = cvt_pk_bf16(fast_sigmoid(v0[0]), fast_sigmoid(v0[1])); w.y = cvt_pk_bf16(fast_sigmoid(v0[2]), fast_sigmoid(v0[3]));
                        w.z = cvt_pk_bf16(fast_sigmoid(v1[0]), fast_sigmoid(v1[1])); w.w = cvt_pk_bf16(fast_sigmoid(v1[2]), fast_sigmoid(v1[3]));
                        *(LAS u32x4*)(wrow + (bj * HD + wc * 32 + 8 * fq) * 2) = w; } }
                asm volatile("s_waitcnt lgkmcnt(0)" ::: "memory"); __builtin_amdgcn_s_barrier(); asm volatile("" ::: "memory");
                const u32x4 ra = *(const LAS u32x4*)rp, rb = *(const LAS u32x4*)(rp + 2 * 528);
                asm volatile("s_waitcnt lgkmcnt(0)" ::: "memory"); __builtin_amdgcn_s_barrier(); asm volatile("" ::: "memory");
                const int grow = u.pm * BM + ai * HALF + m * 16 + trow;
                unsigned char* dst; size_t rstride;
                if (pn == 10 || pn == 11) { bf16_t* cbuf = pn == 10 ? KCb : VCb; dst = (unsigned char*)(cbuf + ((size_t)((grow >> 12) * 2 + (cb >> 8)) * T + (grow & (T - 1))) * HD) + (cb & 255); rstride = (size_t)HD * 2; }
                else if (pn < 16) { dst = (unsigned char*)(QKV + (size_t)grow * 4096 + pn * 256) + cb; rstride = (size_t)4096 * 2; }
                else { dst = (unsigned char*)(GMb + (size_t)grow * 4096 + (pn - 16) * 256) + cb; rstride = (size_t)4096 * 2; }
                *(u32x4*)dst = ra; *(u32x4*)(dst + 2 * rstride) = rb; }
        } else {
            if (wc == 0) {
#pragma unroll
                for (int ai = 0; ai < 2; ++ai)
#pragma unroll
                    for (int m = 0; m < 4; ++m) { const int row = row0 + ai * HALF + m * 16; const float rstd = rsqrtf((float)rq[ai][m] * sc + NORM_EPS) * wscale;
                        const f32x4 v0 = acc[ai][0][m][0] * rstd, v1 = acc[ai][0][m][1] * rstd; u32x4 w;
                        w.x = cvt_pk_bf16(fast_sigmoid(v0[0]), fast_sigmoid(v0[1])); w.y = cvt_pk_bf16(fast_sigmoid(v0[2]), fast_sigmoid(v0[3]));
                        w.z = cvt_pk_bf16(fast_sigmoid(v1[0]), fast_sigmoid(v1[1])); w.w = cvt_pk_bf16(fast_sigmoid(v1[2]), fast_sigmoid(v1[3]));
                        *(u32x4*)(NGb + (size_t)row * 32 + 8 * fq) = w; }
            }
        }
    }
};
struct EpiCmp1 {
    static constexpr bool PERM = true;
    bf16_t* H; const long long* bias;
    __device__ __forceinline__ bool keep(const Unit&) const { return false; }
    __device__ __forceinline__ void operator()(const Acc& acc, const Unit& u, int wr, int wc, int fr, int fq) const {
        const int row0 = u.pm * BM + wr * 64 + fr, col0 = wc * 32 + 8 * fq;
        f32x4 bv[2][2];
#pragma unroll
        for (int bj = 0; bj < 2; ++bj)
#pragma unroll
            for (int n = 0; n < 2; ++n) { const long long* bp = bias + col0 + bj * HALF + 4 * n; bv[bj][n] = f32x4{(float)bp[0], (float)bp[1], (float)bp[2], (float)bp[3]} * (1.0f / CB_SCALE); }
#pragma unroll
        for (int ai = 0; ai < 2; ++ai)
#pragma unroll
            for (int m = 0; m < 4; ++m) { bf16_t* rowp = H + (size_t)(row0 + ai * HALF + m * 16) * 256 + col0;
#pragma unroll
                for (int bj = 0; bj < 2; ++bj) { f32x4 v0 = acc[ai][bj][m][0] + bv[bj][0], v1 = acc[ai][bj][m][1] + bv[bj][1];
#pragma unroll
                    for (int j = 0; j < 4; ++j) { v0[j] = v0[j] * fast_sigmoid(v0[j]); v1[j] = v1[j] * fast_sigmoid(v1[j]); }
                    u32x4 w; w.x = cvt_pk_bf16(v0[0], v0[1]); w.y = cvt_pk_bf16(v0[2], v0[3]); w.z = cvt_pk_bf16(v1[0], v1[1]); w.w = cvt_pk_bf16(v1[2], v1[3]);
                    *(u32x4*)(rowp + bj * HALF) = w; } }
    }
};
struct EpiCmp2 {
    static constexpr bool PERM = true;
    bf16_t* O;
    __device__ __forceinline__ bool keep(const Unit&) const { return false; }
    __device__ __forceinline__ void operator()(const Acc& acc, const Unit& u, int wr, int wc, int fr, int fq) const {
        const int row0 = u.pm * BM + wr * 64 + fr, col0 = wc * 32 + 8 * fq;
#pragma unroll
        for (int ai = 0; ai < 2; ++ai)
#pragma unroll
            for (int m = 0; m < 4; ++m) { const int row = row0 + ai * HALF + m * 16; const float z = ((row & 255) == 255) ? 0.f : 1.f;
                const f32x4 v0 = acc[ai][0][m][0] * z, v1 = acc[ai][0][m][1] * z;
                u32x4 w; w.x = cvt_pk_bf16(v0[0], v0[1]); w.y = cvt_pk_bf16(v0[2], v0[3]); w.z = cvt_pk_bf16(v1[0], v1[1]); w.w = cvt_pk_bf16(v1[2], v1[3]);
                *(u32x4*)(O + (size_t)row * HD + col0) = w; }
    }
};
struct EpiMerge {
    static constexpr bool PERM = true;
    const bf16_t* GMb; unsigned char* Z; float zscale;
    __device__ __forceinline__ bool keep(const Unit& u) const { return u.aux == 0; }
    __device__ __forceinline__ void operator()(Acc& acc, const Unit& u, int wr, int wc, int fr, int fq) const {
        const int row0 = u.pm * BM + wr * 64 + fr, col0 = u.pn * BM + wc * 32 + 8 * fq;
        if (u.aux == 0) {
#pragma unroll
            for (int ai = 0; ai < 2; ++ai)
#pragma unroll
                for (int m = 0; m < 4; ++m) { const int row = row0 + ai * HALF + m * 16;
#pragma unroll
                    for (int bj = 0; bj < 2; ++bj) { const int col = col0 + bj * HALF;
                        const u32x4 g1 = *(const u32x4*)(GMb + (size_t)row * 4096 + 2048 + col), g0 = *(const u32x4*)(GMb + (size_t)row * 4096 + col);
                        const f32x4 g1a = {bf_lo(g1.x), bf_hi(g1.x), bf_lo(g1.y), bf_hi(g1.y)}, g1b = {bf_lo(g1.z), bf_hi(g1.z), bf_lo(g1.w), bf_hi(g1.w)};
                        const f32x4 g0a = {bf_lo(g0.x), bf_hi(g0.x), bf_lo(g0.y), bf_hi(g0.y)}, g0b = {bf_lo(g0.z), bf_hi(g0.z), bf_lo(g0.w), bf_hi(g0.w)};
#pragma unroll
                        for (int j = 0; j < 4; ++j) { acc[ai][bj][m][0][j] *= g0a[j] * __builtin_amdgcn_rcpf(fmaxf(g1a[j], 1e-30f)); acc[ai][bj][m][1][j] *= g0b[j] * __builtin_amdgcn_rcpf(fmaxf(g1b[j], 1e-30f)); } } }
        } else {
            u32x4 gc[2], gn[2];
#pragma unroll
            for (int bj = 0; bj < 2; ++bj) gc[bj] = *(const u32x4*)(GMb + (size_t)row0 * 4096 + 2048 + col0 + bj * HALF);
#pragma unroll
            for (int g = 0; g < 8; ++g) { const int ai = g >> 2, m = g & 3, row = row0 + ai * HALF + m * 16;
                if (g < 7) { const int rn = row0 + ((g + 1) >> 2) * HALF + ((g + 1) & 3) * 16;
#pragma unroll
                    for (int bj = 0; bj < 2; ++bj) gn[bj] = *(const u32x4*)(GMb + (size_t)rn * 4096 + 2048 + col0 + bj * HALF); }
#pragma unroll
                for (int bj = 0; bj < 2; ++bj) { const u32x4 g1 = gc[bj];
                    const f32x4 g1a = {bf_lo(g1.x), bf_hi(g1.x), bf_lo(g1.y), bf_hi(g1.y)}, g1b = {bf_lo(g1.z), bf_hi(g1.z), bf_lo(g1.w), bf_hi(g1.w)};
                    const f32x4 v0 = acc[ai][bj][m][0] * g1a * zscale, v1 = acc[ai][bj][m][1] * g1b * zscale;
                    u32x2 w; w.x = cvt4_fp8(v0[0], v0[1], v0[2], v0[3]); w.y = cvt4_fp8(v1[0], v1[1], v1[2], v1[3]);
                    *(u32x2*)(Z + (size_t)row * D + col0 + bj * HALF) = w; }
                gc[0] = gn[0]; gc[1] = gn[1]; }
        }
    }
};
struct EpiResid {
    static constexpr bool PERM = true;
    const void* xin; int xin16; bf16_t* XB; u64* rsq_out; unsigned char* X8; float ascale;
    __device__ __forceinline__ bool keep(const Unit&) const { return false; }
    __device__ __forceinline__ void ldx(size_t off, f32x4& a, f32x4& b) const {
        if (xin16) { const u32x4 w = *(const u32x4*)((const bf16_t*)xin + off); a = f32x4{bf_lo(w.x), bf_hi(w.x), bf_lo(w.y), bf_hi(w.y)}; b = f32x4{bf_lo(w.z), bf_hi(w.z), bf_lo(w.w), bf_hi(w.w)}; }
        else { a = *(const f32x4*)((const float*)xin + off); b = *(const f32x4*)((const float*)xin + off + 4); } }
    __device__ __forceinline__ void operator()(const Acc& acc, const Unit& u, int wr, int wc, int fr, int fq) const {
        const int row0 = u.pm * BM + wr * 64 + fr, col0 = u.pn * BM + wc * 32 + 8 * fq;
        f32x4 xc[2][2], xn[2][2];
#pragma unroll
        for (int bj = 0; bj < 2; ++bj) ldx((size_t)row0 * D + col0 + bj * HALF, xc[bj][0], xc[bj][1]);
#pragma unroll
        for (int g = 0; g < 8; ++g) { const int ai = g >> 2, m = g & 3, row = row0 + ai * HALF + m * 16; const size_t off = (size_t)row * D + col0; float ss = 0.f;
            if (g < 7) { const size_t offn = (size_t)(row0 + ((g + 1) >> 2) * HALF + ((g + 1) & 3) * 16) * D + col0;
#pragma unroll
                for (int bj = 0; bj < 2; ++bj) ldx(offn + bj * HALF, xn[bj][0], xn[bj][1]); }
#pragma unroll
            for (int bj = 0; bj < 2; ++bj) { const size_t o = off + bj * HALF; const f32x4 x0 = xc[bj][0] + acc[ai][bj][m][0] * ascale, x1 = xc[bj][1] + acc[ai][bj][m][1] * ascale;
                { u32x4 w; w.x = cvt_pk_bf16(x0[0], x0[1]); w.y = cvt_pk_bf16(x0[2], x0[3]); w.z = cvt_pk_bf16(x1[0], x1[1]); w.w = cvt_pk_bf16(x1[2], x1[3]); *(u32x4*)(XB + o) = w; }
                if (X8) { u32x2 w; w.x = cvt4_fp8(x0[0], x0[1], x0[2], x0[3]); w.y = cvt4_fp8(x1[0], x1[1], x1[2], x1[3]); *(u32x2*)(X8 + o) = w; }
                ss += (x0[0] * x0[0] + x0[1] * x0[1]) + (x0[2] * x0[2] + x0[3] * x0[3]) + (x1[0] * x1[0] + x1[1] * x1[1]) + (x1[2] * x1[2] + x1[3] * x1[3]); }
            ss += __shfl_xor(ss, 16); ss += __shfl_xor(ss, 32);
            if (fq == 0) atomicAdd(rsq_out + row, (u64)(ss * RSQ_SCALE + 0.5f));
#pragma unroll
            for (int bj = 0; bj < 2; ++bj)
#pragma unroll
                for (int n = 0; n < 2; ++n) xc[bj][n] = xn[bj][n]; }
    }
};
template <bool MOE, bool OUT8 = MOE, bool W8 = MOE> struct EpiGateUp {
    static constexpr bool PERM = true;
    bf16_t* ACT; const u64* rsq; const int* ltok; const volatile LAS unsigned* misc;
    __device__ __forceinline__ bool keep(const Unit&) const { return false; }
    __device__ __forceinline__ void operator()(const Acc& acc, const Unit& u, int wr, int wc, int fr, int fq) const {
        const int row0 = u.pm * BM + wr * 64 + fr, col0 = u.pn * 128 + wc * 32 + 8 * fq;
        int cnt = 0, r0 = 0; if (MOE) { cnt = (int)misc[8 + u.aux]; r0 = (u.pm - (int)misc[16 + u.aux]) * BM + wr * 64 + fr; }
        int srow[2][4]; u64 rq[2][4];
#pragma unroll
        for (int ai = 0; ai < 2; ++ai)
#pragma unroll
            for (int m = 0; m < 4; ++m) { srow[ai][m] = row0 + ai * HALF + m * 16; if (MOE) { const int r = r0 + ai * HALF + m * 16; srow[ai][m] = r < cnt ? ltok[u.aux * M + r] : 0; } }
#pragma unroll
        for (int ai = 0; ai < 2; ++ai)
#pragma unroll
            for (int m = 0; m < 4; ++m) rq[ai][m] = rsq[srow[ai][m]];
#pragma unroll
        for (int ai = 0; ai < 2; ++ai)
#pragma unroll
            for (int m = 0; m < 4; ++m) { const int row = row0 + ai * HALF + m * 16;
                const float rstd = rsqrtf((float)rq[ai][m] * (1.0f / (RSQ_SCALE * D)) + NORM_EPS) * (W8 ? 1.0f / WGU8_SCALE : 1.0f);
                f32x4 a[2];
#pragma unroll
                for (int n = 0; n < 2; ++n) { const f32x4 g = acc[ai][0][m][n] * rstd, up = acc[ai][1][m][n] * rstd;
#pragma unroll
                    for (int j = 0; j < 4; ++j) a[n][j] = g[j] * fast_sigmoid(g[j]) * up[j]; }
                if (OUT8) { u32x2 w; w.x = cvt4_fp8(a[0][0], a[0][1], a[0][2], a[0][3]); w.y = cvt4_fp8(a[1][0], a[1][1], a[1][2], a[1][3]); *(u32x2*)((unsigned char*)ACT + (size_t)row * FF + col0) = w; }
                else { u32x4 w; w.x = cvt_pk_bf16(a[0][0], a[0][1]); w.y = cvt_pk_bf16(a[0][2], a[0][3]); w.z = cvt_pk_bf16(a[1][0], a[1][1]); w.w = cvt_pk_bf16(a[1][2], a[1][3]); *(u32x4*)(ACT + (size_t)row * FF + col0) = w; } }
    }
};
struct EpiMoeDown {
    static constexpr bool PERM = true;
    bf16_t* YS; const float* lw; const volatile LAS unsigned* misc;
    __device__ __forceinline__ bool keep(const Unit&) const { return false; }
    __device__ __forceinline__ void operator()(const Acc& acc, const Unit& u, int wr, int wc, int fr, int fq) const {
        const int row0 = u.pm * BM + wr * 64 + fr, col0 = u.pn * BM + wc * 32 + 8 * fq;
        const int cnt = (int)misc[8 + u.aux], r0 = (u.pm - (int)misc[16 + u.aux]) * BM + wr * 64 + fr;
        float wg[2][4];
#pragma unroll
        for (int ai = 0; ai < 2; ++ai)
#pragma unroll
            for (int m = 0; m < 4; ++m) { const int r = r0 + ai * HALF + m * 16; wg[ai][m] = r < cnt ? lw[u.aux * M + r] * (1.0f / WD8_SCALE) : 0.f; }
#pragma unroll
        for (int ai = 0; ai < 2; ++ai)
#pragma unroll
            for (int m = 0; m < 4; ++m) { const int row = row0 + ai * HALF + m * 16; const float wgt = wg[ai][m];
#pragma unroll
                for (int bj = 0; bj < 2; ++bj) { const f32x4 v0 = acc[ai][bj][m][0] * wgt, v1 = acc[ai][bj][m][1] * wgt;
                    u32x4 w; w.x = cvt_pk_bf16(v0[0], v0[1]); w.y = cvt_pk_bf16(v0[2], v0[3]); w.z = cvt_pk_bf16(v1[0], v1[1]); w.w = cvt_pk_bf16(v1[2], v1[3]);
                    *(u32x4*)(YS + (size_t)row * D + col0 + bj * HALF) = w; } }
    }
};
struct EpiMoeDownTail {
    static constexpr bool PERM = true;
    bf16_t* YT; const float* lw; const volatile LAS unsigned* misc;
    __device__ __forceinline__ bool keep(const Unit&) const { return false; }
    __device__ __forceinline__ void operator()(const Acc& acc, const Unit& u, int wr, int wc, int fr, int fq) const {
        const int e = u.aux & 255, part = u.aux >> 8, Tm = (int)misc[25];
        const int row0 = (u.pm - Tm) * BM + wr * 64 + fr, col0 = u.pn * BM + wc * 32 + 8 * fq;
        const int cnt = (int)misc[8 + e], r0 = (u.pm - (int)misc[16 + e]) * BM + wr * 64 + fr;
        float wg[2][4];
#pragma unroll
        for (int ai = 0; ai < 2; ++ai)
#pragma unroll
            for (int m = 0; m < 4; ++m) { const int r = r0 + ai * HALF + m * 16; wg[ai][m] = r < cnt ? lw[e * M + r] * (1.0f / WD8_SCALE) : 0.f; }
        bf16_t* Y = YT + (size_t)part * YT_ROWS * D;
#pragma unroll
        for (int ai = 0; ai < 2; ++ai)
#pragma unroll
            for (int m = 0; m < 4; ++m) { const int row = row0 + ai * HALF + m * 16; const float wgt = wg[ai][m];
#pragma unroll
                for (int bj = 0; bj < 2; ++bj) { const f32x4 v0 = acc[ai][bj][m][0] * wgt, v1 = acc[ai][bj][m][1] * wgt;
                    u32x4 w; w.x = cvt_pk_bf16(v0[0], v0[1]); w.y = cvt_pk_bf16(v0[2], v0[3]); w.z = cvt_pk_bf16(v1[0], v1[1]); w.w = cvt_pk_bf16(v1[2], v1[3]);
                    *(u32x4*)(Y + (size_t)row * D + col0 + bj * HALF) = w; } }
    }
};
}

namespace att {
constexpr float SCALE = 0.08838834764831845f, LOG2E = 1.4426950408889634f, C2 = LOG2E * SCALE, THR = 8.f;
constexpr int TILE_B = 16384;
#define KSWZ(row, colB) ((row) * 256 + ((colB) ^ (((row) & 7) << 4)))
#define SBAR() __builtin_amdgcn_sched_barrier(0)
__device__ __forceinline__ int v_st(int k, int c) { const int kk = (k & ~0xC) | ((k & 4) << 1) | ((k & 8) >> 1); return ((kk >> 3) * 4 + (c >> 5)) * 512 + ((kk & 7) * 32 + (c & 31)) * 2; }
__device__ __forceinline__ int v_rd_base(int lane) { return ((lane & 3) << 3) | (((lane >> 2) & 3) << 6) | (((lane >> 4) & 1) << 5) | (((lane >> 5) & 1) << 8); }
constexpr int v_rd_off(int d0, int ks, int half) { return d0 * 512 + ks * 4096 + half * 2048; }
__device__ __forceinline__ int crow(int r, int hi) { return (r & 3) + 8 * (r >> 2) + 4 * hi; }

__device__ __forceinline__ void mask_tile(f32x16& p0, f32x16& p1, int dq, unsigned W) {
    const float NEG = -__builtin_inff();
#pragma unroll
    for (int r = 0; r < 16; ++r) { const int c = (r & 3) + 8 * (r >> 2);
        if ((unsigned)(dq - c) >= W) p0[r] = NEG;
        if ((unsigned)(dq - c - 32) >= W) p1[r] = NEG; }
}
__device__ __forceinline__ void mask_all(f32x16& p0, f32x16& p1, bool keep) {
    const float NEG = -__builtin_inff();
#pragma unroll
    for (int r = 0; r < 16; ++r) { p0[r] = keep ? p0[r] : NEG; p1[r] = keep ? p1[r] : NEG; }
}
__device__ __forceinline__ float rowmax32(const f32x16& p0, const f32x16& p1) {
    float pmax = p0[0];
#pragma unroll
    for (int r = 1; r < 16; ++r) pmax = fmaxf(pmax, p0[r]);
#pragma unroll
    for (int r = 0; r < 16; ++r) pmax = fmaxf(pmax, p1[r]);
    auto rr = __builtin_amdgcn_permlane32_swap(__float_as_uint(pmax), __float_as_uint(pmax), false, false);
    return fmaxf(__uint_as_float(rr[0]), __uint_as_float(rr[1]));
}
__device__ __forceinline__ float rowsum32(const f32x16& p0, const f32x16& p1) {
    float ps = 0.f;
#pragma unroll
    for (int r = 0; r < 16; ++r) ps += p0[r];
#pragma unroll
    for (int r = 0; r < 16; ++r) ps += p1[r];
    auto rr = __builtin_amdgcn_permlane32_swap(__float_as_uint(ps), __float_as_uint(ps), false, false);
    return __uint_as_float(rr[0]) + __uint_as_float(rr[1]);
}
__device__ __forceinline__ void pack_p(const f32x16& p0, const f32x16& p1, bf16x8& pa0, bf16x8& pa1, bf16x8& pa2, bf16x8& pa3) {
#define PK4(P, B_, OUT) do { unsigned a0 = cvt_pk_bf16(P[B_+0], P[B_+1]), a1 = cvt_pk_bf16(P[B_+2], P[B_+3]);                          \
        unsigned b0 = cvt_pk_bf16(P[B_+4], P[B_+5]), b1 = cvt_pk_bf16(P[B_+6], P[B_+7]);                                             \
        auto r0 = __builtin_amdgcn_permlane32_swap(a0, b0, false, false); auto r1 = __builtin_amdgcn_permlane32_swap(a1, b1, false, false); \
        u32x4 w = {r0[0], r1[0], r0[1], r1[1]}; OUT = *reinterpret_cast<bf16x8*>(&w); } while (0)
    PK4(p0, 0, pa0); PK4(p0, 8, pa1); PK4(p1, 0, pa2); PK4(p1, 8, pa3);
#undef PK4
}
__device__ __forceinline__ void softmax_step(f32x16& p0, f32x16& p1, float& m_reg, float& l_reg, float& alpha) {
    const float pmax = rowmax32(p0, p1); float mn;
    if (__builtin_expect(__all((pmax - m_reg) * SCALE <= THR), 1)) { mn = m_reg; alpha = 1.f; }
    else { mn = fmaxf(m_reg, pmax); alpha = __builtin_amdgcn_exp2f((m_reg - mn) * C2); m_reg = mn; }
    const float mnL = -mn * C2;
#pragma unroll
    for (int r = 0; r < 16; ++r) { p0[r] = __builtin_amdgcn_exp2f(fmaf(p0[r], C2, mnL)); p1[r] = __builtin_amdgcn_exp2f(fmaf(p1[r], C2, mnL)); }
    l_reg = l_reg * alpha + rowsum32(p0, p1);
}
__device__ __forceinline__ void qkt(f32x16& p0, f32x16& p1, const LAS char* K_lds, int r32, int hi, const bf16x8* qr) {
    p0 = f32x16{}; p1 = f32x16{};
    const LAS char* kb[4];
#pragma unroll
    for (int dd = 0; dd < 4; ++dd) kb[dd] = K_lds + KSWZ(r32, (dd * 16 + hi * 8) * 2);
#pragma unroll
    for (int d0 = 0; d0 < 8; ++d0) { const LAS char* a = kb[d0 & 3] + (d0 >> 2) * 128;
        const bf16x8 b0 = *reinterpret_cast<const LAS bf16x8*>(a);
        const bf16x8 b1 = *reinterpret_cast<const LAS bf16x8*>(a + 32 * 256);
        p0 = __builtin_amdgcn_mfma_f32_32x32x16_bf16(b0, qr[d0], p0, 0, 0, 0);
        p1 = __builtin_amdgcn_mfma_f32_32x32x16_bf16(b1, qr[d0], p1, 0, 0, 0); }
}
__device__ __forceinline__ void pv_tile(f32x16* o, int vb0, bf16x8 pa0, bf16x8 pa1, bf16x8 pa2, bf16x8 pa3) {
#define TRRD(dst, off) asm volatile("ds_read_b64_tr_b16 %0, %1 offset:%2" : "=&v"(dst) : "v"(vb0), "i"(off) : "memory")
#define PV_D0(d0) do { s16x4 l0, l1, l2, l3, h0, h1, h2, h3; constexpr int b_ = v_rd_off(d0, 0, 0); \
        TRRD(l0, b_); TRRD(h0, b_ + 2048); TRRD(l1, b_ + 4096); TRRD(h1, b_ + 6144); TRRD(l2, b_ + 8192); TRRD(h2, b_ + 10240); TRRD(l3, b_ + 12288); TRRD(h3, b_ + 14336); \
        asm volatile("s_waitcnt lgkmcnt(0)" ::: "memory"); SBAR();   \
        o[d0] = __builtin_amdgcn_mfma_f32_32x32x16_bf16(pa0, (bf16x8){l0[0], l0[1], l0[2], l0[3], h0[0], h0[1], h0[2], h0[3]}, o[d0], 0, 0, 0);   \
        o[d0] = __builtin_amdgcn_mfma_f32_32x32x16_bf16(pa1, (bf16x8){l1[0], l1[1], l1[2], l1[3], h1[0], h1[1], h1[2], h1[3]}, o[d0], 0, 0, 0);   \
        o[d0] = __builtin_amdgcn_mfma_f32_32x32x16_bf16(pa2, (bf16x8){l2[0], l2[1], l2[2], l2[3], h2[0], h2[1], h2[2], h2[3]}, o[d0], 0, 0, 0);   \
        o[d0] = __builtin_amdgcn_mfma_f32_32x32x16_bf16(pa3, (bf16x8){l3[0], l3[1], l3[2], l3[3], h3[0], h3[1], h3[2], h3[3]}, o[d0], 0, 0, 0); } while (0)
    PV_D0(0); PV_D0(1); PV_D0(2); PV_D0(3);
#undef PV_D0
#undef TRRD
}

struct Ctx {
    int tid, wid, lane, r32, hi, sr, sc, kws, vst0, vst1, vb0;
    LAS char* K_lds; LAS char* V_lds; LAS float* wscr;
};
__device__ __forceinline__ Ctx make_ctx(LAS unsigned char* lds) {
    Ctx c; c.tid = opaque_tid(); c.wid = __builtin_amdgcn_readfirstlane(c.tid >> 6); c.lane = c.tid & 63; c.r32 = c.lane & 31; c.hi = c.lane >> 5;
    c.sr = c.tid >> 4; c.sc = (c.tid & 15) * 8; c.kws = KSWZ(c.sr, c.sc * 2); c.vst0 = v_st(c.sr, c.sc); c.vst1 = v_st(32 + c.sr, c.sc);
    c.K_lds = (LAS char*)(lds + LDS_K); c.V_lds = (LAS char*)(lds + LDS_V); c.wscr = (LAS float*)(lds + LDS_WSCR) + c.wid * 64;
    c.vb0 = (int)(unsigned)(uintptr_t)c.V_lds + v_rd_base(c.lane);
    return c;
}
__device__ __forceinline__ void glds16(const void* sbase, unsigned voff, unsigned lds_dst) { unsigned keep;
    asm volatile("s_mov_b32 %0, m0\n\ts_mov_b32 m0, %3\n\ts_nop 0\n\tglobal_load_lds_dwordx4 %1, %2\n\ts_mov_b32 m0, %0" : "=&s"(keep) : "v"(voff), "s"(sbase), "s"(lds_dst) : "memory"); }
__device__ __forceinline__ const void* uniform_ptr(const void* p) { const unsigned long long v = (unsigned long long)p; const unsigned lo = __builtin_amdgcn_readfirstlane((unsigned)v), hi = __builtin_amdgcn_readfirstlane((unsigned)(v >> 32));
    return (const void*)(GAS const void*)(((unsigned long long)hi << 32) | lo); }
struct Dma { unsigned ko[2], vo[2]; };
__device__ __forceinline__ Dma make_dma(const Ctx& c, int ldk, int ldv) {
    Dma d;
#pragma unroll
    for (int i = 0; i < 2; ++i) { const int p = c.wid * 2 + i, row = 4 * p + (c.lane >> 4); d.ko[i] = (unsigned)(row * ldk + (((c.lane & 15) ^ (row & 7)) * 8)) * 2u;
        const int st = 2 * p + (c.lane >> 5), kk = (st >> 2) * 8 + ((c.lane & 31) >> 2), k = (kk & ~0xC) | ((kk & 4) << 1) | ((kk & 8) >> 1); d.vo[i] = (unsigned)(k * ldv + (st & 3) * 32 + (c.lane & 3) * 8) * 2u; }
    return d;
}
__device__ __forceinline__ void dma_tile(const Ctx& c, const Dma& d, const bf16_t* Kg, int ldk, const bf16_t* Vg, int ldv, int key0, int slot) {
    const void* kb = uniform_ptr(Kg + (size_t)key0 * ldk); const void* vb = uniform_ptr(Vg + (size_t)key0 * ldv);
#pragma unroll
    for (int i = 0; i < 2; ++i) {
        glds16(kb, d.ko[i], (unsigned)__builtin_amdgcn_readfirstlane((int)(unsigned)(uintptr_t)(c.K_lds + slot * TILE_B + (c.wid * 2 + i) * 1024)));
        glds16(vb, d.vo[i], (unsigned)__builtin_amdgcn_readfirstlane((int)(unsigned)(uintptr_t)(c.V_lds + slot * TILE_B + (c.wid * 2 + i) * 1024))); }
}
#define ATT_BAR() do { asm volatile("s_waitcnt lgkmcnt(0)" ::: "memory"); __builtin_amdgcn_s_barrier(); asm volatile("" ::: "memory"); } while (0)
__device__ __forceinline__ void rescale_o(f32x16* o, float alpha, const Ctx& c) {
    if (__any(alpha < 1.f)) { if (c.hi == 0) c.wscr[32 + c.r32] = alpha; LDS_WAIT();
#pragma unroll
        for (int d = 0; d < 4; ++d)
#pragma unroll
            for (int r = 0; r < 16; ++r) o[d][r] *= c.wscr[32 + crow(r, c.hi)];
        LDS_WAIT(); }
}
template <int MODE>
__device__ __forceinline__ void attn_loop_simple(const Ctx& c, const bf16_t* Kg, int ldk, const bf16_t* Vg, int ldv, int j_lo, int NT, const bf16x8* qr,
                                          int qpos, int qlo, int W, unsigned sel_lo, unsigned sel_hi, int diag, f32x16* o, float& m_reg, float& l_reg) {
    f32x16 p0, p1; bf16x8 pa0, pa1, pa2, pa3; float alpha;
    const Dma d = make_dma(c, ldk, ldv);
    dma_tile(c, d, Kg, ldk, Vg, ldv, j_lo * 64, 0);
    if (NT > 1) dma_tile(c, d, Kg, ldk, Vg, ldv, j_lo * 64 + 64, 1);
    int slot = 0, slot2 = 2;
    for (int t = 0; t < NT; ++t) { const int jt = j_lo + t, kb_ = jt * 64, bo = slot * TILE_B;
        if (t + 1 < NT) asm volatile("s_waitcnt vmcnt(4)" ::: "memory"); else asm volatile("s_waitcnt vmcnt(0)" ::: "memory");
        ATT_BAR();
        if (t + 2 < NT) dma_tile(c, d, Kg, ldk, Vg, ldv, kb_ + 128, slot2);
        SBAR(); qkt(p0, p1, c.K_lds + bo, c.r32, c.hi, qr);
        if (MODE == 0) { if (kb_ + 63 > qlo || kb_ <= qlo + 31 - W) mask_tile(p0, p1, qpos - kb_ - 4 * c.hi, (unsigned)W); }
        else { const unsigned bit = (jt < 32 ? (sel_lo >> jt) : (sel_hi >> (jt - 32))) & 1u; mask_all(p0, p1, bit != 0u);
               if (jt == diag) mask_tile(p0, p1, qpos - kb_ - 4 * c.hi, 0x40000000u); }
        softmax_step(p0, p1, m_reg, l_reg, alpha); pack_p(p0, p1, pa0, pa1, pa2, pa3); rescale_o(o, alpha, c);
        pv_tile(o, c.vb0 + bo, pa0, pa1, pa2, pa3);
        slot = slot == 2 ? 0 : slot + 1; slot2 = slot2 == 2 ? 0 : slot2 + 1; }
    ATT_BAR();
}
template <int MODE>
__device__ __forceinline__ void attn_loop(const Ctx& c, const bf16_t* Kg, int ldk, const bf16_t* Vg, int ldv, int j_lo, int NT, const bf16x8* qr,
                                          int qpos, int qlo, int W, unsigned sel_lo, unsigned sel_hi, int diag, f32x16* o, float& m_reg, float& l_reg) {
    f32x16 pA0, pA1, pB0, pB1; bf16x8 pa0, pa1, pa2, pa3; float alpha;
    const Dma d = make_dma(c, ldk, ldv);
    dma_tile(c, d, Kg, ldk, Vg, ldv, j_lo * 64, 0);
    if (NT > 1) { dma_tile(c, d, Kg, ldk, Vg, ldv, j_lo * 64 + 64, 1); asm volatile("s_waitcnt vmcnt(4)" ::: "memory"); } else asm volatile("s_waitcnt vmcnt(0)" ::: "memory");
    ATT_BAR();
    if (NT > 2) dma_tile(c, d, Kg, ldk, Vg, ldv, j_lo * 64 + 128, 2);
    SBAR(); qkt(pA0, pA1, c.K_lds, c.r32, c.hi, qr);
#define ATT_STEP(PX0, PX1, PY0, PY1, t_) do { const int t = (t_), jt = j_lo + t, kb_ = jt * 64;                                          \
        if (t + 1 < NT) { if (t + 2 < NT) asm volatile("s_waitcnt vmcnt(4)" ::: "memory"); else asm volatile("s_waitcnt vmcnt(0)" ::: "memory"); }     \
        ATT_BAR();                                                                           \
        if (t + 3 < NT) dma_tile(c, d, Kg, ldk, Vg, ldv, kb_ + 192, (t + 3) & 3);                           \
        SBAR(); if (t + 1 < NT) qkt(PY0, PY1, c.K_lds + ((t + 1) & 3) * TILE_B, c.r32, c.hi, qr);          \
        SBAR();                                                                                  \
        if (MODE == 0) { if (kb_ + 63 > qlo || kb_ <= qlo + 31 - W) mask_tile(PX0, PX1, qpos - kb_ - 4 * c.hi, (unsigned)W); }            \
        else { const unsigned bit = (jt < 32 ? (sel_lo >> jt) : (sel_hi >> (jt - 32))) & 1u; mask_all(PX0, PX1, bit != 0u);               \
               if (jt == diag) mask_tile(PX0, PX1, qpos - kb_ - 4 * c.hi, 0x40000000u); }                                                \
        softmax_step(PX0, PX1, m_reg, l_reg, alpha); pack_p(PX0, PX1, pa0, pa1, pa2, pa3); rescale_o(o, alpha, c);                        \
        pv_tile(o, c.vb0 + (t & 3) * TILE_B, pa0, pa1, pa2, pa3); } while (0)
    for (int t2 = 0; t2 < NT; t2 += 2) { ATT_STEP(pA0, pA1, pB0, pB1, t2); if (t2 + 1 < NT) ATT_STEP(pB0, pB1, pA0, pA1, t2 + 1); }
#undef ATT_STEP
    ATT_BAR();
}
__device__ __forceinline__ void load_q(bf16x8* qr, const bf16_t* qrow, int hi) {
#pragma unroll
    for (int d0 = 0; d0 < 8; ++d0) qr[d0] = *(const bf16x8*)(qrow + d0 * 16 + hi * 8);
    asm volatile("" :: "v"(qr[0]), "v"(qr[1]), "v"(qr[2]), "v"(qr[3]), "v"(qr[4]), "v"(qr[5]), "v"(qr[6]), "v"(qr[7]));
}
template <bool ADD, bool OUT8 = false>
__device__ __forceinline__ void store_o(const f32x16* o, float frow, const Ctx& c, bf16_t* Og, int ldo, float fold_row = 1.0f, bool has_fold = false, unsigned char* O8 = nullptr) {
    if (c.hi == 0) { c.wscr[c.r32] = frow; c.wscr[32 + c.r32] = fold_row; } LDS_WAIT();
    LAS float* stg = (LAS float*)(c.K_lds + c.wid * 16384);
#pragma unroll
    for (int r = 0; r < 16; ++r) { const int row = crow(r, c.hi); const float f = c.wscr[row];
#pragma unroll
        for (int d0 = 0; d0 < 4; ++d0) stg[row * 128 + d0 * 32 + c.r32] = o[d0][r] * f; }
    LDS_WAIT();
    const int cc = c.lane & 15, rq = c.lane >> 4;
#pragma unroll
    for (int hb = 0; hb < 8; hb += 4) {
        int hbv = hb; asm volatile("" : "+v"(hbv));
        u32x4 old[4];
        if (ADD) {
#pragma unroll
            for (int i = 0; i < 4; ++i) old[i] = *(const u32x4*)(Og + (size_t)(rq + 4 * (hbv + i)) * 1024 + cc * 8);
        }
#pragma unroll
        for (int i = 0; i < 4; ++i) { const int row = rq + 4 * (hbv + i);
            f32x4 v0 = *(const LAS f32x4*)(stg + row * 128 + cc * 8), v1 = *(const LAS f32x4*)(stg + row * 128 + cc * 8 + 4);
            if (ADD) { const float fo = has_fold ? c.wscr[32 + row] : 1.0f;
                v0[0] = fmaf(bf_lo(old[i].x), fo, v0[0]); v0[1] = fmaf(bf_hi(old[i].x), fo, v0[1]); v0[2] = fmaf(bf_lo(old[i].y), fo, v0[2]); v0[3] = fmaf(bf_hi(old[i].y), fo, v0[3]);
                v1[0] = fmaf(bf_lo(old[i].z), fo, v1[0]); v1[1] = fmaf(bf_hi(old[i].z), fo, v1[1]); v1[2] = fmaf(bf_lo(old[i].w), fo, v1[2]); v1[3] = fmaf(bf_hi(old[i].w), fo, v1[3]); }
            if constexpr (OUT8) { u32x2 w; w.x = cvt4_fp8(v0[0] * O8_SCALE, v0[1] * O8_SCALE, v0[2] * O8_SCALE, v0[3] * O8_SCALE); w.y = cvt4_fp8(v1[0] * O8_SCALE, v1[1] * O8_SCALE, v1[2] * O8_SCALE, v1[3] * O8_SCALE);
                *(u32x2*)(O8 + (size_t)row * ldo + cc * 8) = w; }
            else { u32x4 w; w.x = cvt_pk_bf16(v0[0], v0[1]); w.y = cvt_pk_bf16(v0[2], v0[3]); w.z = cvt_pk_bf16(v1[0], v1[1]); w.w = cvt_pk_bf16(v1[2], v1[3]);
                *(u32x4*)(Og + (size_t)row * ldo + cc * 8) = w; } }
        asm volatile("" ::: "memory");
    }
    LDS_WAIT();
}
}

struct Frame {
    LAS unsigned char* lds; volatile LAS unsigned* misc; unsigned* ctl;
    int tid, lane, wave, G, vcu;
    const float* const* in; float* out; unsigned char* ws;
};
__device__ __forceinline__ void launder(Frame& F) { unsigned long long w_ = (unsigned long long)F.ws; asm volatile("" : "+s"(w_)); F.ws = (unsigned char*)(GAS unsigned char*)w_; F.out = (float*)(GAS float*)F.out; F.ctl = (unsigned*)(GAS unsigned*)F.ctl; asm volatile("" : "+v"(F.tid)); F.lane = F.tid & 63; F.wave = __builtin_amdgcn_readfirstlane(F.tid >> 6); }
enum { IN_X = 0, IN_ANORM, IN_WIN, IN_SINK, IN_PEK, IN_PEV, IN_WK1, IN_WK2, IN_WV1, IN_WV2, IN_WUPA, IN_WUPB, IN_WO, IN_FNORM, IN_DWG, IN_DWU, IN_DWD, IN_RW, IN_MWG, IN_MWU, IN_MWD, IN_FINAL };
#define INP(i) ((const float*)(const GAS float*)F.in[i])
#define WSP(T_, off) ((T_*)(F.ws + (off)))
#define BGP(T_, off) ((T_*)(F.ws + WS_BIG + (off)))

__device__ __forceinline__ int queue_pop(Frame& F, int q) {
    __syncthreads();
    if (F.tid == 0) F.misc[2] = __hip_atomic_fetch_add(F.ctl + CW_QUEUE + 64 * q, 1u, RLX_AGENT);
    __syncthreads();
    return (int)F.misc[2];
}

__device__ __forceinline__ int tr_drow(int mode, int n, int nn) {
    if (mode == 0) return n;
    if (mode == 1) { if (n < 4096) { const int d = n & 127; return (n & ~127) + 32 * ((d >> 4) & 3) + 8 * ((d >> 2) & 3) + 4 * (d >> 6) + (d & 3); }
                     return n < 4120 ? 8192 + (n - 4096) : 4096 + (n - 4120); }
    return 256 * (n >> 7) + 128 * nn + (n & 127);
}
__device__ __forceinline__ void tr_item(int mode, int nn, const float* W, int ld, int nsrc, const float* gain, int K, bf16_t* WT, int item, int nblk, int lane) {
    const int kb = item / nblk, nb = item - kb * nblk, kg = lane & 7, nq = lane >> 3, k0 = 64 * kb + 8 * kg, n = 32 * nb + 4 * nq;
    if (n >= nsrc) return;
    const float* p = W + (size_t)k0 * ld + n; f32x4 v[8];
#pragma unroll
    for (int j = 0; j < 8; ++j) v[j] = __builtin_nontemporal_load((const f32x4*)(p + (size_t)j * ld));
    if (gain) { const f32x4 g0 = *(const f32x4*)(gain + k0), g1 = *(const f32x4*)(gain + k0 + 4);
#pragma unroll
        for (int j = 0; j < 4; ++j) { v[j] = v[j] * g0[j]; v[4 + j] = v[4 + j] * g1[j]; } }
    const int c = tr_drow(mode, n, nn);
#pragma unroll
    for (int q = 0; q < 4; ++q) { u32x4 o; o.x = cvt_pk_bf16(v[0][q], v[1][q]); o.y = cvt_pk_bf16(v[2][q], v[3][q]); o.z = cvt_pk_bf16(v[4][q], v[5][q]); o.w = cvt_pk_bf16(v[6][q], v[7][q]);
        *(u32x4*)(WT + (size_t)(c + q) * K + k0) = o; }
}
__device__ __forceinline__ void tr_item8(int mode, int nn, const float* W, int ld, int nsrc, const float* gain, float scale, int K, unsigned char* WT, int item, int nblk, int lane) {
    const int kb = item / nblk, nb = item - kb * nblk, kg = lane & 7, nq = lane >> 3, k0 = 128 * kb + 16 * kg, n = 32 * nb + 4 * nq;
    if (n >= nsrc) return;
    const float* p = W + (size_t)k0 * ld + n; f32x4 v[16];
#pragma unroll
    for (int j = 0; j < 16; ++j) v[j] = __builtin_nontemporal_load((const f32x4*)(p + (size_t)j * ld));
#pragma unroll
    for (int j4 = 0; j4 < 4; ++j4) { f32x4 g = {scale, scale, scale, scale}; if (gain) g = *(const f32x4*)(gain + k0 + 4 * j4) * scale;
#pragma unroll
        for (int j = 0; j < 4; ++j) v[4 * j4 + j] = v[4 * j4 + j] * g[j]; }
    const int c = tr_drow(mode, n, nn);
#pragma unroll
    for (int q = 0; q < 4; ++q) { u32x4 o; o.x = cvt4_fp8(v[0][q], v[1][q], v[2][q], v[3][q]); o.y = cvt4_fp8(v[4][q], v[5][q], v[6][q], v[7][q]); o.z = cvt4_fp8(v[8][q], v[9][q], v[10][q], v[11][q]); o.w = cvt4_fp8(v[12][q], v[13][q], v[14][q], v[15][q]);
        __builtin_nontemporal_store(o, (u32x4*)(WT + (size_t)(c + q) * K + k0)); }
}
__device__ __forceinline__ void p_prologue(Frame F) {
    launder(F);
    const int gw = F.vcu * NWAVES + F.wave, NGW = F.G * NWAVES, lane = F.lane;
    constexpr int NB_IN = (IN_DIM + 31) / 32;
    { long long* cb = WSP(long long, WS_CBIAS);
      for (int u = gw; u < 1024; u += NGW) { const int q = u >> 8, l = q >> 1, kv = q & 1, nb = (u >> 6) & 3, kc = u & 63, n = nb * 64 + lane;
          const float* pe = INP(kv ? IN_PEV : IN_PEK) + (size_t)l * 4096 + kc * 64; const float* w1 = INP(kv ? IN_WV1 : IN_WK1) + (size_t)l * 4096 * 256 + (size_t)kc * 64 * 256 + n;
          float wv[64];
#pragma unroll
          for (int k = 0; k < 64; ++k) wv[k] = w1[(size_t)k * 256];
          float a0 = 0.f, a1 = 0.f, a2 = 0.f, a3 = 0.f;
#pragma unroll
          for (int k = 0; k < 64; k += 4) { a0 = fmaf(pe[k], wv[k], a0); a1 = fmaf(pe[k + 1], wv[k + 1], a1); a2 = fmaf(pe[k + 2], wv[k + 2], a2); a3 = fmaf(pe[k + 3], wv[k + 3], a3); }
          const float sum = (a0 + a1) + (a2 + a3);
          atomicAdd((unsigned long long*)(cb + q * 256 + n), (unsigned long long)(long long)rintf(sum * CB_SCALE)); } }
    constexpr int I_WIN = (D / 128) * NB_IN, I_W1 = (4096 / 64) * (256 / 32), I_W2 = (256 / 64) * (128 / 32), I_WUP = (1024 / 128) * (D / 32), I_WO = (D / 128) * (D / 32);
    {   constexpr int BI_G = (D / 128) * (FF / 256), BI_D = (FF / 128) * (D / 256), NBI = 16 * BI_G + 8 * BI_D;
        LAS unsigned char* tile = F.lds;
        for (int bi = F.vcu; bi < NBI; bi += F.G) {
            const float* W; const float* gain = nullptr; float scale; unsigned char* dst; int ld, Kd, mode = 0, nn = 0, kb, nb;
            if (bi < 16 * BI_G) { const int q = bi / BI_G, r = bi - q * BI_G, e = q >> 1; nn = q & 1; mode = 2; W = INP(nn ? IN_MWU : IN_MWG) + (size_t)e * D * FF; ld = FF; gain = INP(IN_FNORM) + D; scale = WGU8_SCALE;
                dst = WSP(unsigned char, WS_WGUM + (size_t)e * SZ_WGU8); Kd = D; kb = r / (FF / 256); nb = r - kb * (FF / 256); }
            else { const int r0 = bi - 16 * BI_G, e = r0 / BI_D, r = r0 - e * BI_D; ld = D; scale = WD8_SCALE;
                if (e < 8) { W = INP(IN_MWD) + (size_t)e * FF * D; dst = WSP(unsigned char, WS_WDM + (size_t)e * SZ_WD8); } else { W = INP(IN_DWD); dst = WSP(unsigned char, WS_WDD); }
                Kd = FF; kb = r / (D / 256); nb = r - kb * (D / 256); }
            const int k0 = 128 * kb + 16 * F.wave, n = 256 * nb + 4 * lane;
            const float* p = W + (size_t)k0 * ld + n; f32x4 v[16];
#pragma unroll
            for (int j = 0; j < 16; ++j) v[j] = __builtin_nontemporal_load((const f32x4*)(p + (size_t)j * ld));
#pragma unroll
            for (int j = 0; j < 16; ++j) { const float g = gain ? gain[k0 + j] * scale : scale; v[j] = v[j] * g; }
#pragma unroll
            for (int q = 0; q < 4; ++q) { u32x4 o; o.x = cvt4_fp8(v[0][q], v[1][q], v[2][q], v[3][q]); o.y = cvt4_fp8(v[4][q], v[5][q], v[6][q], v[7][q]); o.z = cvt4_fp8(v[8][q], v[9][q], v[10][q], v[11][q]); o.w = cvt4_fp8(v[12][q], v[13][q], v[14][q], v[15][q]);
                *(LAS u32x4*)(tile + (4 * lane + q) * 144 + 16 * F.wave) = o; }
            __syncthreads();
#pragma unroll
            for (int i = 0; i < 4; ++i) { const int nrow = 32 * F.wave + 8 * i + (lane >> 3), ch = lane & 7;
                const u32x4 o = *(const LAS u32x4*)(tile + nrow * 144 + 16 * ch);
                __builtin_nontemporal_store(o, (u32x4*)(dst + (size_t)tr_drow(mode, 256 * nb + nrow, nn) * Kd + 128 * kb + 16 * ch)); }
            __syncthreads();
        }
    }
    constexpr int I_G = (D / 64) * (FF / 32), I_DN = (FF / 64) * (D / 32);
    constexpr int NITEMS = 2 * I_WIN + 4 * I_W1 + 4 * I_W2 + 4 * I_WUP + 2 * I_WO + 2 * I_G + I_DN;
    for (int it = gw; it < NITEMS; it += NGW) {
        int r = it;
        if (r < 2 * I_G) { const int nn = r / I_G; r -= nn * I_G;
            tr_item(2, nn, INP(nn ? IN_DWU : IN_DWG), FF, FF, INP(IN_FNORM), D, WSP(bf16_t, WS_WGUD), r, FF / 32, lane); continue; } r -= 2 * I_G;
        if (r < I_DN) { tr_item(0, 0, INP(IN_DWD), D, D, nullptr, FF, WSP(bf16_t, WS_WDD), r, D / 32, lane); continue; } r -= I_DN;
        if (r < 2 * I_WIN) { const int l = r / I_WIN; r -= l * I_WIN;
            tr_item8(1, 0, INP(IN_WIN) + (size_t)l * D * IN_DIM, IN_DIM, IN_DIM, INP(IN_ANORM) + l * D, WIN8_SCALE, D, WSP(unsigned char, WS_WIN + l * SZ_WIN), r, NB_IN, lane); continue; } r -= 2 * I_WIN;
        if (r < 4 * I_W1) { const int q = r / I_W1; r -= q * I_W1; const int l = q >> 1, kv = q & 1;
            tr_item(0, 0, INP(kv ? IN_WV1 : IN_WK1) + (size_t)l * 4096 * 256, 256, 256, nullptr, 4096, WSP(bf16_t, WS_W1 + q * SZ_W1), r, 256 / 32, lane); continue; } r -= 4 * I_W1;
        if (r < 4 * I_W2) { const int q = r / I_W2; r -= q * I_W2; const int l = q >> 1, kv = q & 1;
            tr_item(0, 0, INP(kv ? IN_WV2 : IN_WK2) + (size_t)l * 256 * 128, 128, 128, nullptr, 256, WSP(bf16_t, WS_W2 + q * SZ_W2), r, 128 / 32, lane); continue; } r -= 4 * I_W2;
        if (r < 4 * I_WUP) { const int q = r / I_WUP; r -= q * I_WUP; const int l = q >> 1, ab = q & 1;
            tr_item8(0, 0, INP(ab ? IN_WUPB : IN_WUPA) + (size_t)l * 1024 * D, D, D, nullptr, WUP8_SCALE, 1024, WSP(unsigned char, WS_WUP + q * SZ_WUP), r, D / 32, lane); continue; } r -= 4 * I_WUP;
        { const int l = r / I_WO; r -= l * I_WO;
            tr_item8(0, 0, INP(IN_WO) + (size_t)l * D * D, D, D, nullptr, WO8_SCALE, D, WSP(unsigned char, WS_WO + l * SZ_WO), r, D / 32, lane); }
    }
    { const int gt = gw * 64 + lane, NGT = NGW * 64; const u32x4 z = {0u, 0u, 0u, 0u};
      for (int i = gt; i < 2 * (NIN - IN_DIM) * (D / 16); i += NGT) { const int l = i / ((NIN - IN_DIM) * (D / 16)), j = i - l * ((NIN - IN_DIM) * (D / 16)); *((u32x4*)(WSP(unsigned char, WS_WIN + l * SZ_WIN) + (size_t)IN_DIM * D) + j) = z; }
      for (int i = gt; i < 4 * 128 * (256 / 8); i += NGT) { const int q = i / (128 * 32), j = i - q * (128 * 32); *((u32x4*)(WSP(bf16_t, WS_W2 + q * SZ_W2) + (size_t)128 * 256) + j) = z; } }
    { const float* x = INP(IN_X); unsigned char* x8 = WSP(unsigned char, WS_X8); u64* rsq = WSP(u64, WS_RSQ);
      for (int m = gw; m < M; m += NGW) { const f32x4* xr = (const f32x4*)(x + (size_t)m * D) + lane; f32x4 v[8]; float s = 0.f;
#pragma unroll
          for (int j = 0; j < 8; ++j) { v[j] = xr[64 * j]; s += (v[j][0] * v[j][0] + v[j][1] * v[j][1]) + (v[j][2] * v[j][2] + v[j][3] * v[j][3]); }
          s = wave_sum(s); if (lane == 0) rsq[m] = (u64)(s * RSQ_SCALE + 0.5f);
          unsigned* o4 = (unsigned*)(x8 + (size_t)m * D) + lane;
#pragma unroll
          for (int j = 0; j < 8; ++j) o4[64 * j] = cvt4_fp8(v[j][0], v[j][1], v[j][2], v[j][3]); } }
    { float* cosT = WSP(float, WS_ROPE); float* sinT = cosT + T * 64; const int gt = gw * 64 + lane, NGT = NGW * 64;
      for (int i = gt; i < T * 64; i += NGT) { const int t = i >> 6, d = i & 63; const float inv = (float)exp(-9.210340371976184 * (double)d / 64.0); const float ang = (float)t * inv;
          cosT[i] = (float)cos((double)ang); sinT[i] = (float)sin((double)ang); } }
}

__device__ __forceinline__ void p_attn_a(Frame F, int layer) {
    launder(F);
    bf16_t* QKV = BGP(bf16_t, BG_QKV); const bf16_t* NGb = BGP(bf16_t, BG_NG);
#ifndef NO_CMP
    if (blockIdx.x < 16) {
        const int kv = blockIdx.x >> 3, pm = blockIdx.x & 7, q = layer * 2 + kv;
        bf16_t* H = BGP(bf16_t, BG_HC) + (size_t)kv * 2048 * 256;
        { pg8::SchedOne S{BGP(bf16_t, kv ? BG_VCB : BG_KCB), WSP(bf16_t, WS_W1 + q * SZ_W1), 2048 * 2, 4096 * 2, pm, 0};
          pg8::EpiCmp1 E{H, WSP(long long, WS_CBIAS) + q * 256};
          pg8::gemm_phase<false>(F.lds, 4096 * 2, S, E); }
        VM_WAIT(); __syncthreads(); __builtin_amdgcn_fence(__ATOMIC_ACQUIRE, "agent"); VM_WAIT(); __syncthreads();
        { pg8::SchedOne S{H, WSP(bf16_t, WS_W2 + q * SZ_W2), 256 * 2, 256 * 2, pm, 0};
          pg8::EpiCmp2 E{BGP(bf16_t, kv ? BG_VCMP : BG_KCMP)};
          pg8::gemm_phase<false>(F.lds, 256 * 2, S, E); }
        __syncthreads();
    }
#endif
    const att::Ctx c = att::make_ctx(F.lds);
    const float* sinks = INP(IN_SINK) + layer * 8;
    const int nstat = (int)F.G - 16; bool first = blockIdx.x >= 16;
    for (;;) {
        int u = first ? (int)blockIdx.x - 16 : nstat + queue_pop(F, layer * 2 + 0); first = false; if (u >= 1024 + 64) break;
        if (u < 64) {
            pg8::SchedOne S{WSP(unsigned char, WS_X8), WSP(unsigned char, WS_WIN + layer * SZ_WIN), D, D, u, 32};
            pg8::EpiIn E{BGP(bf16_t, BG_QKV), BGP(bf16_t, BG_KCB), BGP(bf16_t, BG_VCB), BGP(bf16_t, BG_GM), BGP(bf16_t, BG_NG), WSP(u64, WS_RSQ) + (2 * layer) * M, WSP(float, WS_ROPE), WSP(float, WS_ROPE) + T * 64, 1.0f / WIN8_SCALE, F.lds + LDS_WSCR};
            pg8::gemm_phase<true>(F.lds, D, S, E); __syncthreads(); continue; }
        u -= 64;
        const bool swa = u >= 512; const int v = u & 511, qt = 63 - (v >> 3), bg = v & 7, b = bg >> 1, g = bg & 1;
        const int t0 = qt * 64, h = 4 * g + (c.wid >> 1), trow = t0 + 32 * (c.wid & 1);
        const size_t rowbase = (size_t)b * T;
        const int qcol = (swa ? 0 : 1536) + h * HD, kcol = (swa ? 1024 : 3584) + g * HD, vcol = (swa ? 1280 : 3840) + g * HD, W = swa ? 128 : 512;
        bf16x8 qr[8]; att::load_q(qr, QKV + (rowbase + trow + c.r32) * 4096 + qcol, c.hi);
        const int j_lo = (t0 - W + 1) > 0 ? (t0 - W + 1) / 64 : 0, NT = qt - j_lo + 1;
        f32x16 o[4] = {}; float m_reg = -1e30f, l_reg = 0.f;
        att::attn_loop<0>(c, QKV + rowbase * 4096 + kcol, 4096, QKV + rowbase * 4096 + vcol, 4096, j_lo, NT, qr, trow + c.r32, trow, W, 0u, 0u, -1, o, m_reg, l_reg);
        float f;
        if (swa) { const float lt = l_reg + __builtin_amdgcn_exp2f(sinks[h] * att::LOG2E - m_reg * att::C2); f = 1.0f / lt; }
        else f = 1.0f / l_reg;
        if (swa) att::store_o<false, true>(o, f, c, nullptr, 1024, 1.0f, false, BGP(unsigned char, BG_OA) + (rowbase + trow) * 1024 + h * HD);
        else att::store_o<false>(o, f, c, BGP(bf16_t, BG_OB) + (rowbase + trow) * 1024 + h * HD, 1024);
    }
}

__device__ __forceinline__ void p_attn_b(Frame F, int layer) {
    launder(F);
    const bf16_t* QKV = BGP(bf16_t, BG_QKV); const bf16_t* NGb = BGP(bf16_t, BG_NG);
    const att::Ctx c = att::make_ctx(F.lds);
    LAS unsigned* IMP = (LAS unsigned*)(F.lds + LDS_IMP);
    volatile LAS unsigned* SELM = (volatile LAS unsigned*)(F.lds + LDS_SELM);
    bool first = true;
    for (;;) {
        const int u = first ? (int)blockIdx.x : (int)F.G + queue_pop(F, layer * 2 + 1); first = false; if (u >= 512) break;
        const int qt = 63 - (u >> 3), bg = u & 7, b = bg >> 1, g = bg & 1;
        const int t0 = qt * 64, h = 4 * g + (c.wid >> 1), trow = t0 + 32 * (c.wid & 1), tl = 32 * (c.wid & 1) + c.r32;
        const size_t rowbase = (size_t)b * T; const int pos = trow + c.r32;
        for (int i = c.tid; i < 64 * 65; i += NTHREADS) IMP[i] = 0u;
        bf16x8 qr[8]; att::load_q(qr, QKV + (rowbase + pos) * 4096 + 1536 + h * HD, c.hi);
        const int maxc = (t0 + 63 - 31) >> 4, NTc = (maxc >> 6) + 1;
        const bf16_t* Kc = BGP(bf16_t, BG_KCMP) + (size_t)bg * 256 * HD; const bf16_t* Vc = BGP(bf16_t, BG_VCMP) + (size_t)bg * 256 * HD;
        { const att::Dma dc = att::make_dma(c, HD, HD); for (int j = 0; j < NTc; ++j) att::dma_tile(c, dc, Kc, HD, Vc, HD, j * 64, j); }
        VM_WAIT(); __syncthreads();
        const int cpos = (pos - 31) >> 4;
        float m_reg = -1e30f, l_reg = 0.f;
        {
            f32x16 p0, p1; float alpha;
#pragma unroll 1
            for (int J = 0; J < NTc; ++J) { att::qkt(p0, p1, c.K_lds + J * att::TILE_B, c.r32, c.hi, qr); att::mask_tile(p0, p1, cpos - J * 64 - 4 * c.hi, 0x40000000u); att::softmax_step(p0, p1, m_reg, l_reg, alpha); }
        }
        f32x16 o[4] = {};
        {
            const float inv_l = l_reg > 0.f ? 1.0f / l_reg : 0.f, mnL = -m_reg * att::C2; f32x16 p0, p1; bf16x8 pa0, pa1, pa2, pa3;
#pragma unroll 1
            for (int J = 0; J < NTc; ++J) { att::qkt(p0, p1, c.K_lds + J * att::TILE_B, c.r32, c.hi, qr); att::mask_tile(p0, p1, cpos - J * 64 - 4 * c.hi, 0x40000000u);
#pragma unroll
                for (int r = 0; r < 16; ++r) { p0[r] = __builtin_amdgcn_exp2f(fmaf(p0[r], att::C2, mnL)) * inv_l; p1[r] = __builtin_amdgcn_exp2f(fmaf(p1[r], att::C2, mnL)) * inv_l; }
                LAS unsigned* irow = IMP + tl * 65 + J * 16 + c.hi; constexpr float IS = 67108864.0f;
#pragma unroll
                for (int jj = 0; jj < 4; ++jj) {
                    atomicAdd((unsigned*)(irow + 2 * jj), (unsigned)((p0[4 * jj] + p0[4 * jj + 1] + p0[4 * jj + 2] + 0.5f * p0[4 * jj + 3]) * IS + 0.5f)); atomicAdd((unsigned*)(irow + 2 * jj + 1), (unsigned)(0.5f * p0[4 * jj + 3] * IS + 0.5f));
                    atomicAdd((unsigned*)(irow + 2 * jj + 8), (unsigned)((p1[4 * jj] + p1[4 * jj + 1] + p1[4 * jj + 2] + 0.5f * p1[4 * jj + 3]) * IS + 0.5f)); atomicAdd((unsigned*)(irow + 2 * jj + 9), (unsigned)(0.5f * p1[4 * jj + 3] * IS + 0.5f)); }
                att::pack_p(p0, p1, pa0, pa1, pa2, pa3); att::pv_tile(o, c.vb0 + J * att::TILE_B, pa0, pa1, pa2, pa3); }
        }
        bf16_t* Og = BGP(bf16_t, BG_OB) + (rowbase + trow) * 1024 + h * HD;
        __syncthreads();
        { const float g0 = bf2f(NGb[(rowbase + pos) * 32 + h * 3 + 0]), g2 = bf2f(NGb[(rowbase + pos) * 32 + h * 3 + 2]); att::store_o<true>(o, g0, c, Og, 1024, g2, true); }
        for (int i = 0; i < 8; ++i) { const int tk = c.wid * 8 + i, s = c.lane; volatile LAS unsigned* row = (volatile LAS unsigned*)IMP + tk * 65;
            const unsigned raw = row[s]; const bool forced = (s == 0) | (s == qt) | (s == qt - 1), valid = s <= qt;
            unsigned key = ((((raw >> 6) + 1u) << 6) | (unsigned)(63 - s)); key = forced ? (0xFFFFFFC0u | (unsigned)(63 - s)) : key; key = valid ? key : 0u;
            row[s] = key; LDS_WAIT();
            int rank = 0;
#pragma unroll 16
            for (int j = 0; j < 64; ++j) rank += (row[j] > key) ? 1 : 0;
            const unsigned long long bal = __ballot(rank < 16 && key != 0u);
            if (c.lane == 0) { SELM[2 * tk] = (unsigned)bal; SELM[2 * tk + 1] = (unsigned)(bal >> 32); } }
        __syncthreads();
        const unsigned sel_lo = SELM[2 * tl], sel_hi = SELM[2 * tl + 1];
#pragma unroll
        for (int d = 0; d < 4; ++d) o[d] = f32x16{};
        m_reg = -1e30f; l_reg = 0.f;
        att::attn_loop_simple<2>(c, QKV + rowbase * 4096 + 3072 + g * HD, 4096, QKV + rowbase * 4096 + 3328 + g * HD, 4096, 0, qt + 1, qr, pos, trow, 0, sel_lo, sel_hi, qt, o, m_reg, l_reg);
        { const float g1 = bf2f(NGb[(rowbase + pos) * 32 + h * 3 + 1]); VM_WAIT(); att::store_o<true, true>(o, g1 / l_reg, c, Og, 1024, 1.0f, false, BGP(unsigned char, BG_OA) + (size_t)M * 1024 + (rowbase + trow) * 1024 + h * HD); }
    }
}

__device__ __forceinline__ void p_router(Frame F) {
    launder(F);
    LAS float* wr = (LAS float*)F.lds;
    const float* rw = INP(IN_RW); const float* gain = INP(IN_FNORM) + D;
    for (int i = F.tid; i < D * 8; i += NTHREADS) wr[i] = rw[i] * gain[i >> 3];
    LAS int* te = (LAS int*)(F.lds + 65536); LAS float* tw = (LAS float*)(F.lds + 65536 + 1024);
    const bf16_t* XB = WSP(bf16_t, WS_XBF); const u64* rsq = WSP(u64, WS_RSQ) + 3 * M;
    int* ltok = WSP(int, WS_LTOK); float* lw = WSP(float, WS_LW); int* slot = WSP(int, WS_SLOT);
    for (int chunk = blockIdx.x; chunk < M / 64; chunk += F.G) {
        __syncthreads();
        for (int i = 0; i < 8; ++i) { const int tl = F.wave * 8 + i, tok = chunk * 64 + tl;
            const u32x2* xr = (const u32x2*)(XB + (size_t)tok * D) + F.lane; float a[8] = {0.f, 0.f, 0.f, 0.f, 0.f, 0.f, 0.f, 0.f};
#pragma unroll
            for (int j = 0; j < 8; ++j) { const u32x2 xw = xr[64 * j]; const f32x4 x = {bf_lo(xw.x), bf_hi(xw.x), bf_lo(xw.y), bf_hi(xw.y)}; const int k = 4 * (F.lane + 64 * j);
#pragma unroll
                for (int q = 0; q < 4; ++q) { const f32x4 w0 = *(const LAS f32x4*)(wr + (k + q) * 8), w1 = *(const LAS f32x4*)(wr + (k + q) * 8 + 4);
                    a[0] = fmaf(x[q], w0[0], a[0]); a[1] = fmaf(x[q], w0[1], a[1]); a[2] = fmaf(x[q], w0[2], a[2]); a[3] = fmaf(x[q], w0[3], a[3]);
                    a[4] = fmaf(x[q], w1[0], a[4]); a[5] = fmaf(x[q], w1[1], a[5]); a[6] = fmaf(x[q], w1[2], a[6]); a[7] = fmaf(x[q], w1[3], a[7]); } }
            const float rstd = rstd_of(rsq, tok);
#pragma unroll
            for (int e = 0; e < 8; ++e) a[e] = wave_sum(a[e]) * rstd;
            int e1 = 0; float l1 = a[0];
#pragma unroll
            for (int e = 1; e < 8; ++e) if (a[e] > l1) { l1 = a[e]; e1 = e; }
            int e2 = -1; float l2 = -3.0e38f;
#pragma unroll
            for (int e = 0; e < 8; ++e) if (e != e1 && a[e] > l2) { l2 = a[e]; e2 = e; }
            const float ex = __expf(l2 - l1), w1 = 1.0f / (1.0f + ex), w2 = ex * w1;
            if (F.lane == 0) { te[tl] = e1; te[64 + tl] = e2; tw[tl] = w1; tw[64 + tl] = w2; } }
        __syncthreads();
        if (F.wave == 0) { const int tl = F.lane, tok = chunk * 64 + tl, e1 = te[tl], e2 = te[64 + tl]; const float w1 = tw[tl], w2 = tw[64 + tl];
            const unsigned long long lt = (1ull << tl) - 1ull;
            int myn = 0;
#pragma unroll
            for (int e = 0; e < 8; ++e) { const int n = __popcll(__ballot(e1 == e)) + __popcll(__ballot(e2 == e)); if (tl == e) myn = n; }
            int mybase = 0; if (tl < 8 && myn > 0) mybase = (int)__hip_atomic_fetch_add(F.ctl + CW_ECNT + 64 * tl, (unsigned)myn, RLX_AGENT);
#pragma unroll
            for (int e = 0; e < 8; ++e) { const unsigned long long m1 = __ballot(e1 == e), m2 = __ballot(e2 == e); const int n1 = __popcll(m1);
                const int base = __shfl(mybase, e);
                if (e1 == e) { const int p = base + __popcll(m1 & lt); ltok[e * M + p] = tok; lw[e * M + p] = w1; slot[2 * tok] = (e << 20) | p; }
                if (e2 == e) { const int p = base + n1 + __popcll(m2 & lt); ltok[e * M + p] = tok; lw[e * M + p] = w2; slot[2 * tok + 1] = (e << 20) | p; } } }
    }
}
__device__ __forceinline__ void moe_counts(Frame& F) {
    __syncthreads();
    if (F.tid < 64) {
        int cnt = 0; if (F.tid < NE) cnt = (int)__hip_atomic_load(F.ctl + CW_ECNT + 64 * F.tid, RLX_AGENT);
        const int tiles = (cnt + 255) >> 8; int incl = tiles;
#pragma unroll
        for (int d = 1; d < 8; d <<= 1) { const int t = __shfl_up(incl, d); if (F.tid >= d) incl += t; }
        if (F.tid < NE) { F.misc[8 + F.tid] = (unsigned)cnt; F.misc[16 + F.tid] = (unsigned)(incl - tiles); }
        const int acc = __shfl(incl, NE - 1);
        if (F.tid == 0) { F.misc[24] = (unsigned)acc;
            int per_round = F.G / (D / 256); asm volatile("" : "+v"(per_round));
            const int tm = (acc / per_round) * per_round, tu = (acc - tm) * (D / 256);
            F.misc[25] = (unsigned)tm; F.misc[26] = (tu > 0 && tu * 4 <= F.G) ? 4u : ((tu > 0 && tu * 2 <= F.G) ? 2u : 1u); } }
    __syncthreads();
}
__device__ __forceinline__ void p_final(Frame F) {
    launder(F);
    moe_counts(F);
    const int gw = F.vcu * NWAVES + F.wave, NGW = F.G * NWAVES, lane = F.lane;
    const bf16_t* XB = WSP(bf16_t, WS_XBF); const bf16_t* YS = WSP(bf16_t, WS_YS); const int* slot = WSP(int, WS_SLOT); const float* gf = INP(IN_FINAL);
    const int Tm = (int)F.misc[25], S = (int)F.misc[26]; const bf16_t* YT = BGP(bf16_t, BG_YT);
    for (int m = gw; m < M; m += NGW) {
        const int s0 = slot[2 * m], s1 = slot[2 * m + 1];
        const size_t r0 = (size_t)F.misc[16 + (s0 >> 20)] * 256 + (s0 & 0xfffff), r1 = (size_t)F.misc[16 + (s1 >> 20)] * 256 + (s1 & 0xfffff);
        const u32x2* xr = (const u32x2*)(XB + (size_t)m * D) + lane;
        f32x4 v[8];
#pragma unroll
        for (int j = 0; j < 8; ++j) { const u32x2 a = xr[64 * j]; v[j] = f32x4{bf_lo(a.x), bf_hi(a.x), bf_lo(a.y), bf_hi(a.y)}; }
#pragma unroll
        for (int q = 0; q < 2; ++q) { const size_t r = q ? r1 : r0; const bool tail = (int)(r >> 8) >= Tm;
            const bf16_t* base = tail ? YT + (r - (size_t)Tm * 256) * D : YS + r * D; const int nrep = tail ? S : 1;
            for (int k = 0; k < nrep; ++k) { const u32x2* y = (const u32x2*)(base + (size_t)k * YT_ROWS * D) + lane;
#pragma unroll
                for (int j = 0; j < 8; ++j) { const u32x2 a = y[64 * j]; v[j][0] += bf_lo(a.x); v[j][1] += bf_hi(a.x); v[j][2] += bf_lo(a.y); v[j][3] += bf_hi(a.y); } } }
        float s = 0.f;
#pragma unroll
        for (int j = 0; j < 8; ++j) s += (v[j][0] * v[j][0] + v[j][1] * v[j][1]) + (v[j][2] * v[j][2] + v[j][3] * v[j][3]);
        const float rstd = rsqrtf(wave_sum(s) * (1.0f / D) + NORM_EPS);
        f32x4* o = (f32x4*)(F.out + (size_t)m * D) + lane; const f32x4* gp = (const f32x4*)gf + lane;
#pragma unroll
        for (int j = 0; j < 8; ++j) o[64 * j] = v[j] * rstd * gp[64 * j];
    }
}

#ifndef MK_SPLIT
#define MK_SPLIT 0
#endif
constexpr int NPHASE = 17;
struct Args { const float* in[22]; float* out; unsigned char* ws; int ph_lo, ph_hi, li, pad; };
__global__ void __launch_bounds__(NTHREADS, 2) mega_fwd(Args args) {
    extern __shared__ __attribute__((aligned(16))) unsigned char lds_raw[];
    Frame F0;
    F0.lds = (LAS unsigned char*)lds_raw; F0.misc = (volatile LAS unsigned*)(F0.lds + LDS_MISC);
    F0.tid = threadIdx.x; F0.lane = F0.tid & 63; F0.wave = __builtin_amdgcn_readfirstlane(F0.tid >> 6);
    F0.G = gridDim.x; { const int bx = blockIdx.x; F0.vcu = (F0.G % 8 == 0) ? (bx % 8) * (F0.G / 8) + bx / 8 : bx; }
    F0.in = args.in;
    F0.out = args.out; F0.ws = args.ws; F0.ctl = (unsigned*)(args.ws + WS_CTL);
    if (F0.tid < 64) F0.misc[F0.tid] = 0u;
    __syncthreads();
    XcdBarrier bar = xcd_barrier_post(F0.ctl + CW_BAR + args.li * XCD_BAR_WORDS, F0.misc);
    const int lo = args.ph_lo, hi = args.ph_hi;
#ifndef PHMASK
#define PHMASK 0x1ffff
#endif
#define IN(k) (((PHMASK >> ((k) > 7 && (k) < 13 ? (k) - 7 : (k))) & 1) && lo <= (k) && (k) < hi)
#define SEAM(k) do { if (IN(k) && IN((k) + 1)) { XcdBarrier b2 = bar; asm volatile("" : "+s"(b2.bar)); xcd_barrier(b2); } } while (0)

    if (IN(0)) p_prologue(F0);
    SEAM(0);
    for (int layer = 0; layer < 2; ++layer) {
        const int pb = 1 + 7 * layer;
        if (IN(pb)) { Frame F = F0; launder(F); u64* rsq = WSP(u64, WS_RSQ);
            pg8::SchedDense S{WSP(unsigned char, WS_X8), WSP(unsigned char, WS_WIN + layer * SZ_WIN), D, D, M / 256, 32, F.G, (int)blockIdx.x};
            pg8::EpiIn E{BGP(bf16_t, BG_QKV), BGP(bf16_t, BG_KCB), BGP(bf16_t, BG_VCB), BGP(bf16_t, BG_GM), BGP(bf16_t, BG_NG), rsq + (2 * layer) * M, WSP(float, WS_ROPE), WSP(float, WS_ROPE) + T * 64, 1.0f / WIN8_SCALE, F.lds + LDS_WSCR};
            pg8::gemm_phase<true>(F.lds, D, S, E);
        }
        SEAM(pb);
        if (IN(pb + 1)) p_attn_a(F0, layer);
        SEAM(pb + 1);
        if (IN(pb + 2)) p_attn_b(F0, layer);
        SEAM(pb + 2);
        if (IN(pb + 3)) { Frame F = F0; launder(F);
            pg8::SchedSeg2 S{BGP(unsigned char, BG_OA), WSP(unsigned char, WS_WUP + (2 * layer) * SZ_WUP), BGP(unsigned char, BG_OA) + (size_t)M * 1024, WSP(unsigned char, WS_WUP + (2 * layer + 1) * SZ_WUP), 1024, M / 256, D / 256, F.G, (int)blockIdx.x};
            pg8::EpiMerge E{BGP(bf16_t, BG_GM), BGP(unsigned char, BG_Z), Z8_SCALE / (O8_SCALE * WUP8_SCALE)};
            pg8::gemm_phase<true>(F.lds, 1024, S, E);
        }
        SEAM(pb + 3);
        if (IN(pb + 4)) { Frame F = F0; launder(F); u64* rsq = WSP(u64, WS_RSQ);
            pg8::SchedDense S{BGP(unsigned char, BG_Z), WSP(unsigned char, WS_WO + layer * SZ_WO), D, D, M / 256, D / 256, F.G, (int)blockIdx.x};
            pg8::EpiResid E{layer == 0 ? (const void*)INP(IN_X) : (const void*)WSP(bf16_t, WS_XBF), layer != 0, WSP(bf16_t, WS_XBF), rsq + (2 * layer + 1) * M, layer == 1 ? WSP(unsigned char, WS_X8) : nullptr, 1.0f / (Z8_SCALE * WO8_SCALE)};
            pg8::gemm_phase<true>(F.lds, D, S, E);
        }
        SEAM(pb + 4);
        if (layer == 0) {
            if (IN(pb + 5)) { Frame F = F0; launder(F); u64* rsq = WSP(u64, WS_RSQ);
                pg8::SchedDense S{WSP(bf16_t, WS_XBF), WSP(bf16_t, WS_WGUD), D * 2, D * 2, M / 256, 2 * FF / 256, F.G, (int)blockIdx.x};
                pg8::EpiGateUp<false, false, false> E{BGP(bf16_t, 0), rsq + 1 * M, nullptr, F.misc};
                pg8::gemm_phase<false>(F.lds, D * 2, S, E);
            }
            SEAM(pb + 5);
            if (IN(pb + 6)) { Frame F = F0; launder(F); u64* rsq = WSP(u64, WS_RSQ);
                pg8::SchedDense S{BGP(bf16_t, 0), WSP(bf16_t, WS_WDD), FF * 2, FF * 2, M / 256, D / 256, F.G, (int)blockIdx.x};
                pg8::EpiResid E{WSP(bf16_t, WS_XBF), 1, WSP(bf16_t, WS_XBF), rsq + 2 * M, WSP(unsigned char, WS_X8), 1.0f};
                pg8::gemm_phase<false>(F.lds, FF * 2, S, E);
            }
            SEAM(pb + 6);
        } else {
            if (IN(pb + 5)) p_router(F0);
            SEAM(pb + 5);
            if (IN(pb + 6)) { Frame F = F0; launder(F); u64* rsq = WSP(u64, WS_RSQ);
                moe_counts(F);
                pg8::SchedMoE<true> S{WSP(unsigned char, WS_X8), WSP(unsigned char, WS_WGUM), WSP(int, WS_LTOK), D, D, 2 * FF / 256, F.G, (int)blockIdx.x, SZ_WGU8, F.misc, 24};
                pg8::EpiGateUp<true> E{BGP(bf16_t, 0), rsq + 3 * M, WSP(int, WS_LTOK), F.misc};
                pg8::gemm_phase<true>(F.lds, D, S, E);
            }
            SEAM(pb + 6);
            if (IN(pb + 7)) { Frame F = F0; launder(F);
                moe_counts(F);
                pg8::SchedMoE<false> S{BGP(unsigned char, 0), WSP(unsigned char, WS_WDM), nullptr, FF, FF, D / 256, F.G, (int)blockIdx.x, SZ_WD8, F.misc, 25};
                pg8::EpiMoeDown E{WSP(bf16_t, WS_YS), WSP(float, WS_LW), F.misc};
                pg8::gemm_phase<true>(F.lds, FF, S, E);
                { const int kpart = FF / (int)F.misc[26];
                  pg8::SchedMoETail St{BGP(unsigned char, 0), WSP(unsigned char, WS_WDM), FF, FF, D / 256, (int)blockIdx.x, kpart, SZ_WD8, F.misc};
                  pg8::EpiMoeDownTail Et{BGP(bf16_t, BG_YT), WSP(float, WS_LW), F.misc};
                  pg8::gemm_phase<true>(F.lds, kpart, St, Et); }
            }
            SEAM(pb + 7);
        }
    }
    if (IN(16)) p_final(F0);
#undef IN
#undef SEAM
}

extern "C" void kernel_launch(void* const* d_in, const int* in_sizes, int n_in, void* d_out, int out_size, void* d_ws, size_t ws_size, hipStream_t stream) {
    static int grid = 0;
    if (grid == 0) {
        if (n_in != 22 || in_sizes[0] != M * D || out_size != M * D || ws_size < WS_END) { fprintf(stderr, "kernel_launch: unexpected shapes (n_in %d, in0 %d, out %d, ws %zu < %zu); nothing launched\n", n_in, n_in > 0 ? in_sizes[0] : -1, out_size, ws_size, (size_t)WS_END); grid = -1; return; }
        int dev = 0, cus = 0, per_cu = 0;
        if (hipGetDevice(&dev) != hipSuccess || hipDeviceGetAttribute(&cus, hipDeviceAttributeMultiprocessorCount, dev) != hipSuccess) { grid = -1; return; }
        if (hipFuncSetAttribute((const void*)mega_fwd, hipFuncAttributeMaxDynamicSharedMemorySize, LDS_BYTES) != hipSuccess) { fprintf(stderr, "kernel_launch: hipFuncSetAttribute failed\n"); grid = -1; return; }
        if (hipOccupancyMaxActiveBlocksPerMultiprocessor(&per_cu, (const void*)mega_fwd, NTHREADS, LDS_BYTES) != hipSuccess || per_cu < 1) fprintf(stderr, "kernel_launch: occupancy query reports %d\n", per_cu);
        (void)hipGetLastError();
        grid = cus;
    }
    if (grid < 0) return;
    (void)hipMemsetAsync((char*)d_ws + WS_CTL, 0, CTL_ZERO_BYTES, stream);
    Args a{};
    for (int i = 0; i < 22; ++i) a.in[i] = (const float*)d_in[i];
    a.out = (float*)d_out; a.ws = (unsigned char*)d_ws; a.pad = 0;
#if MK_SPLIT
    for (int p = 0; p < NPHASE; ++p) { a.ph_lo = p; a.ph_hi = p + 1; a.li = p; hipLaunchKernelGGL(mega_fwd, dim3(grid), dim3(NTHREADS), LDS_BYTES, stream, a); }
#else
    a.ph_lo = 0; a.ph_hi = NPHASE; a.li = 0;
    hipLaunchKernelGGL(mega_fwd, dim3(grid), dim3(NTHREADS), LDS_BYTES, stream, a);
#endif
}
```

```cpp
#include <hip/hip_runtime.h>
#include <cstdio>
#include <cstdint>

#define LAS __attribute__((address_space(3)))
#define GAS __attribute__((address_space(1)))
typedef unsigned short bf16_t;
typedef short bf16x8 __attribute__((ext_vector_type(8)));
typedef short s16x4 __attribute__((ext_vector_type(4)));
typedef float f32x4 __attribute__((ext_vector_type(4)));
typedef float f32x2 __attribute__((ext_vector_type(2)));
typedef float f32x16 __attribute__((ext_vector_type(16)));
typedef unsigned u32x4 __attribute__((ext_vector_type(4)));
typedef unsigned u32x2 __attribute__((ext_vector_type(2)));

constexpr int NB = 4, T = 4096, D = 2048, M = NB * T, HD = 128, FF = 7168, NE = 8;
constexpr int IN_DIM = 8216, NIN = 8448;
constexpr int NCMP = 255, CMPH = 256;
constexpr float NORM_EPS = 1e-6f;
constexpr int MAXSLOT = 34816;
constexpr int YT_ROWS = 31 * 256;

constexpr size_t MiB = 1u << 20;
constexpr size_t WS_CTL = 0, CTL_ZERO_BYTES = 2 * MiB;
constexpr int CW_TMO = 0, CW_QUEUE = 1024, CW_ECNT = 2048, CW_BAR = 4096;
constexpr size_t WS_RSQ = 1 * MiB;
constexpr size_t WS_ROPE = 2 * MiB;
constexpr size_t WS_MISC = 4 * MiB;
constexpr size_t WS_CBIAS = 512 * 1024;
constexpr float CB_SCALE = 1099511627776.0f;
constexpr size_t WS_LTOK = WS_MISC + 64 * 1024;
constexpr size_t WS_LW = WS_LTOK + (size_t)NE * M * 4;
constexpr size_t WS_SLOT = WS_LW + (size_t)NE * M * 4;
constexpr size_t WS_W = 6 * MiB;
constexpr size_t SZ_WIN = (size_t)NIN * D * 2, SZ_W1 = (size_t)CMPH * 4096 * 2, SZ_W2 = (size_t)256 * 256 * 2, SZ_WUP = (size_t)D * 1024 * 2, SZ_WO = (size_t)D * D * 2;
constexpr size_t SZ_WGU = (size_t)2 * FF * D * 2, SZ_WD = (size_t)D * FF * 2;
constexpr size_t SZ_WGU8 = (size_t)2 * FF * D, SZ_WD8 = (size_t)D * FF;
constexpr float WGU8_SCALE = 32.0f, WD8_SCALE = 64.0f, WIN8_SCALE = 32.0f, WUP8_SCALE = 32.0f, WO8_SCALE = 32.0f, O8_SCALE = 16.0f, Z8_SCALE = 16.0f;
constexpr size_t WS_WIN = WS_W;
constexpr size_t WS_W1 = WS_WIN + 2 * SZ_WIN;
constexpr size_t WS_W2 = WS_W1 + 4 * SZ_W1;
constexpr size_t WS_WUP = WS_W2 + 4 * SZ_W2;
constexpr size_t WS_WO = WS_WUP + 4 * SZ_WUP;
constexpr size_t WS_WGUD = WS_WO + 2 * SZ_WO;
constexpr size_t WS_WDD = WS_WGUD + SZ_WGU;
constexpr size_t WS_WGUM = WS_WDD + SZ_WD;
constexpr size_t WS_WDM = WS_WGUM + 8 * SZ_WGU8;
constexpr size_t WS_X8 = WS_WDM + 8 * SZ_WD8;
constexpr size_t WS_XR = WS_X8 + (size_t)M * D;
constexpr size_t WS_XBF = WS_XR + (size_t)M * D * 4;
constexpr size_t WS_YS = WS_XBF + (size_t)M * D * 2;
constexpr size_t WS_BIG = WS_YS + (size_t)MAXSLOT * D * 2;
constexpr size_t SZ_BIG = (size_t)MAXSLOT * FF * 2;
constexpr size_t WS_END = WS_BIG + SZ_BIG;
constexpr size_t BG_QKV = 0;
constexpr size_t BG_GM = BG_QKV + (size_t)M * 4096 * 2;
constexpr size_t BG_NG = BG_GM + (size_t)M * 4096 * 2;
constexpr size_t BG_KCB = BG_NG + (size_t)M * 32 * 2;
constexpr size_t BG_VCB = BG_KCB + (size_t)M * 256 * 2 + 65536;
constexpr size_t BG_HC = BG_VCB + (size_t)M * 256 * 2 + 65536;
constexpr size_t BG_KCMP = BG_HC + (size_t)2 * 2048 * 256 * 2;
constexpr size_t BG_VCMP = BG_KCMP + (size_t)8 * 256 * 128 * 2;
constexpr size_t BG_OA = BG_VCMP + (size_t)8 * 256 * 128 * 2;
constexpr size_t BG_OB = BG_OA + (size_t)M * 1024 * 2;
constexpr size_t BG_Z = BG_OB + (size_t)M * 1024 * 2;
constexpr size_t BG_END = BG_Z + (size_t)M * D * 2;
static_assert(BG_END <= SZ_BIG, "attention-phase tensors fit the aliased region");
constexpr size_t BG_YT = 256 * MiB;
static_assert((size_t)MAXSLOT * FF <= BG_YT && BG_YT + (size_t)4 * YT_ROWS * D * 2 <= SZ_BIG, "tail partials fit");
static_assert(WS_SLOT + (size_t)M * 8 <= WS_W, "misc region");

constexpr int LDS_K = 0, LDS_V = 65536, LDS_WSCR = 131072  , LDS_IMP = LDS_WSCR + 2048  , LDS_SELM = LDS_IMP + 64 * 65 * 4  ;
constexpr int LDS_MISC = LDS_SELM + 512;
constexpr int LDS_BYTES = LDS_MISC + 256;
static_assert(LDS_BYTES <= 163840, "LDS");
static_assert(LDS_WSCR + 32 * 528 <= LDS_MISC, "epilogue slab fits beside the GEMM buffers");
constexpr int NWAVES = 8, NTHREADS = 512;

#define RLX_AGENT __ATOMIC_RELAXED, __HIP_MEMORY_SCOPE_AGENT
#define LDS_WAIT() asm volatile("s_waitcnt lgkmcnt(0)" ::: "memory")
#define VM_WAIT() asm volatile("s_waitcnt vmcnt(0)" ::: "memory")

typedef __bf16 bf16x2_t __attribute__((ext_vector_type(2)));
__device__ __forceinline__ unsigned cvt_pk_bf16(float lo, float hi) { f32x2 v = {lo, hi}; bf16x2_t b = __builtin_convertvector(v, bf16x2_t); return __builtin_bit_cast(unsigned, b); }
__device__ __forceinline__ float bf_lo(unsigned w) { return __uint_as_float(w << 16); }
__device__ __forceinline__ float bf_hi(unsigned w) { return __uint_as_float(w & 0xffff0000u); }
__device__ __forceinline__ float bf2f(bf16_t b) { return __uint_as_float(((unsigned)b) << 16); }
__device__ __forceinline__ float fast_sigmoid(float x) { return __builtin_amdgcn_rcpf(1.0f + __builtin_amdgcn_exp2f(-1.4426950408889634f * x)); }
__device__ __forceinline__ int opaque_tid() { int t; asm volatile("v_mov_b32 %0, %1" : "=v"(t) : "v"((int)threadIdx.x)); return t; }
typedef unsigned long long u64;
typedef int v8i __attribute__((ext_vector_type(8)));
typedef int v4i __attribute__((ext_vector_type(4)));
__device__ __forceinline__ unsigned cvt4_fp8(float a, float b, float c, float d) { unsigned w = 0u; w = __builtin_amdgcn_cvt_pk_fp8_f32(a, b, w, false); w = __builtin_amdgcn_cvt_pk_fp8_f32(c, d, w, true); return w; }
constexpr float RSQ_SCALE = 1048576.0f;
__device__ __forceinline__ float rstd_of(const u64* rsq, int row) { return rsqrtf((float)rsq[row] * (1.0f / (RSQ_SCALE * D)) + NORM_EPS); }
__device__ __forceinline__ float wave_sum(float v) {
#pragma unroll
    for (int o = 1; o < 64; o <<= 1) v += __shfl_xor(v, o);
    return v;
}

#define XB_TMO      128
#define XB_XCNT(j)  (256  + 64 * (j))
#define XB_XSUB(j)  (1280 + 64 * (j))
#define XB_XGEN(j)  (2304 + 64 * (j))
#define XB_TOP      3328
#define XB_TOPGEN   3392
#define XCD_BAR_WORDS 3456
#define XB_SPIN_CAP (1u << 18)
__device__ __forceinline__ unsigned xb_ld(unsigned* p)              { return __hip_atomic_load(p, __ATOMIC_RELAXED, __HIP_MEMORY_SCOPE_AGENT); }
__device__ __forceinline__ unsigned xb_add(unsigned* p, unsigned v) { return __hip_atomic_fetch_add(p, v, __ATOMIC_RELAXED, __HIP_MEMORY_SCOPE_AGENT); }
__device__ __forceinline__ unsigned xb_xcc_id() { return (unsigned)__builtin_amdgcn_s_getreg((3 << 11) | 20) & 0xFu; }
#define XB_SPIN(cond, bar) do { unsigned _sp = 0; while (cond) { __builtin_amdgcn_s_sleep(1); \
    if ((++_sp & 255u) == 0u) { if (xb_ld(&(bar)[XB_TMO])) break; if (_sp > XB_SPIN_CAP) { atomicAdd(&(bar)[XB_TMO], 1u); break; } } } } while (0)
struct XcdBarrier { unsigned* bar; unsigned x; volatile LAS unsigned* st; };
__device__ __forceinline__ XcdBarrier xcd_barrier_post(unsigned* bar, volatile LAS unsigned* st) {
    XcdBarrier b; b.bar = bar; b.x = xb_xcc_id(); b.st = st;
    if (threadIdx.x == 0) (void)xb_add(&bar[XB_XCNT(b.x)], 1u);
    return b;
}
__device__ __forceinline__ void xcd_barrier_complete(unsigned* bar, unsigned x, unsigned& nloc, unsigned& nx) {
    const unsigned G = gridDim.x * gridDim.y * gridDim.z;
    unsigned sum, cnt, mine, sp = 0u;
    for (;;) {
        sum = 0u; cnt = 0u; mine = 0u;
#pragma unroll
        for (unsigned j = 0; j < 16; ++j) { const unsigned c = xb_ld(&bar[XB_XCNT(j)]); sum += c; cnt += (c > 0u) ? 1u : 0u; mine = (j == x) ? c : mine; }
        if (sum == G) break;
        __builtin_amdgcn_s_sleep(1);
        if ((++sp & 255u) == 0u) { if (xb_ld(&bar[XB_TMO])) break; if (sp > XB_SPIN_CAP) { atomicAdd(&bar[XB_TMO], 1u); break; } }
    }
    nloc = mine > 0u ? mine : 1u; nx = cnt > 0u ? cnt : 1u;
}
__device__ __forceinline__ void xcd_barrier(const XcdBarrier& b) {
    asm volatile("s_waitcnt vmcnt(0)" ::: "memory");
    __syncthreads();
    if (threadIdx.x == 0) {
        unsigned* bar = b.bar;
        __builtin_amdgcn_s_waitcnt(0);
        unsigned nloc = b.st[0], nx = b.st[1];
        if (nloc == 0u) { xcd_barrier_complete(bar, b.x, nloc, nx); b.st[0] = nloc; b.st[1] = nx; }
        const unsigned old = xb_add(&bar[XB_XSUB(b.x)], 1u);
        const unsigned gen = old / nloc;
        if (old + 1u == (gen + 1u) * nloc) {
            __builtin_amdgcn_fence(__ATOMIC_RELEASE, "agent");
            asm volatile("s_waitcnt vmcnt(0)" ::: "memory");
            const unsigned og = xb_add(&bar[XB_TOP], 1u);
            const unsigned tg = og / nx;
            if (og + 1u == (tg + 1u) * nx) xb_add(&bar[XB_TOPGEN], 1u);
            else XB_SPIN(xb_ld(&bar[XB_TOPGEN]) == tg, bar);
            __builtin_amdgcn_fence(__ATOMIC_ACQUIRE, "agent");
            xb_add(&bar[XB_XGEN(b.x)], 1u);
            asm volatile("s_waitcnt vmcnt(0)" ::: "memory");
        } else {
            XB_SPIN(xb_ld(&bar[XB_XGEN(b.x)]) == gen, bar);
            __builtin_amdgcn_fence(__ATOMIC_ACQUIRE, "agent");
            asm volatile("s_waitcnt vmcnt(0)" ::: "memory");
        }
    }
    __syncthreads();
}

namespace pg8 {
constexpr int BM = 256, BK = 64, HALF = 128, HTB = HALF * BK * 2, STAGE_BYTES = 8 * HTB, NXCD = 8, WGM = 4;
__host__ __device__ __forceinline__ int lds_byte(int r, int c) { const int st = (r >> 4) * 2 + (c >> 5), rr = r & 15, cc = c & 31, ob = rr * 64 + cc * 2; return st * 1024 + (ob ^ (((ob >> 9) & 1) << 5)); }
__host__ __device__ __forceinline__ void stage_rc(int b, int& R, int& C) { const int st = b / 1024, sb = b % 1024, swz = sb ^ (((sb >> 9) & 1) << 5); R = (st >> 1) * 16 + swz / 64; C = (st & 1) * 32 + (swz % 64) / 2; }
__host__ __device__ __forceinline__ int perm32(int rho) { const int n = rho >> 4, i = rho & 15; return 8 * (i >> 2) + 4 * n + (i & 3); }

struct Unit { int pm, pn, aux; };
typedef f32x4 Acc[2][2][4][2];

__device__ __forceinline__ bool static_tile(int L, int nM, int nN, int& pm, int& pn) {
    const int nwg = nM * nN; if (L >= nwg) return false;
    int wgid = L; { const int q = nwg / NXCD, r = nwg % NXCD, xcd = wgid % NXCD, off = wgid / NXCD; wgid = (xcd < r ? xcd * (q + 1) : r * (q + 1) + (xcd - r) * q) + off; }
    const int nig = WGM * nN, gid = wgid / nig, fm = gid * WGM, gsz = (nM - fm) < WGM ? (nM - fm) : WGM;
    pm = fm + ((wgid % nig) % gsz); pn = (wgid % nig) / gsz; return true;
}

__device__ __forceinline__ void glds_s(const void* sbase, unsigned voff, unsigned lds_dst) { unsigned keep;
    asm volatile("s_mov_b32 %0, m0\n\ts_mov_b32 m0, %3\n\ts_nop 0\n\tglobal_load_lds_dwordx4 %1, %2\n\ts_mov_b32 m0, %0" : "=&s"(keep) : "v"(voff), "s"(sbase), "s"(lds_dst) : "memory"); }
__device__ __forceinline__ const char* uni_ptr(const char* p) { const unsigned long long v = (unsigned long long)p; const unsigned lo = __builtin_amdgcn_readfirstlane((unsigned)v), hi = __builtin_amdgcn_readfirstlane((unsigned)(v >> 32));
    return (const char*)(GAS const char*)(((unsigned long long)hi << 32) | lo); }
template <bool FP8, class Epi, class Sched>
__device__ __forceinline__ void gemm_phase(LAS unsigned char* lds, const int Kb, const Sched& S, const Epi& E) {
    const int tid = opaque_tid(), wid = __builtin_amdgcn_readfirstlane(tid >> 6), lane = tid & 63, wr = wid >> 2, wc = wid & 3, fr = lane & 15, fq = lane >> 4;
    const int nt = Kb / 128;
    int Rr[2], Cc[2]; unsigned voffB[2];
#pragma unroll
    for (int i = 0; i < 2; ++i) { stage_rc(tid * 16 + i * 8192, Rr[i], Cc[i]); const int Rb = Epi::PERM ? ((Rr[i] & ~31) + perm32(Rr[i] & 31)) : Rr[i];
        voffB[i] = (unsigned)(Rb * S.ldb() + Cc[i] * 2); }
    const size_t kstep = (size_t)(BK * 2);
    const size_t hstepB = (size_t)HALF * S.ldb();
    const unsigned ldsw = (unsigned)wid * 1024u;
    const unsigned ldsb = (unsigned)__builtin_amdgcn_readfirstlane((int)((unsigned)(uintptr_t)lds + ldsw));
    const int aoff = lds_byte(wr * 64 + fr, fq * 8), boff = lds_byte(wc * 32 + fr, fq * 8);
#define PG8_SA(b, h) (((b) * 2 + (h)) * HTB)
#define PG8_SB(b, h) ((4 + (b) * 2 + (h)) * HTB)
#define PG8_STAGE(bufoff, gbase, voff) do { const void* sb_ = (const void*)(gbase); _Pragma("unroll") for (int _i = 0; _i < 2; ++_i) \
        glds_s(sb_, (voff)[_i], ldsb + (unsigned)((bufoff) + _i * 8192)); } while (0)
#define PG8_LD8(p_) __builtin_shufflevector(*(const LAS v4i*)(p_), *(const LAS v4i*)((p_) + 1024), 0, 1, 2, 3, 4, 5, 6, 7)
#define PG8_LDA(dst, b, h) do { _Pragma("unroll") for (int m = 0; m < 4; ++m) dst[m] = PG8_LD8(lds + PG8_SA(b, h) + aoff + m * 2048); } while (0)
#define PG8_LDB(dst, b, h) do { _Pragma("unroll") for (int n = 0; n < 2; ++n) dst[n] = PG8_LD8(lds + PG8_SB(b, h) + boff + n * 2048); } while (0)
#define PG8_H(v_, k_) __builtin_bit_cast(bf16x8, __builtin_shufflevector(v_, v_, 4 * (k_), 4 * (k_) + 1, 4 * (k_) + 2, 4 * (k_) + 3))
#define PG8_MMA(ai, bj, At, Bt) do { __builtin_amdgcn_s_setprio(1); _Pragma("unroll") for (int m = 0; m < 4; ++m) _Pragma("unroll") for (int n = 0; n < 2; ++n) { \
        if constexpr (FP8) asm volatile("v_mfma_f32_16x16x128_f8f6f4 %0, %1, %2, %0" : "+v"(acc[ai][bj][m][n]) : "v"(Bt[n]), "v"(At[m]));   \
        else { acc[ai][bj][m][n] = __builtin_amdgcn_mfma_f32_16x16x32_bf16(PG8_H(Bt[n], 0), PG8_H(At[m], 0), acc[ai][bj][m][n], 0, 0, 0); \
               acc[ai][bj][m][n] = __builtin_amdgcn_mfma_f32_16x16x32_bf16(PG8_H(Bt[n], 1), PG8_H(At[m], 1), acc[ai][bj][m][n], 0, 0, 0); } } \
        __builtin_amdgcn_s_setprio(0); } while (0)
#define PG8_WAIT_V(n) asm volatile("s_waitcnt vmcnt(" #n ")" ::: "memory")
#define PG8_WAIT_L(n) asm volatile("s_waitcnt lgkmcnt(" #n ")" ::: "memory")
#define PG8_BAR __builtin_amdgcn_s_barrier()
#define PG8_SCHED __builtin_amdgcn_sched_barrier(0)
    Unit cur, nxt; int ui = 0;
    if (!S.next(0, cur)) return;
    Acc acc;
#pragma unroll
    for (int a = 0; a < 2; ++a)
#pragma unroll
        for (int b = 0; b < 2; ++b)
#pragma unroll
            for (int m = 0; m < 4; ++m)
#pragma unroll
                for (int n = 0; n < 2; ++n) acc[a][b][m][n] = (f32x4){0.f, 0.f, 0.f, 0.f};
    v8i At[4], B0[2], B1[2]; const int one8 = 0x7F7F7F7F;
    unsigned vA[2][2], vAn[2][2];
    S.a_off(cur, Rr, Cc, vA);
    const char* cA = uni_ptr(S.a_base(cur)); const char* cB = uni_ptr(S.b_base(cur));
    PG8_STAGE(PG8_SB(0, 0), cB, voffB); PG8_STAGE(PG8_SB(0, 1), cB + hstepB, voffB); PG8_STAGE(PG8_SA(0, 0), cA, vA[0]); PG8_STAGE(PG8_SA(0, 1), cA, vA[1]);
    if (wr == 1) PG8_BAR;
    PG8_WAIT_V(2); PG8_BAR;
    PG8_STAGE(PG8_SB(1, 0), cB + kstep, voffB); PG8_STAGE(PG8_SA(1, 0), cA + kstep, vA[0]); PG8_STAGE(PG8_SB(1, 1), cB + hstepB + kstep, voffB);
    PG8_WAIT_V(6); PG8_BAR;
    for (;;) {
        const bool has_next = S.next(ui + 1, nxt);
        const char* nA = cA; const char* nB = cB;
#pragma unroll
        for (int h = 0; h < 2; ++h)
#pragma unroll
            for (int i = 0; i < 2; ++i) vAn[h][i] = vA[h][i];
        if (has_next) { nA = uni_ptr(S.a_base(nxt)); nB = uni_ptr(S.b_base(nxt)); if (Sched::VARIES) S.a_off(nxt, Rr, Cc, vAn); }
        for (int t = 0; t < nt; t += 2) {
            const bool last = (t == nt - 2);
            const char* a1 = cA + (size_t)(t + 1) * kstep;
            const char* a2 = last ? nA : cA + (size_t)(t + 2) * kstep; const char* b2 = last ? nB : cB + (size_t)(t + 2) * kstep;
            const char* a3 = a2 + kstep; const char* b3 = b2 + kstep;
            unsigned v2[2][2];
#pragma unroll
            for (int h = 0; h < 2; ++h)
#pragma unroll
                for (int i = 0; i < 2; ++i) v2[h][i] = (Sched::VARIES && last) ? vAn[h][i] : vA[h][i];
            PG8_LDB(B0, 0, 0); PG8_LDB(B1, 0, 1); PG8_SCHED; PG8_LDA(At, 0, 0); PG8_STAGE(PG8_SA(1, 1), a1, vA[1]);
            PG8_WAIT_V(8); PG8_WAIT_L(0); PG8_BAR; PG8_MMA(0, 0, At, B0); PG8_MMA(0, 1, At, B1); PG8_BAR; PG8_SCHED;
            PG8_LDA(At, 0, 1); PG8_STAGE(PG8_SB(0, 0), b2, voffB); PG8_STAGE(PG8_SB(0, 1), b2 + hstepB, voffB); PG8_STAGE(PG8_SA(0, 0), a2, v2[0]);
            PG8_WAIT_V(8); PG8_WAIT_L(0); PG8_BAR; PG8_MMA(1, 0, At, B0); PG8_MMA(1, 1, At, B1); PG8_BAR; PG8_SCHED;
            PG8_LDB(B0, 1, 0); PG8_LDB(B1, 1, 1); PG8_SCHED; PG8_LDA(At, 1, 0); PG8_STAGE(PG8_SA(0, 1), a2, v2[1]);
            PG8_WAIT_V(8); PG8_WAIT_L(0); PG8_BAR; PG8_MMA(0, 0, At, B0); PG8_MMA(0, 1, At, B1); PG8_BAR; PG8_SCHED;
            PG8_LDA(At, 1, 1); PG8_STAGE(PG8_SB(1, 0), b3, voffB); PG8_STAGE(PG8_SB(1, 1), b3 + hstepB, voffB); PG8_STAGE(PG8_SA(1, 0), a3, v2[0]);
            PG8_WAIT_V(8); PG8_WAIT_L(0); PG8_BAR; PG8_MMA(1, 0, At, B0); PG8_MMA(1, 1, At, B1); PG8_BAR; PG8_SCHED;
        }
        if (wr == 0) PG8_BAR;
        if constexpr (FP8) asm volatile("s_nop 15\n\ts_nop 15" ::: "memory");
        E(acc, cur, wr, wc, fr, fq);
        if (!has_next) break;
        if (!E.keep(cur)) {
#pragma unroll
            for (int a = 0; a < 2; ++a)
#pragma unroll
                for (int b = 0; b < 2; ++b)
#pragma unroll
                    for (int m = 0; m < 4; ++m)
#pragma unroll
                        for (int n = 0; n < 2; ++n) acc[a][b][m][n] = (f32x4){0.f, 0.f, 0.f, 0.f};
        }
        cur = nxt; cA = nA; cB = nB; ++ui;
#pragma unroll
        for (int h = 0; h < 2; ++h)
#pragma unroll
            for (int i = 0; i < 2; ++i) vA[h][i] = vAn[h][i];
        if (wr == 1) PG8_BAR;
    }
    PG8_WAIT_V(0);
    PG8_BAR;
#undef PG8_SA
#undef PG8_SB
#undef PG8_STAGE
#undef PG8_LDA
#undef PG8_LDB
#undef PG8_MMA
#undef PG8_WAIT_V
#undef PG8_WAIT_L
#undef PG8_BAR
#undef PG8_SCHED
}

struct SchedDense {
    static constexpr bool VARIES = false;
    const void* A; const void* Bt; int lda, ldb_, nM, nN, G, c;
    __device__ __forceinline__ int ldb() const { return ldb_; }
    __device__ __forceinline__ bool next(int i, Unit& u) const { u.aux = 0; return static_tile(i * G + c, nM, nN, u.pm, u.pn); }
    __device__ __forceinline__ const char* a_base(const Unit& u) const { return (const char*)A + (size_t)u.pm * BM * lda; }
    __device__ __forceinline__ const char* b_base(const Unit& u) const { return (const char*)Bt + (size_t)u.pn * BM * ldb_; }
    __device__ __forceinline__ void a_off(const Unit&, const int (&R)[2], const int (&C)[2], unsigned (&vo)[2][2]) const {
#pragma unroll
        for (int h = 0; h < 2; ++h)
#pragma unroll
            for (int i = 0; i < 2; ++i) vo[h][i] = (unsigned)((h * HALF + R[i]) * lda + C[i] * 2); }
};
struct SchedOne {
    static constexpr bool VARIES = false;
    const void* A; const void* Bt; int lda, ldb_, pm, pn;
    __device__ __forceinline__ int ldb() const { return ldb_; }
    __device__ __forceinline__ bool next(int i, Unit& u) const { u.aux = 0; u.pm = pm; u.pn = pn; return i == 0; }
    __device__ __forceinline__ const char* a_base(const Unit& u) const { return (const char*)A + (size_t)u.pm * BM * lda; }
    __device__ __forceinline__ const char* b_base(const Unit& u) const { return (const char*)Bt + (size_t)u.pn * BM * ldb_; }
    __device__ __forceinline__ void a_off(const Unit&, const int (&R)[2], const int (&C)[2], unsigned (&vo)[2][2]) const {
#pragma unroll
        for (int h = 0; h < 2; ++h)
#pragma unroll
            for (int i = 0; i < 2; ++i) vo[h][i] = (unsigned)((h * HALF + R[i]) * lda + C[i] * 2); }
};
struct SchedSeg2 {
    static constexpr bool VARIES = false;
    const void* A0; const void* B0; const void* A1; const void* B1; int ld, nM, nN, G, c;
    __device__ __forceinline__ int ldb() const { return ld; }
    __device__ __forceinline__ bool next(int i, Unit& u) const { u.aux = i & 1; return static_tile((i >> 1) * G + c, nM, nN, u.pm, u.pn); }
    __device__ __forceinline__ const char* a_base(const Unit& u) const { return (const char*)(u.aux ? A1 : A0) + (size_t)u.pm * BM * ld; }
    __device__ __forceinline__ const char* b_base(const Unit& u) const { return (const char*)(u.aux ? B1 : B0) + (size_t)u.pn * BM * ld; }
    __device__ __forceinline__ void a_off(const Unit&, const int (&R)[2], const int (&C)[2], unsigned (&vo)[2][2]) const {
#pragma unroll
        for (int h = 0; h < 2; ++h)
#pragma unroll
            for (int i = 0; i < 2; ++i) vo[h][i] = (unsigned)((h * HALF + R[i]) * ld + C[i] * 2); }
};
template <bool GATHER> struct SchedMoE {
    static constexpr bool VARIES = GATHER;
    const void* A; const void* Bt; const int* ltok; int lda, ldb_, nN, G, c; size_t bstride; const volatile LAS unsigned* misc; int nm_word;
    __device__ __forceinline__ int ldb() const { return ldb_; }
    __device__ __forceinline__ bool next(int i, Unit& u) const {
        const int nM = (int)misc[nm_word]; if (!static_tile(i * G + c, nM, nN, u.pm, u.pn)) return false;
        int e = 0;
#pragma unroll
        for (int j = 1; j < NE; ++j) e += ((int)misc[16 + j] <= u.pm) ? 1 : 0;
        u.aux = e; return true; }
    __device__ __forceinline__ const char* a_base(const Unit& u) const { return GATHER ? (const char*)A : (const char*)A + (size_t)u.pm * BM * lda; }
    __device__ __forceinline__ const char* b_base(const Unit& u) const { return (const char*)Bt + (size_t)u.aux * bstride + (size_t)u.pn * BM * ldb_; }
    __device__ __forceinline__ void a_off(const Unit& u, const int (&R)[2], const int (&C)[2], unsigned (&vo)[2][2]) const {
        if (GATHER) {
            const int cnt = (int)misc[8 + u.aux], r0 = (u.pm - (int)misc[16 + u.aux]) * BM;
#pragma unroll
            for (int h = 0; h < 2; ++h)
#pragma unroll
                for (int i = 0; i < 2; ++i) { const int r = r0 + h * HALF + R[i]; const int tok = r < cnt ? ltok[u.aux * M + r] : 0; vo[h][i] = (unsigned)(tok * lda + C[i] * 2); }
        } else {
#pragma unroll
            for (int h = 0; h < 2; ++h)
#pragma unroll
                for (int i = 0; i < 2; ++i) vo[h][i] = (unsigned)((h * HALF + R[i]) * lda + C[i] * 2);
        } }
};

struct SchedMoETail {
    static constexpr bool VARIES = false;
    const void* A; const void* Bt; int lda, ldb_, nN, c, kpart; size_t bstride; const volatile LAS unsigned* misc;
    __device__ __forceinline__ int ldb() const { return ldb_; }
    __device__ __forceinline__ bool next(int i, Unit& u) const {
        const int S = (int)misc[26], Tm = (int)misc[25], nt = ((int)misc[24] - Tm) * nN;
        if (i != 0 || c >= nt * S) return false;
        const int j = c / S, part = c - j * S; u.pm = Tm + j / nN; u.pn = j % nN;
        int e = 0;
#pragma unroll
        for (int q = 1; q < NE; ++q) e += ((int)misc[16 + q] <= u.pm) ? 1 : 0;
        u.aux = e | (part << 8); return true; }
    __device__ __forceinline__ const char* a_base(const Unit& u) const { return (const char*)A + (size_t)u.pm * BM * lda + (size_t)(u.aux >> 8) * kpart; }
    __device__ __forceinline__ const char* b_base(const Unit& u) const { return (const char*)Bt + (size_t)(u.aux & 255) * bstride + (size_t)u.pn * BM * ldb_ + (size_t)(u.aux >> 8) * kpart; }
    __device__ __forceinline__ void a_off(const Unit&, const int (&R)[2], const int (&C)[2], unsigned (&vo)[2][2]) const {
#pragma unroll
        for (int h = 0; h < 2; ++h)
#pragma unroll
            for (int i = 0; i < 2; ++i) vo[h][i] = (unsigned)((h * HALF + R[i]) * lda + C[i] * 2); }
};

struct EpiIn {
    static constexpr bool PERM = true;
    bf16_t* QKV; bf16_t* KCb; bf16_t* VCb; bf16_t* GMb; bf16_t* NGb; const u64* rsq; const float* cosT; const float* sinT; float wscale;
    LAS unsigned char* slab;
    __device__ __forceinline__ bool keep(const Unit&) const { return false; }
    __device__ __forceinline__ void operator()(const Acc& acc, const Unit& u, int wr, int wc, int fr, int fq) const {
        const int pn = u.pn, row0 = u.pm * BM + wr * 64 + fr;
        u64 rq[2][4];
#pragma unroll
        for (int ai = 0; ai < 2; ++ai)
#pragma unroll
            for (int m = 0; m < 4; ++m) rq[ai][m] = rsq[row0 + ai * HALF + m * 16];
        const float sc = (1.0f / (RSQ_SCALE * D));
        if (pn < 32) {
            const int wid = wr * 4 + wc, lane = fq * 16 + fr;
            LAS unsigned char* wrow = slab + (wr * 16 + fr) * 528;
            const int sr = wid * 4 + (lane >> 5), cb = (lane & 31) * 16;
            const LAS unsigned char* rp = slab + sr * 528 + cb;
            const int trow = (sr >> 4) * 64 + (sr & 15);
            const bool rope = pn < 16 && ((0x57DF >> pn) & 1); const int d0 = 16 * wc + 4 * fq;
            f32x4 csa[8], sna[8];
#pragma unroll
            for (int g = 0; g < 8; ++g) { csa[g] = f32x4{1.f, 1.f, 1.f, 1.f}; sna[g] = f32x4{0.f, 0.f, 0.f, 0.f}; }
            if (rope) {
#pragma unroll
                for (int g = 0; g < 8; ++g) { const int t = (row0 + (g >> 2) * HALF + (g & 3) * 16) & (T - 1); csa[g] = *(const f32x4*)(cosT + t * 64 + d0); sna[g] = *(const f32x4*)(sinT + t * 64 + d0); } }
#pragma unroll
            for (int g = 0; g < 8; ++g) { const int ai = g >> 2, m = g & 3; const f32x4 cs = csa[g], sn = sna[g];
                const float rstd = rsqrtf((float)rq[ai][m] * sc + NORM_EPS) * wscale;
#pragma unroll
                for (int bj = 0; bj < 2; ++bj) { const f32x4 v0 = acc[ai][bj][m][0] * rstd, v1 = acc[ai][bj][m][1] * rstd;
                    if (pn < 16) { const f32x4 o1 = v0 * cs - v1 * sn, o2 = v1 * cs + v0 * sn;
                        u32x2 w1, w2; w1.x = cvt_pk_bf16(o1[0], o1[1]); w1.y = cvt_pk_bf16(o1[2], o1[3]); w2.x = cvt_pk_bf16(o2[0], o2[1]); w2.y = cvt_pk_bf16(o2[2], o2[3]);
                        *(LAS u32x2*)(wrow + (bj * HD + d0) * 2) = w1; *(LAS u32x2*)(wrow + (bj * HD + 64 + d0) * 2) = w2; }
                    else { u32x4 w;
                        w.x = cvt_pk_bf16(fast_sigmoid(v0[0]), fast_sigmoid(v0[1])); w.y = cvt_pk_bf16(fast_sigmoid(v0[2]), fast_sigmoid(v0[3]));
                        w.z = cvt_pk_bf16(fast_sigmoid(v1[0]), fast_sigmoid(v1[1])); w.w = cvt_pk_bf16(fast_sigmoid(v1[2]), fast_sigmoid(v1[3]));
                        *(LAS u32x4*)(wrow + (bj * HD + wc * 32 + 8 * fq) * 2) = w; } }
                asm volatile("s_waitcnt lgkmcnt(0)" ::: "memory"); __builtin_amdgcn_s_barrier(); asm volatile("" ::: "memory");
                const u32x4 ra = *(const LAS u32x4*)rp, rb = *(const LAS u32x4*)(rp + 2 * 528);
                asm volatile("s_waitcnt lgkmcnt(0)" ::: "memory"); __builtin_amdgcn_s_barrier(); asm volatile("" ::: "memory");
                const int grow = u.pm * BM + ai * HALF + m * 16 + trow;
                unsigned char* dst; size_t rstride;
                if (pn == 10 || pn == 11) { bf16_t* cbuf = pn == 10 ? KCb : VCb; dst = (unsigned char*)(cbuf + ((size_t)((grow >> 12) * 2 + (cb >> 8)) * T + (grow & (T - 1))) * HD) + (cb & 255); rstride = (size_t)HD * 2; }
                else if (pn < 16) { dst = (unsigned char*)(QKV + (size_t)grow * 4096 + pn * 256) + cb; rstride = (size_t)4096 * 2; }
                else { dst = (unsigned char*)(GMb + (size_t)grow * 4096 + (pn - 16) * 256) + cb; rstride = (size_t)4096 * 2; }
                *(u32x4*)dst = ra; *(u32x4*)(dst + 2 * rstride) = rb; }
        } else {
            if (wc == 0) {
#pragma unroll
                for (int ai = 0; ai < 2; ++ai)
#pragma unroll
                    for (int m = 0; m < 4; ++m) { const int row = row0 + ai * HALF + m * 16; const float rstd = rsqrtf((float)rq[ai][m] * sc + NORM_EPS) * wscale;
                        const f32x4 v0 = acc[ai][0][m][0] * rstd, v1 = acc[ai][0][m][1] * rstd; u32x4 w;
                        w.x = cvt_pk_bf16(fast_sigmoid(v0[0]), fast_sigmoid(v0[1])); w.y = cvt_pk_bf16(fast_sigmoid(v0[2]), fast_sigmoid(v0[3]));
                        w.z = cvt_pk_bf16(fast_sigmoid(v1[0]), fast_sigmoid(v1[1])); w.w = cvt_pk_bf16(fast_sigmoid(v1[2]), fast_sigmoid(v1[3]));
                        *(u32x4*)(NGb + (size_t)row * 32 + 8 * fq) = w; }
            }
        }
    }
};
struct EpiCmp1 {
    static constexpr bool PERM = true;
    bf16_t* H; const long long* bias;
    __device__ __forceinline__ bool keep(const Unit&) const { return false; }
    __device__ __forceinline__ void operator()(const Acc& acc, const Unit& u, int wr, int wc, int fr, int fq) const {
        const int row0 = u.pm * BM + wr * 64 + fr, col0 = wc * 32 + 8 * fq;
        f32x4 bv[2][2];
#pragma unroll
        for (int bj = 0; bj < 2; ++bj)
#pragma unroll
            for (int n = 0; n < 2; ++n) { const long long* bp = bias + col0 + bj * HALF + 4 * n; bv[bj][n] = f32x4{(float)bp[0], (float)bp[1], (float)bp[2], (float)bp[3]} * (1.0f / CB_SCALE); }
#pragma unroll
        for (int ai = 0; ai < 2; ++ai)
#pragma unroll
            for (int m = 0; m < 4; ++m) { bf16_t* rowp = H + (size_t)(row0 + ai * HALF + m * 16) * 256 + col0;
#pragma unroll
                for (int bj = 0; bj < 2; ++bj) { f32x4 v0 = acc[ai][bj][m][0] + bv[bj][0], v1 = acc[ai][bj][m][1] + bv[bj][1];
#pragma unroll
                    for (int j = 0; j < 4; ++j) { v0[j] = v0[j] * fast_sigmoid(v0[j]); v1[j] = v1[j] * fast_sigmoid(v1[j]); }
                    u32x4 w; w.x = cvt_pk_bf16(v0[0], v0[1]); w.y = cvt_pk_bf16(v0[2], v0[3]); w.z = cvt_pk_bf16(v1[0], v1[1]); w.w = cvt_pk_bf16(v1[2], v1[3]);
                    *(u32x4*)(rowp + bj * HALF) = w; } }
    }
};
struct EpiCmp2 {
    static constexpr bool PERM = true;
    bf16_t* O;
    __device__ __forceinline__ bool keep(const Unit&) const { return false; }
    __device__ __forceinline__ void operator()(const Acc& acc, const Unit& u, int wr, int wc, int fr, int fq) const {
        const int row0 = u.pm * BM + wr * 64 + fr, col0 = wc * 32 + 8 * fq;
#pragma unroll
        for (int ai = 0; ai < 2; ++ai)
#pragma unroll
            for (int m = 0; m < 4; ++m) { const int row = row0 + ai * HALF + m * 16; const float z = ((row & 255) == 255) ? 0.f : 1.f;
                const f32x4 v0 = acc[ai][0][m][0] * z, v1 = acc[ai][0][m][1] * z;
                u32x4 w; w.x = cvt_pk_bf16(v0[0], v0[1]); w.y = cvt_pk_bf16(v0[2], v0[3]); w.z = cvt_pk_bf16(v1[0], v1[1]); w.w = cvt_pk_bf16(v1[2], v1[3]);
                *(u32x4*)(O + (size_t)row * HD + col0) = w; }
    }
};
struct EpiMerge {
    static constexpr bool PERM = true;
    const bf16_t* GMb; unsigned char* Z; float zscale;
    __device__ __forceinline__ bool keep(const Unit& u) const { return u.aux == 0; }
    __device__ __forceinline__ void operator()(Acc& acc, const Unit& u, int wr, int wc, int fr, int fq) const {
        const int row0 = u.pm * BM + wr * 64 + fr, col0 = u.pn * BM + wc * 32 + 8 * fq;
        if (u.aux == 0) {
#pragma unroll
            for (int ai = 0; ai < 2; ++ai)
#pragma unroll
                for (int m = 0; m < 4; ++m) { const int row = row0 + ai * HALF + m * 16;
#pragma unroll
                    for (int bj = 0; bj < 2; ++bj) { const int col = col0 + bj * HALF;
                        const u32x4 g1 = *(const u32x4*)(GMb + (size_t)row * 4096 + 2048 + col), g0 = *(const u32x4*)(GMb + (size_t)row * 4096 + col);
                        const f32x4 g1a = {bf_lo(g1.x), bf_hi(g1.x), bf_lo(g1.y), bf_hi(g1.y)}, g1b = {bf_lo(g1.z), bf_hi(g1.z), bf_lo(g1.w), bf_hi(g1.w)};
                        const f32x4 g0a = {bf_lo(g0.x), bf_hi(g0.x), bf_lo(g0.y), bf_hi(g0.y)}, g0b = {bf_lo(g0.z), bf_hi(g0.z), bf_lo(g0.w), bf_hi(g0.w)};
#pragma unroll
                        for (int j = 0; j < 4; ++j) { acc[ai][bj][m][0][j] *= g0a[j] * __builtin_amdgcn_rcpf(fmaxf(g1a[j], 1e-30f)); acc[ai][bj][m][1][j] *= g0b[j] * __builtin_amdgcn_rcpf(fmaxf(g1b[j], 1e-30f)); } } }
        } else {
            u32x4 gc[2], gn[2];
#pragma unroll
            for (int bj = 0; bj < 2; ++bj) gc[bj] = *(const u32x4*)(GMb + (size_t)row0 * 4096 + 2048 + col0 + bj * HALF);
#pragma unroll
            for (int g = 0; g < 8; ++g) { const int ai = g >> 2, m = g & 3, row = row0 + ai * HALF + m * 16;
                if (g < 7) { const int rn = row0 + ((g + 1) >> 2) * HALF + ((g + 1) & 3) * 16;
#pragma unroll
                    for (int bj = 0; bj < 2; ++bj) gn[bj] = *(const u32x4*)(GMb + (size_t)rn * 4096 + 2048 + col0 + bj * HALF); }
#pragma unroll
                for (int bj = 0; bj < 2; ++bj) { const u32x4 g1 = gc[bj];
                    const f32x4 g1a = {bf_lo(g1.x), bf_hi(g1.x), bf_lo(g1.y), bf_hi(g1.y)}, g1b = {bf_lo(g1.z), bf_hi(g1.z), bf_lo(g1.w), bf_hi(g1.w)};
                    const f32x4 v0 = acc[ai][bj][m][0] * g1a * zscale, v1 = acc[ai][bj][m][1] * g1b * zscale;
                    u32x2 w; w.x = cvt4_fp8(v0[0], v0[1], v0[2], v0[3]); w.y = cvt4_fp8(v1[0], v1[1], v1[2], v1[3]);
                    *(u32x2*)(Z + (size_t)row * D + col0 + bj * HALF) = w; }
                gc[0] = gn[0]; gc[1] = gn[1]; }
        }
    }
};
struct EpiResid {
    static constexpr bool PERM = true;
    const void* xin; int xin16; bf16_t* XB; u64* rsq_out; unsigned char* X8; float ascale;
    __device__ __forceinline__ bool keep(const Unit&) const { return false; }
    __device__ __forceinline__ void ldx(size_t off, f32x4& a, f32x4& b) const {
        if (xin16) { const u32x4 w = *(const u32x4*)((const bf16_t*)xin + off); a = f32x4{bf_lo(w.x), bf_hi(w.x), bf_lo(w.y), bf_hi(w.y)}; b = f32x4{bf_lo(w.z), bf_hi(w.z), bf_lo(w.w), bf_hi(w.w)}; }
        else { a = *(const f32x4*)((const float*)xin + off); b = *(const f32x4*)((const float*)xin + off + 4); } }
    __device__ __forceinline__ void operator()(const Acc& acc, const Unit& u, int wr, int wc, int fr, int fq) const {
        const int row0 = u.pm * BM + wr * 64 + fr, col0 = u.pn * BM + wc * 32 + 8 * fq;
        f32x4 xc[2][2], xn[2][2];
#pragma unroll
        for (int bj = 0; bj < 2; ++bj) ldx((size_t)row0 * D + col0 + bj * HALF, xc[bj][0], xc[bj][1]);
#pragma unroll
        for (int g = 0; g < 8; ++g) { const int ai = g >> 2, m = g & 3, row = row0 + ai * HALF + m * 16; const size_t off = (size_t)row * D + col0; float ss = 0.f;
            if (g < 7) { const size_t offn = (size_t)(row0 + ((g + 1) >> 2) * HALF + ((g + 1) & 3) * 16) * D + col0;
#pragma unroll
                for (int bj = 0; bj < 2; ++bj) ldx(offn + bj * HALF, xn[bj][0], xn[bj][1]); }
#pragma unroll
            for (int bj = 0; bj < 2; ++bj) { const size_t o = off + bj * HALF; const f32x4 x0 = xc[bj][0] + acc[ai][bj][m][0] * ascale, x1 = xc[bj][1] + acc[ai][bj][m][1] * ascale;
                { u32x4 w; w.x = cvt_pk_bf16(x0[0], x0[1]); w.y = cvt_pk_bf16(x0[2], x0[3]); w.z = cvt_pk_bf16(x1[0], x1[1]); w.w = cvt_pk_bf16(x1[2], x1[3]); *(u32x4*)(XB + o) = w; }
                if (X8) { u32x2 w; w.x = cvt4_fp8(x0[0], x0[1], x0[2], x0[3]); w.y = cvt4_fp8(x1[0], x1[1], x1[2], x1[3]); *(u32x2*)(X8 + o) = w; }
                ss += (x0[0] * x0[0] + x0[1] * x0[1]) + (x0[2] * x0[2] + x0[3] * x0[3]) + (x1[0] * x1[0] + x1[1] * x1[1]) + (x1[2] * x1[2] + x1[3] * x1[3]); }
            ss += __shfl_xor(ss, 16); ss += __shfl_xor(ss, 32);
            if (fq == 0) atomicAdd(rsq_out + row, (u64)(ss * RSQ_SCALE + 0.5f));
#pragma unroll
            for (int bj = 0; bj < 2; ++bj)
#pragma unroll
                for (int n = 0; n < 2; ++n) xc[bj][n] = xn[bj][n]; }
    }
};
template <bool MOE, bool OUT8 = MOE, bool W8 = MOE> struct EpiGateUp {
    static constexpr bool PERM = true;
    bf16_t* ACT; const u64* rsq; const int* ltok; const volatile LAS unsigned* misc;
    __device__ __forceinline__ bool keep(const Unit&) const { return false; }
    __device__ __forceinline__ void operator()(const Acc& acc, const Unit& u, int wr, int wc, int fr, int fq) const {
        const int row0 = u.pm * BM + wr * 64 + fr, col0 = u.pn * 128 + wc * 32 + 8 * fq;
        int cnt = 0, r0 = 0; if (MOE) { cnt = (int)misc[8 + u.aux]; r0 = (u.pm - (int)misc[16 + u.aux]) * BM + wr * 64 + fr; }
        int srow[2][4]; u64 rq[2][4];
#pragma unroll
        for (int ai = 0; ai < 2; ++ai)
#pragma unroll
            for (int m = 0; m < 4; ++m) { srow[ai][m] = row0 + ai * HALF + m * 16; if (MOE) { const int r = r0 + ai * HALF + m * 16; srow[ai][m] = r < cnt ? ltok[u.aux * M + r] : 0; } }
#pragma unroll
        for (int ai = 0; ai < 2; ++ai)
#pragma unroll
            for (int m = 0; m < 4; ++m) rq[ai][m] = rsq[srow[ai][m]];
#pragma unroll
        for (int ai = 0; ai < 2; ++ai)
#pragma unroll
            for (int m = 0; m < 4; ++m) { const int row = row0 + ai * HALF + m * 16;
                const float rstd = rsqrtf((float)rq[ai][m] * (1.0f / (RSQ_SCALE * D)) + NORM_EPS) * (W8 ? 1.0f / WGU8_SCALE : 1.0f);
                f32x4 a[2];
#pragma unroll
                for (int n = 0; n < 2; ++n) { const f32x4 g = acc[ai][0][m][n] * rstd, up = acc[ai][1][m][n] * rstd;
#pragma unroll
                    for (int j = 0; j < 4; ++j) a[n][j] = g[j] * fast_sigmoid(g[j]) * up[j]; }
                if (OUT8) { u32x2 w; w.x = cvt4_fp8(a[0][0], a[0][1], a[0][2], a[0][3]); w.y = cvt4_fp8(a[1][0], a[1][1], a[1][2], a[1][3]); *(u32x2*)((unsigned char*)ACT + (size_t)row * FF + col0) = w; }
                else { u32x4 w; w.x = cvt_pk_bf16(a[0][0], a[0][1]); w.y = cvt_pk_bf16(a[0][2], a[0][3]); w.z = cvt_pk_bf16(a[1][0], a[1][1]); w.w = cvt_pk_bf16(a[1][2], a[1][3]); *(u32x4*)(ACT + (size_t)row * FF + col0) = w; } }
    }
};
struct EpiMoeDown {
    static constexpr bool PERM = true;
    bf16_t* YS; const float* lw; const volatile LAS unsigned* misc;
    __device__ __forceinline__ bool keep(const Unit&) const { return false; }
    __device__ __forceinline__ void operator()(const Acc& acc, const Unit& u, int wr, int wc, int fr, int fq) const {
        const int row0 = u.pm * BM + wr * 64 + fr, col0 = u.pn * BM + wc * 32 + 8 * fq;
        const int cnt = (int)misc[8 + u.aux], r0 = (u.pm - (int)misc[16 + u.aux]) * BM + wr * 64 + fr;
        float wg[2][4];
#pragma unroll
        for (int ai = 0; ai < 2; ++ai)
#pragma unroll
            for (int m = 0; m < 4; ++m) { const int r = r0 + ai * HALF + m * 16; wg[ai][m] = r < cnt ? lw[u.aux * M + r] * (1.0f / WD8_SCALE) : 0.f; }
#pragma unroll
        for (int ai = 0; ai < 2; ++ai)
#pragma unroll
            for (int m = 0; m < 4; ++m) { const int row = row0 + ai * HALF + m * 16; const float wgt = wg[ai][m];
#pragma unroll
                for (int bj = 0; bj < 2; ++bj) { const f32x4 v0 = acc[ai][bj][m][0] * wgt, v1 = acc[ai][bj][m][1] * wgt;
                    u32x4 w; w.x = cvt_pk_bf16(v0[0], v0[1]); w.y = cvt_pk_bf16(v0[2], v0[3]); w.z = cvt_pk_bf16(v1[0], v1[1]); w.w = cvt_pk_bf16(v1[2], v1[3]);
                    *(u32x4*)(YS + (size_t)row * D + col0 + bj * HALF) = w; } }
    }
};
struct EpiMoeDownTail {
    static constexpr bool PERM = true;
    bf16_t* YT; const float* lw; const volatile LAS unsigned* misc;
    __device__ __forceinline__ bool keep(const Unit&) const { return false; }
    __device__ __forceinline__ void operator()(const Acc& acc, const Unit& u, int wr, int wc, int fr, int fq) const {
        const int e = u.aux & 255, part = u.aux >> 8, Tm = (int)misc[25];
        const int row0 = (u.pm - Tm) * BM + wr * 64 + fr, col0 = u.pn * BM + wc * 32 + 8 * fq;
        const int cnt = (int)misc[8 + e], r0 = (u.pm - (int)misc[16 + e]) * BM + wr * 64 + fr;
        float wg[2][4];
#pragma unroll
        for (int ai = 0; ai < 2; ++ai)
#pragma unroll
            for (int m = 0; m < 4; ++m) { const int r = r0 + ai * HALF + m * 16; wg[ai][m] = r < cnt ? lw[e * M + r] * (1.0f / WD8_SCALE) : 0.f; }
        bf16_t* Y = YT + (size_t)part * YT_ROWS * D;
#pragma unroll
        for (int ai = 0; ai < 2; ++ai)
#pragma unroll
            for (int m = 0; m < 4; ++m) { const int row = row0 + ai * HALF + m * 16; const float wgt = wg[ai][m];
#pragma unroll
                for (int bj = 0; bj < 2; ++bj) { const f32x4 v0 = acc[ai][bj][m][0] * wgt, v1 = acc[ai][bj][m][1] * wgt;
                    u32x4 w; w.x = cvt_pk_bf16(v0[0], v0[1]); w.y = cvt_pk_bf16(v0[2], v0[3]); w.z = cvt_pk_bf16(v1[0], v1[1]); w.w = cvt_pk_bf16(v1[2], v1[3]);
                    *(u32x4*)(Y + (size_t)row * D + col0 + bj * HALF) = w; } }
    }
};
}

namespace att {
constexpr float SCALE = 0.08838834764831845f, LOG2E = 1.4426950408889634f, C2 = LOG2E * SCALE, THR = 8.f;
constexpr int TILE_B = 16384;
#define KSWZ(row, colB) ((row) * 256 + ((colB) ^ (((row) & 7) << 4)))
#define SBAR() __builtin_amdgcn_sched_barrier(0)
__device__ __forceinline__ int v_st(int k, int c) { const int kk = (k & ~0xC) | ((k & 4) << 1) | ((k & 8) >> 1); return ((kk >> 3) * 4 + (c >> 5)) * 512 + ((kk & 7) * 32 + (c & 31)) * 2; }
__device__ __forceinline__ int v_rd_base(int lane) { return ((lane & 3) << 3) | (((lane >> 2) & 3) << 6) | (((lane >> 4) & 1) << 5) | (((lane >> 5) & 1) << 8); }
constexpr int v_rd_off(int d0, int ks, int half) { return d0 * 512 + ks * 4096 + half * 2048; }
__device__ __forceinline__ int crow(int r, int hi) { return (r & 3) + 8 * (r >> 2) + 4 * hi; }

__device__ __forceinline__ void mask_tile(f32x16& p0, f32x16& p1, int dq, unsigned W) {
    const float NEG = -__builtin_inff();
#pragma unroll
    for (int r = 0; r < 16; ++r) { const int c = (r & 3) + 8 * (r >> 2);
        if ((unsigned)(dq - c) >= W) p0[r] = NEG;
        if ((unsigned)(dq - c - 32) >= W) p1[r] = NEG; }
}
__device__ __forceinline__ void mask_all(f32x16& p0, f32x16& p1, bool keep) {
    const float NEG = -__builtin_inff();
#pragma unroll
    for (int r = 0; r < 16; ++r) { p0[r] = keep ? p0[r] : NEG; p1[r] = keep ? p1[r] : NEG; }
}
__device__ __forceinline__ float rowmax32(const f32x16& p0, const f32x16& p1) {
    float pmax = p0[0];
#pragma unroll
    for (int r = 1; r < 16; ++r) pmax = fmaxf(pmax, p0[r]);
#pragma unroll
    for (int r = 0; r < 16; ++r) pmax = fmaxf(pmax, p1[r]);
    auto rr = __builtin_amdgcn_permlane32_swap(__float_as_uint(pmax), __float_as_uint(pmax), false, false);
    return fmaxf(__uint_as_float(rr[0]), __uint_as_float(rr[1]));
}
__device__ __forceinline__ float rowsum32(const f32x16& p0, const f32x16& p1) {
    float ps = 0.f;
#pragma unroll
    for (int r = 0; r < 16; ++r) ps += p0[r];
#pragma unroll
    for (int r = 0; r < 16; ++r) ps += p1[r];
    auto rr = __builtin_amdgcn_permlane32_swap(__float_as_uint(ps), __float_as_uint(ps), false, false);
    return __uint_as_float(rr[0]) + __uint_as_float(rr[1]);
}
__device__ __forceinline__ void pack_p(const f32x16& p0, const f32x16& p1, bf16x8& pa0, bf16x8& pa1, bf16x8& pa2, bf16x8& pa3) {
#define PK4(P, B_, OUT) do { unsigned a0 = cvt_pk_bf16(P[B_+0], P[B_+1]), a1 = cvt_pk_bf16(P[B_+2], P[B_+3]);                          \
        unsigned b0 = cvt_pk_bf16(P[B_+4], P[B_+5]), b1 = cvt_pk_bf16(P[B_+6], P[B_+7]);                                             \
        auto r0 = __builtin_amdgcn_permlane32_swap(a0, b0, false, false); auto r1 = __builtin_amdgcn_permlane32_swap(a1, b1, false, false); \
        u32x4 w = {r0[0], r1[0], r0[1], r1[1]}; OUT = *reinterpret_cast<bf16x8*>(&w); } while (0)
    PK4(p0, 0, pa0); PK4(p0, 8, pa1); PK4(p1, 0, pa2); PK4(p1, 8, pa3);
#undef PK4
}
__device__ __forceinline__ void softmax_step(f32x16& p0, f32x16& p1, float& m_reg, float& l_reg, float& alpha) {
    const float pmax = rowmax32(p0, p1); float mn;
    if (__builtin_expect(__all((pmax - m_reg) * SCALE <= THR), 1)) { mn = m_reg; alpha = 1.f; }
    else { mn = fmaxf(m_reg, pmax); alpha = __builtin_amdgcn_exp2f((m_reg - mn) * C2); m_reg = mn; }
    const float mnL = -mn * C2;
#pragma unroll
    for (int r = 0; r < 16; ++r) { p0[r] = __builtin_amdgcn_exp2f(fmaf(p0[r], C2, mnL)); p1[r] = __builtin_amdgcn_exp2f(fmaf(p1[r], C2, mnL)); }
    l_reg = l_reg * alpha + rowsum32(p0, p1);
}
__device__ __forceinline__ void softmax_step_keep(f32x16& p0, f32x16& p1, float& m_reg, float& l_reg, float& alpha, bool keep) {
    const float NEG = -__builtin_inff();
    const float pm = rowmax32(p0, p1), pmax = keep ? pm : NEG; float mn;
    if (__builtin_expect(__all((pmax - m_reg) * SCALE <= THR), 1)) { mn = m_reg; alpha = 1.f; }
    else { mn = fmaxf(m_reg, pmax); alpha = __builtin_amdgcn_exp2f((m_reg - mn) * C2); m_reg = mn; }
    const float c2 = keep ? C2 : 0.f, mnL = keep ? -mn * C2 : NEG;
#pragma unroll
    for (int r = 0; r < 16; ++r) { p0[r] = __builtin_amdgcn_exp2f(fmaf(p0[r], c2, mnL)); p1[r] = __builtin_amdgcn_exp2f(fmaf(p1[r], c2, mnL)); }
    l_reg = l_reg * alpha + rowsum32(p0, p1);
}
__device__ __forceinline__ void qkt(f32x16& p0, f32x16& p1, const LAS char* K_lds, int r32, int hi, const bf16x8* qr) {
    p0 = f32x16{}; p1 = f32x16{};
    const LAS char* kb[4];
#pragma unroll
    for (int dd = 0; dd < 4; ++dd) kb[dd] = K_lds + KSWZ(r32, (dd * 16 + hi * 8) * 2);
#pragma unroll
    for (int d0 = 0; d0 < 8; ++d0) { const LAS char* a = kb[d0 & 3] + (d0 >> 2) * 128;
        const bf16x8 b0 = *reinterpret_cast<const LAS bf16x8*>(a);
        const bf16x8 b1 = *reinterpret_cast<const LAS bf16x8*>(a + 32 * 256);
        p0 = __builtin_amdgcn_mfma_f32_32x32x16_bf16(b0, qr[d0], p0, 0, 0, 0);
        p1 = __builtin_amdgcn_mfma_f32_32x32x16_bf16(b1, qr[d0], p1, 0, 0, 0); }
}
__device__ __forceinline__ void pv_tile(f32x16* o, int vb0, bf16x8 pa0, bf16x8 pa1, bf16x8 pa2, bf16x8 pa3) {
#define TRRD(dst, off) asm volatile("ds_read_b64_tr_b16 %0, %1 offset:%2" : "=&v"(dst) : "v"(vb0), "i"(off) : "memory")
#define PV_D0(d0) do { s16x4 l0, l1, l2, l3, h0, h1, h2, h3; constexpr int b_ = v_rd_off(d0, 0, 0); \
        TRRD(l0, b_); TRRD(h0, b_ + 2048); TRRD(l1, b_ + 4096); TRRD(h1, b_ + 6144); TRRD(l2, b_ + 8192); TRRD(h2, b_ + 10240); TRRD(l3, b_ + 12288); TRRD(h3, b_ + 14336); \
        asm volatile("s_waitcnt lgkmcnt(0)" ::: "memory"); SBAR();   \
        o[d0] = __builtin_amdgcn_mfma_f32_32x32x16_bf16(pa0, (bf16x8){l0[0], l0[1], l0[2], l0[3], h0[0], h0[1], h0[2], h0[3]}, o[d0], 0, 0, 0);   \
        o[d0] = __builtin_amdgcn_mfma_f32_32x32x16_bf16(pa1, (bf16x8){l1[0], l1[1], l1[2], l1[3], h1[0], h1[1], h1[2], h1[3]}, o[d0], 0, 0, 0);   \
        o[d0] = __builtin_amdgcn_mfma_f32_32x32x16_bf16(pa2, (bf16x8){l2[0], l2[1], l2[2], l2[3], h2[0], h2[1], h2[2], h2[3]}, o[d0], 0, 0, 0);   \
        o[d0] = __builtin_amdgcn_mfma_f32_32x32x16_bf16(pa3, (bf16x8){l3[0], l3[1], l3[2], l3[3], h3[0], h3[1], h3[2], h3[3]}, o[d0], 0, 0, 0); } while (0)
    PV_D0(0); PV_D0(1); PV_D0(2); PV_D0(3);
#undef PV_D0
#undef TRRD
}

struct Ctx {
    int tid, wid, lane, r32, hi, sr, sc, kws, vst0, vst1, vb0;
    LAS char* K_lds; LAS char* V_lds; LAS float* wscr;
};
__device__ __forceinline__ Ctx make_ctx(LAS unsigned char* lds) {
    Ctx c; c.tid = opaque_tid(); c.wid = __builtin_amdgcn_readfirstlane(c.tid >> 6); c.lane = c.tid & 63; c.r32 = c.lane & 31; c.hi = c.lane >> 5;
    c.sr = c.tid >> 4; c.sc = (c.tid & 15) * 8; c.kws = KSWZ(c.sr, c.sc * 2); c.vst0 = v_st(c.sr, c.sc); c.vst1 = v_st(32 + c.sr, c.sc);
    c.K_lds = (LAS char*)(lds + LDS_K); c.V_lds = (LAS char*)(lds + LDS_V); c.wscr = (LAS float*)(lds + LDS_WSCR) + c.wid * 64;
    c.vb0 = (int)(unsigned)(uintptr_t)c.V_lds + v_rd_base(c.lane);
    return c;
}
__device__ __forceinline__ void glds16(const void* sbase, unsigned voff, unsigned lds_dst) { unsigned keep;
    asm volatile("s_mov_b32 %0, m0\n\ts_mov_b32 m0, %3\n\ts_nop 0\n\tglobal_load_lds_dwordx4 %1, %2\n\ts_mov_b32 m0, %0" : "=&s"(keep) : "v"(voff), "s"(sbase), "s"(lds_dst) : "memory"); }
__device__ __forceinline__ const void* uniform_ptr(const void* p) { const unsigned long long v = (unsigned long long)p; const unsigned lo = __builtin_amdgcn_readfirstlane((unsigned)v), hi = __builtin_amdgcn_readfirstlane((unsigned)(v >> 32));
    return (const void*)(GAS const void*)(((unsigned long long)hi << 32) | lo); }
struct Dma { unsigned ko[2], vo[2]; };
__device__ __forceinline__ Dma make_dma(const Ctx& c, int ldk, int ldv) {
    Dma d;
#pragma unroll
    for (int i = 0; i < 2; ++i) { const int p = c.wid * 2 + i, row = 4 * p + (c.lane >> 4); d.ko[i] = (unsigned)(row * ldk + (((c.lane & 15) ^ (row & 7)) * 8)) * 2u;
        const int st = 2 * p + (c.lane >> 5), kk = (st >> 2) * 8 + ((c.lane & 31) >> 2), k = (kk & ~0xC) | ((kk & 4) << 1) | ((kk & 8) >> 1); d.vo[i] = (unsigned)(k * ldv + (st & 3) * 32 + (c.lane & 3) * 8) * 2u; }
    return d;
}
__device__ __forceinline__ void dma_tile(const Ctx& c, const Dma& d, const bf16_t* Kg, int ldk, const bf16_t* Vg, int ldv, int key0, int slot) {
    const void* kb = uniform_ptr(Kg + (size_t)key0 * ldk); const void* vb = uniform_ptr(Vg + (size_t)key0 * ldv);
#pragma unroll
    for (int i = 0; i < 2; ++i) {
        glds16(kb, d.ko[i], (unsigned)__builtin_amdgcn_readfirstlane((int)(unsigned)(uintptr_t)(c.K_lds + slot * TILE_B + (c.wid * 2 + i) * 1024)));
        glds16(vb, d.vo[i], (unsigned)__builtin_amdgcn_readfirstlane((int)(unsigned)(uintptr_t)(c.V_lds + slot * TILE_B + (c.wid * 2 + i) * 1024))); }
}
#define ATT_BAR() do { asm volatile("s_waitcnt lgkmcnt(0)" ::: "memory"); __builtin_amdgcn_s_barrier(); asm volatile("" ::: "memory"); } while (0)
__device__ __forceinline__ void rescale_o(f32x16* o, float alpha, const Ctx& c) {
    if (__any(alpha < 1.f)) { if (c.hi == 0) c.wscr[32 + c.r32] = alpha; LDS_WAIT();
#pragma unroll
        for (int d = 0; d < 4; ++d)
#pragma unroll
            for (int r = 0; r < 16; ++r) o[d][r] *= c.wscr[32 + crow(r, c.hi)];
        LDS_WAIT(); }
}
template <int MODE>
__device__ __forceinline__ void attn_loop_simple(const Ctx& c, const bf16_t* Kg, int ldk, const bf16_t* Vg, int ldv, int j_lo, int NT, const bf16x8* qr,
                                          int qpos, int qlo, int W, unsigned sel_lo, unsigned sel_hi, int diag, f32x16* o, float& m_reg, float& l_reg) {
    f32x16 p0, p1; bf16x8 pa0, pa1, pa2, pa3; float alpha;
    const Dma d = make_dma(c, ldk, ldv);
    dma_tile(c, d, Kg, ldk, Vg, ldv, j_lo * 64, 0);
    if (NT > 1) dma_tile(c, d, Kg, ldk, Vg, ldv, j_lo * 64 + 64, 1);
    int slot = 0, slot2 = 2;
    for (int t = 0; t < NT; ++t) { const int jt = j_lo + t, kb_ = jt * 64, bo = slot * TILE_B;
        if (t + 1 < NT) asm volatile("s_waitcnt vmcnt(4)" ::: "memory"); else asm volatile("s_waitcnt vmcnt(0)" ::: "memory");
        ATT_BAR();
        if (t + 2 < NT) dma_tile(c, d, Kg, ldk, Vg, ldv, kb_ + 128, slot2);
        SBAR(); qkt(p0, p1, c.K_lds + bo, c.r32, c.hi, qr); bool keep = true;
        if (MODE == 0) { if (kb_ + 63 > qlo || kb_ <= qlo + 31 - W) mask_tile(p0, p1, qpos - kb_ - 4 * c.hi, (unsigned)W); }
        else { const unsigned bit = (jt < 32 ? (sel_lo >> jt) : (sel_hi >> (jt - 32))) & 1u; keep = bit != 0u;
               if (jt == diag) mask_tile(p0, p1, qpos - kb_ - 4 * c.hi, 0x40000000u); }
        if (MODE == 2) softmax_step_keep(p0, p1, m_reg, l_reg, alpha, keep); else softmax_step(p0, p1, m_reg, l_reg, alpha); pack_p(p0, p1, pa0, pa1, pa2, pa3); rescale_o(o, alpha, c);
        pv_tile(o, c.vb0 + bo, pa0, pa1, pa2, pa3);
        slot = slot == 2 ? 0 : slot + 1; slot2 = slot2 == 2 ? 0 : slot2 + 1; }
    ATT_BAR();
}
template <int MODE>
__device__ __forceinline__ void attn_loop(const Ctx& c, const bf16_t* Kg, int ldk, const bf16_t* Vg, int ldv, int j_lo, int NT, const bf16x8* qr,
                                          int qpos, int qlo, int W, unsigned sel_lo, unsigned sel_hi, int diag, f32x16* o, float& m_reg, float& l_reg) {
    f32x16 pA0, pA1, pB0, pB1; bf16x8 pa0, pa1, pa2, pa3; float alpha;
    const Dma d = make_dma(c, ldk, ldv);
    dma_tile(c, d, Kg, ldk, Vg, ldv, j_lo * 64, 0);
    if (NT > 1) { dma_tile(c, d, Kg, ldk, Vg, ldv, j_lo * 64 + 64, 1); asm volatile("s_waitcnt vmcnt(4)" ::: "memory"); } else asm volatile("s_waitcnt vmcnt(0)" ::: "memory");
    ATT_BAR();
    if (NT > 2) dma_tile(c, d, Kg, ldk, Vg, ldv, j_lo * 64 + 128, 2);
    SBAR(); qkt(pA0, pA1, c.K_lds, c.r32, c.hi, qr);
#define ATT_STEP(PX0, PX1, PY0, PY1, t_) do { const int t = (t_), jt = j_lo + t, kb_ = jt * 64;                                          \
        if (t + 1 < NT) { if (t + 2 < NT) asm volatile("s_waitcnt vmcnt(4)" ::: "memory"); else asm volatile("s_waitcnt vmcnt(0)" ::: "memory"); }     \
        ATT_BAR();                                                                           \
        if (t + 3 < NT) dma_tile(c, d, Kg, ldk, Vg, ldv, kb_ + 192, (t + 3) & 3);                           \
        SBAR(); if (t + 1 < NT) qkt(PY0, PY1, c.K_lds + ((t + 1) & 3) * TILE_B, c.r32, c.hi, qr);          \
        SBAR();                                                                                  \
        if (MODE == 0) { if (kb_ + 63 > qlo || kb_ <= qlo + 31 - W) mask_tile(PX0, PX1, qpos - kb_ - 4 * c.hi, (unsigned)W); }            \
        else { const unsigned bit = (jt < 32 ? (sel_lo >> jt) : (sel_hi >> (jt - 32))) & 1u; mask_all(PX0, PX1, bit != 0u);               \
               if (jt == diag) mask_tile(PX0, PX1, qpos - kb_ - 4 * c.hi, 0x40000000u); }                                                \
        softmax_step(PX0, PX1, m_reg, l_reg, alpha); pack_p(PX0, PX1, pa0, pa1, pa2, pa3); rescale_o(o, alpha, c);                        \
        pv_tile(o, c.vb0 + (t & 3) * TILE_B, pa0, pa1, pa2, pa3); } while (0)
    for (int t2 = 0; t2 < NT; t2 += 2) { ATT_STEP(pA0, pA1, pB0, pB1, t2); if (t2 + 1 < NT) ATT_STEP(pB0, pB1, pA0, pA1, t2 + 1); }
#undef ATT_STEP
    ATT_BAR();
}
__device__ __forceinline__ void load_q(bf16x8* qr, const bf16_t* qrow, int hi) {
#pragma unroll
    for (int d0 = 0; d0 < 8; ++d0) qr[d0] = *(const bf16x8*)(qrow + d0 * 16 + hi * 8);
    asm volatile("" :: "v"(qr[0]), "v"(qr[1]), "v"(qr[2]), "v"(qr[3]), "v"(qr[4]), "v"(qr[5]), "v"(qr[6]), "v"(qr[7]));
}
template <bool ADD, bool OUT8 = false>
__device__ __forceinline__ void store_o(const f32x16* o, float frow, const Ctx& c, bf16_t* Og, int ldo, float fold_row = 1.0f, bool has_fold = false, unsigned char* O8 = nullptr) {
    if (c.hi == 0) { c.wscr[c.r32] = frow; c.wscr[32 + c.r32] = fold_row; } LDS_WAIT();
    LAS float* stg = (LAS float*)(c.K_lds + c.wid * 16384);
#pragma unroll
    for (int r = 0; r < 16; ++r) { const int row = crow(r, c.hi); const float f = c.wscr[row];
#pragma unroll
        for (int d0 = 0; d0 < 4; ++d0) stg[row * 128 + d0 * 32 + c.r32] = o[d0][r] * f; }
    LDS_WAIT();
    const int cc = c.lane & 15, rq = c.lane >> 4;
#pragma unroll
    for (int hb = 0; hb < 8; hb += 4) {
        int hbv = hb; asm volatile("" : "+v"(hbv));
        u32x4 old[4];
        if (ADD) {
#pragma unroll
            for (int i = 0; i < 4; ++i) old[i] = *(const u32x4*)(Og + (size_t)(rq + 4 * (hbv + i)) * 1024 + cc * 8);
        }
#pragma unroll
        for (int i = 0; i < 4; ++i) { const int row = rq + 4 * (hbv + i);
            f32x4 v0 = *(const LAS f32x4*)(stg + row * 128 + cc * 8), v1 = *(const LAS f32x4*)(stg + row * 128 + cc * 8 + 4);
            if (ADD) { const float fo = has_fold ? c.wscr[32 + row] : 1.0f;
                v0[0] = fmaf(bf_lo(old[i].x), fo, v0[0]); v0[1] = fmaf(bf_hi(old[i].x), fo, v0[1]); v0[2] = fmaf(bf_lo(old[i].y), fo, v0[2]); v0[3] = fmaf(bf_hi(old[i].y), fo, v0[3]);
                v1[0] = fmaf(bf_lo(old[i].z), fo, v1[0]); v1[1] = fmaf(bf_hi(old[i].z), fo, v1[1]); v1[2] = fmaf(bf_lo(old[i].w), fo, v1[2]); v1[3] = fmaf(bf_hi(old[i].w), fo, v1[3]); }
            if constexpr (OUT8) { u32x2 w; w.x = cvt4_fp8(v0[0] * O8_SCALE, v0[1] * O8_SCALE, v0[2] * O8_SCALE, v0[3] * O8_SCALE); w.y = cvt4_fp8(v1[0] * O8_SCALE, v1[1] * O8_SCALE, v1[2] * O8_SCALE, v1[3] * O8_SCALE);
                *(u32x2*)(O8 + (size_t)row * ldo + cc * 8) = w; }
            else { u32x4 w; w.x = cvt_pk_bf16(v0[0], v0[1]); w.y = cvt_pk_bf16(v0[2], v0[3]); w.z = cvt_pk_bf16(v1[0], v1[1]); w.w = cvt_pk_bf16(v1[2], v1[3]);
                *(u32x4*)(Og + (size_t)row * ldo + cc * 8) = w; } }
        asm volatile("" ::: "memory");
    }
    LDS_WAIT();
}
}

struct Frame {
    LAS unsigned char* lds; volatile LAS unsigned* misc; unsigned* ctl;
    int tid, lane, wave, G, vcu;
    const float* const* in; float* out; unsigned char* ws;
};
__device__ __forceinline__ void launder(Frame& F) { unsigned long long w_ = (unsigned long long)F.ws; asm volatile("" : "+s"(w_)); F.ws = (unsigned char*)(GAS unsigned char*)w_; F.out = (float*)(GAS float*)F.out; F.ctl = (unsigned*)(GAS unsigned*)F.ctl; asm volatile("" : "+v"(F.tid)); F.lane = F.tid & 63; F.wave = __builtin_amdgcn_readfirstlane(F.tid >> 6); }
enum { IN_X = 0, IN_ANORM, IN_WIN, IN_SINK, IN_PEK, IN_PEV, IN_WK1, IN_WK2, IN_WV1, IN_WV2, IN_WUPA, IN_WUPB, IN_WO, IN_FNORM, IN_DWG, IN_DWU, IN_DWD, IN_RW, IN_MWG, IN_MWU, IN_MWD, IN_FINAL };
#define INP(i) ((const float*)(const GAS float*)F.in[i])
#define WSP(T_, off) ((T_*)(F.ws + (off)))
#define BGP(T_, off) ((T_*)(F.ws + WS_BIG + (off)))

__device__ __forceinline__ int queue_pop(Frame& F, int q) {
    __syncthreads();
    if (F.tid == 0) F.misc[2] = __hip_atomic_fetch_add(F.ctl + CW_QUEUE + 64 * q, 1u, RLX_AGENT);
    __syncthreads();
    return (int)F.misc[2];
}

__device__ __forceinline__ int tr_drow(int mode, int n, int nn) {
    if (mode == 0) return n;
    if (mode == 1) { if (n < 4096) { const int d = n & 127; return (n & ~127) + 32 * ((d >> 4) & 3) + 8 * ((d >> 2) & 3) + 4 * (d >> 6) + (d & 3); }
                     return n < 4120 ? 8192 + (n - 4096) : 4096 + (n - 4120); }
    return 256 * (n >> 7) + 128 * nn + (n & 127);
}
__device__ __forceinline__ void tr_item(int mode, int nn, const float* W, int ld, int nsrc, const float* gain, int K, bf16_t* WT, int item, int nblk, int lane) {
    const int kb = item / nblk, nb = item - kb * nblk, kg = lane & 7, nq = lane >> 3, k0 = 64 * kb + 8 * kg, n = 32 * nb + 4 * nq;
    if (n >= nsrc) return;
    const float* p = W + (size_t)k0 * ld + n; f32x4 v[8];
#pragma unroll
    for (int j = 0; j < 8; ++j) v[j] = __builtin_nontemporal_load((const f32x4*)(p + (size_t)j * ld));
    if (gain) { const f32x4 g0 = *(const f32x4*)(gain + k0), g1 = *(const f32x4*)(gain + k0 + 4);
#pragma unroll
        for (int j = 0; j < 4; ++j) { v[j] = v[j] * g0[j]; v[4 + j] = v[4 + j] * g1[j]; } }
    const int c = tr_drow(mode, n, nn);
#pragma unroll
    for (int q = 0; q < 4; ++q) { u32x4 o; o.x = cvt_pk_bf16(v[0][q], v[1][q]); o.y = cvt_pk_bf16(v[2][q], v[3][q]); o.z = cvt_pk_bf16(v[4][q], v[5][q]); o.w = cvt_pk_bf16(v[6][q], v[7][q]);
        *(u32x4*)(WT + (size_t)(c + q) * K + k0) = o; }
}
__device__ __forceinline__ void tr_item8(int mode, int nn, const float* W, int ld, int nsrc, const float* gain, float scale, int K, unsigned char* WT, int item, int nblk, int lane) {
    const int kb = item / nblk, nb = item - kb * nblk, kg = lane & 7, nq = lane >> 3, k0 = 128 * kb + 16 * kg, n = 32 * nb + 4 * nq;
    if (n >= nsrc) return;
    const float* p = W + (size_t)k0 * ld + n; f32x4 v[16];
#pragma unroll
    for (int j = 0; j < 16; ++j) v[j] = __builtin_nontemporal_load((const f32x4*)(p + (size_t)j * ld));
#pragma unroll
    for (int j4 = 0; j4 < 4; ++j4) { f32x4 g = {scale, scale, scale, scale}; if (gain) g = *(const f32x4*)(gain + k0 + 4 * j4) * scale;
#pragma unroll
        for (int j = 0; j < 4; ++j) v[4 * j4 + j] = v[4 * j4 + j] * g[j]; }
    const int c = tr_drow(mode, n, nn);
#pragma unroll
    for (int q = 0; q < 4; ++q) { u32x4 o; o.x = cvt4_fp8(v[0][q], v[1][q], v[2][q], v[3][q]); o.y = cvt4_fp8(v[4][q], v[5][q], v[6][q], v[7][q]); o.z = cvt4_fp8(v[8][q], v[9][q], v[10][q], v[11][q]); o.w = cvt4_fp8(v[12][q], v[13][q], v[14][q], v[15][q]);
        __builtin_nontemporal_store(o, (u32x4*)(WT + (size_t)(c + q) * K + k0)); }
}
__device__ __forceinline__ void p_prologue(Frame F) {
    launder(F);
    const int gw = F.vcu * NWAVES + F.wave, NGW = F.G * NWAVES, lane = F.lane;
    constexpr int NB_IN = (IN_DIM + 31) / 32;
    { long long* cb = WSP(long long, WS_CBIAS);
      for (int u = gw; u < 1024; u += NGW) { const int q = u >> 8, l = q >> 1, kv = q & 1, nb = (u >> 6) & 3, kc = u & 63, n = nb * 64 + lane;
          const float* pe = INP(kv ? IN_PEV : IN_PEK) + (size_t)l * 4096 + kc * 64; const float* w1 = INP(kv ? IN_WV1 : IN_WK1) + (size_t)l * 4096 * 256 + (size_t)kc * 64 * 256 + n;
          float wv[64];
#pragma unroll
          for (int k = 0; k < 64; ++k) wv[k] = w1[(size_t)k * 256];
          float a0 = 0.f, a1 = 0.f, a2 = 0.f, a3 = 0.f;
#pragma unroll
          for (int k = 0; k < 64; k += 4) { a0 = fmaf(pe[k], wv[k], a0); a1 = fmaf(pe[k + 1], wv[k + 1], a1); a2 = fmaf(pe[k + 2], wv[k + 2], a2); a3 = fmaf(pe[k + 3], wv[k + 3], a3); }
          const float sum = (a0 + a1) + (a2 + a3);
          atomicAdd((unsigned long long*)(cb + q * 256 + n), (unsigned long long)(long long)rintf(sum * CB_SCALE)); } }
    constexpr int I_WIN = (D / 128) * NB_IN, I_W1 = (4096 / 64) * (256 / 32), I_W2 = (256 / 64) * (128 / 32), I_WUP = (1024 / 128) * (D / 32), I_WO = (D / 128) * (D / 32);
    {   constexpr int BI_G = (D / 128) * (FF / 256), BI_D = (FF / 128) * (D / 256), NBI = 16 * BI_G + 9 * BI_D;
        LAS unsigned char* tile = F.lds;
        for (int bi = F.vcu; bi < NBI; bi += F.G) {
            const float* W; const float* gain = nullptr; float scale; unsigned char* dst; int ld, Kd, mode = 0, nn = 0, kb, nb;
            if (bi < 16 * BI_G) { const int q = bi / BI_G, r = bi - q * BI_G, e = q >> 1; nn = q & 1; mode = 2; W = INP(nn ? IN_MWU : IN_MWG) + (size_t)e * D * FF; ld = FF; gain = INP(IN_FNORM) + D; scale = WGU8_SCALE;
                dst = WSP(unsigned char, WS_WGUM + (size_t)e * SZ_WGU8); Kd = D; kb = r / (FF / 256); nb = r - kb * (FF / 256); }
            else { const int r0 = bi - 16 * BI_G, e = r0 / BI_D, r = r0 - e * BI_D; ld = D; scale = WD8_SCALE;
                if (e < 8) { W = INP(IN_MWD) + (size_t)e * FF * D; dst = WSP(unsigned char, WS_WDM + (size_t)e * SZ_WD8); } else { W = INP(IN_DWD); dst = WSP(unsigned char, WS_WDD); }
                Kd = FF; kb = r / (D / 256); nb = r - kb * (D / 256); }
            const int k0 = 128 * kb + 16 * F.wave, n = 256 * nb + 4 * lane;
            const float* p = W + (size_t)k0 * ld + n; f32x4 v[16];
#pragma unroll
            for (int j = 0; j < 16; ++j) v[j] = __builtin_nontemporal_load((const f32x4*)(p + (size_t)j * ld));
#pragma unroll
            for (int j = 0; j < 16; ++j) { const float g = gain ? gain[k0 + j] * scale : scale; v[j] = v[j] * g; }
#pragma unroll
            for (int q = 0; q < 4; ++q) { u32x4 o; o.x = cvt4_fp8(v[0][q], v[1][q], v[2][q], v[3][q]); o.y = cvt4_fp8(v[4][q], v[5][q], v[6][q], v[7][q]); o.z = cvt4_fp8(v[8][q], v[9][q], v[10][q], v[11][q]); o.w = cvt4_fp8(v[12][q], v[13][q], v[14][q], v[15][q]);
                *(LAS u32x4*)(tile + (4 * lane + q) * 144 + 16 * F.wave) = o; }
            __syncthreads();
#pragma unroll
            for (int i = 0; i < 4; ++i) { const int nrow = 32 * F.wave + 8 * i + (lane >> 3), ch = lane & 7;
                const u32x4 o = *(const LAS u32x4*)(tile + nrow * 144 + 16 * ch);
                __builtin_nontemporal_store(o, (u32x4*)(dst + (size_t)tr_drow(mode, 256 * nb + nrow, nn) * Kd + 128 * kb + 16 * ch)); }
            __syncthreads();
        }
    }
    constexpr int I_G = (D / 64) * (FF / 32);
    constexpr int NITEMS = 2 * I_WIN + 4 * I_W1 + 4 * I_W2 + 4 * I_WUP + 2 * I_WO + 2 * I_G;
    for (int it = gw; it < NITEMS; it += NGW) {
        int r = it;
        if (r < 2 * I_G) { const int nn = r / I_G; r -= nn * I_G;
            tr_item(2, nn, INP(nn ? IN_DWU : IN_DWG), FF, FF, INP(IN_FNORM), D, WSP(bf16_t, WS_WGUD), r, FF / 32, lane); continue; } r -= 2 * I_G;
        if (r < 2 * I_WIN) { const int l = r / I_WIN; r -= l * I_WIN;
            tr_item8(1, 0, INP(IN_WIN) + (size_t)l * D * IN_DIM, IN_DIM, IN_DIM, INP(IN_ANORM) + l * D, WIN8_SCALE, D, WSP(unsigned char, WS_WIN + l * SZ_WIN), r, NB_IN, lane); continue; } r -= 2 * I_WIN;
        if (r < 4 * I_W1) { const int q = r / I_W1; r -= q * I_W1; const int l = q >> 1, kv = q & 1;
            tr_item(0, 0, INP(kv ? IN_WV1 : IN_WK1) + (size_t)l * 4096 * 256, 256, 256, nullptr, 4096, WSP(bf16_t, WS_W1 + q * SZ_W1), r, 256 / 32, lane); continue; } r -= 4 * I_W1;
        if (r < 4 * I_W2) { const int q = r / I_W2; r -= q * I_W2; const int l = q >> 1, kv = q & 1;
            tr_item(0, 0, INP(kv ? IN_WV2 : IN_WK2) + (size_t)l * 256 * 128, 128, 128, nullptr, 256, WSP(bf16_t, WS_W2 + q * SZ_W2), r, 128 / 32, lane); continue; } r -= 4 * I_W2;
        if (r < 4 * I_WUP) { const int q = r / I_WUP; r -= q * I_WUP; const int l = q >> 1, ab = q & 1;
            tr_item8(0, 0, INP(ab ? IN_WUPB : IN_WUPA) + (size_t)l * 1024 * D, D, D, nullptr, WUP8_SCALE, 1024, WSP(unsigned char, WS_WUP + q * SZ_WUP), r, D / 32, lane); continue; } r -= 4 * I_WUP;
        { const int l = r / I_WO; r -= l * I_WO;
            tr_item8(0, 0, INP(IN_WO) + (size_t)l * D * D, D, D, nullptr, WO8_SCALE, D, WSP(unsigned char, WS_WO + l * SZ_WO), r, D / 32, lane); }
    }
    { const int gt = gw * 64 + lane, NGT = NGW * 64; const u32x4 z = {0u, 0u, 0u, 0u};
      for (int i = gt; i < 2 * (NIN - IN_DIM) * (D / 16); i += NGT) { const int l = i / ((NIN - IN_DIM) * (D / 16)), j = i - l * ((NIN - IN_DIM) * (D / 16)); *((u32x4*)(WSP(unsigned char, WS_WIN + l * SZ_WIN) + (size_t)IN_DIM * D) + j) = z; }
      for (int i = gt; i < 4 * 128 * (256 / 8); i += NGT) { const int q = i / (128 * 32), j = i - q * (128 * 32); *((u32x4*)(WSP(bf16_t, WS_W2 + q * SZ_W2) + (size_t)128 * 256) + j) = z; } }
    { const float* x = INP(IN_X); unsigned char* x8 = WSP(unsigned char, WS_X8); u64* rsq = WSP(u64, WS_RSQ);
      for (int m = gw; m < M; m += NGW) { const f32x4* xr = (const f32x4*)(x + (size_t)m * D) + lane; f32x4 v[8]; float s = 0.f;
#pragma unroll
          for (int j = 0; j < 8; ++j) { v[j] = xr[64 * j]; s += (v[j][0] * v[j][0] + v[j][1] * v[j][1]) + (v[j][2] * v[j][2] + v[j][3] * v[j][3]); }
          s = wave_sum(s); if (lane == 0) rsq[m] = (u64)(s * RSQ_SCALE + 0.5f);
          unsigned* o4 = (unsigned*)(x8 + (size_t)m * D) + lane;
#pragma unroll
          for (int j = 0; j < 8; ++j) o4[64 * j] = cvt4_fp8(v[j][0], v[j][1], v[j][2], v[j][3]); } }
    { float* cosT = WSP(float, WS_ROPE); float* sinT = cosT + T * 64; const int gt = gw * 64 + lane, NGT = NGW * 64;
      for (int i = gt; i < T * 64; i += NGT) { const int t = i >> 6, d = i & 63; const float inv = (float)exp(-9.210340371976184 * (double)d / 64.0); const float ang = (float)t * inv;
          cosT[i] = (float)cos((double)ang); sinT[i] = (float)sin((double)ang); } }
}

__device__ __forceinline__ void p_attn_a(Frame F, int layer) {
    launder(F);
    bf16_t* QKV = BGP(bf16_t, BG_QKV); const bf16_t* NGb = BGP(bf16_t, BG_NG);
#ifndef NO_CMP
    if (blockIdx.x < 16) {
        const int kv = blockIdx.x >> 3, pm = blockIdx.x & 7, q = layer * 2 + kv;
        bf16_t* H = BGP(bf16_t, BG_HC) + (size_t)kv * 2048 * 256;
        { pg8::SchedOne S{BGP(bf16_t, kv ? BG_VCB : BG_KCB), WSP(bf16_t, WS_W1 + q * SZ_W1), 2048 * 2, 4096 * 2, pm, 0};
          pg8::EpiCmp1 E{H, WSP(long long, WS_CBIAS) + q * 256};
          pg8::gemm_phase<false>(F.lds, 4096 * 2, S, E); }
        VM_WAIT(); __syncthreads(); __builtin_amdgcn_fence(__ATOMIC_ACQUIRE, "agent"); VM_WAIT(); __syncthreads();
        { pg8::SchedOne S{H, WSP(bf16_t, WS_W2 + q * SZ_W2), 256 * 2, 256 * 2, pm, 0};
          pg8::EpiCmp2 E{BGP(bf16_t, kv ? BG_VCMP : BG_KCMP)};
          pg8::gemm_phase<false>(F.lds, 256 * 2, S, E); }
        __syncthreads();
    }
#endif
    const att::Ctx c = att::make_ctx(F.lds);
    const float* sinks = INP(IN_SINK) + layer * 8;
    const int nstat = (int)F.G - 16; bool first = blockIdx.x >= 16;
    for (;;) {
        int u = first ? (int)blockIdx.x - 16 : nstat + queue_pop(F, layer * 2 + 0); first = false; if (u >= 1024 + 64) break;
        if (u < 64) {
            pg8::SchedOne S{WSP(unsigned char, WS_X8), WSP(unsigned char, WS_WIN + layer * SZ_WIN), D, D, u, 32};
            pg8::EpiIn E{BGP(bf16_t, BG_QKV), BGP(bf16_t, BG_KCB), BGP(bf16_t, BG_VCB), BGP(bf16_t, BG_GM), BGP(bf16_t, BG_NG), WSP(u64, WS_RSQ) + (2 * layer) * M, WSP(float, WS_ROPE), WSP(float, WS_ROPE) + T * 64, 1.0f / WIN8_SCALE, F.lds + LDS_WSCR};
            pg8::gemm_phase<true>(F.lds, D, S, E); __syncthreads(); continue; }
        u -= 64;
        const bool swa = u >= 512; const int v = u & 511, qt = 63 - (v >> 3), bg = v & 7, b = bg >> 1, g = bg & 1;
        const int t0 = qt * 64, h = 4 * g + (c.wid >> 1), trow = t0 + 32 * (c.wid & 1);
        const size_t rowbase = (size_t)b * T;
        const int qcol = (swa ? 0 : 1536) + h * HD, kcol = (swa ? 1024 : 3584) + g * HD, vcol = (swa ? 1280 : 3840) + g * HD, W = swa ? 128 : 512;
        bf16x8 qr[8]; att::load_q(qr, QKV + (rowbase + trow + c.r32) * 4096 + qcol, c.hi);
        const int j_lo = (t0 - W + 1) > 0 ? (t0 - W + 1) / 64 : 0, NT = qt - j_lo + 1;
        f32x16 o[4] = {}; float m_reg = -1e30f, l_reg = 0.f;
        att::attn_loop<0>(c, QKV + rowbase * 4096 + kcol, 4096, QKV + rowbase * 4096 + vcol, 4096, j_lo, NT, qr, trow + c.r32, trow, W, 0u, 0u, -1, o, m_reg, l_reg);
        float f;
        if (swa) { const float lt = l_reg + __builtin_amdgcn_exp2f(sinks[h] * att::LOG2E - m_reg * att::C2); f = 1.0f / lt; }
        else f = 1.0f / l_reg;
        if (swa) att::store_o<false, true>(o, f, c, nullptr, 1024, 1.0f, false, BGP(unsigned char, BG_OA) + (rowbase + trow) * 1024 + h * HD);
        else att::store_o<false>(o, f, c, BGP(bf16_t, BG_OB) + (rowbase + trow) * 1024 + h * HD, 1024);
    }
}

__device__ __forceinline__ void p_attn_b(Frame F, int layer) {
    launder(F);
    const bf16_t* QKV = BGP(bf16_t, BG_QKV); const bf16_t* NGb = BGP(bf16_t, BG_NG);
    const att::Ctx c = att::make_ctx(F.lds);
    LAS unsigned* IMP = (LAS unsigned*)(F.lds + LDS_IMP);
    volatile LAS unsigned* SELM = (volatile LAS unsigned*)(F.lds + LDS_SELM);
    bool first = true;
    for (;;) {
        const int u = first ? (int)blockIdx.x : (int)F.G + queue_pop(F, layer * 2 + 1); first = false; if (u >= 512) break;
        const int qt = 63 - (u >> 3), bg = u & 7, b = bg >> 1, g = bg & 1;
        const int t0 = qt * 64, h = 4 * g + (c.wid >> 1), trow = t0 + 32 * (c.wid & 1), tl = 32 * (c.wid & 1) + c.r32;
        const size_t rowbase = (size_t)b * T; const int pos = trow + c.r32;
        for (int i = c.tid; i < 64 * 65; i += NTHREADS) IMP[i] = 0u;
        bf16x8 qr[8]; att::load_q(qr, QKV + (rowbase + pos) * 4096 + 1536 + h * HD, c.hi);
        const int maxc = (t0 + 63 - 31) >> 4, NTc = (maxc >> 6) + 1;
        const bf16_t* Kc = BGP(bf16_t, BG_KCMP) + (size_t)bg * 256 * HD; const bf16_t* Vc = BGP(bf16_t, BG_VCMP) + (size_t)bg * 256 * HD;
        { const att::Dma dc = att::make_dma(c, HD, HD); for (int j = 0; j < NTc; ++j) att::dma_tile(c, dc, Kc, HD, Vc, HD, j * 64, j); }
        VM_WAIT(); __syncthreads();
        const int cpos = (pos - 31) >> 4;
        float m_reg = -1e30f, l_reg = 0.f;
        {
            f32x16 p0, p1; float alpha;
#pragma unroll 1
            for (int J = 0; J < NTc; ++J) { att::qkt(p0, p1, c.K_lds + J * att::TILE_B, c.r32, c.hi, qr); att::mask_tile(p0, p1, cpos - J * 64 - 4 * c.hi, 0x40000000u); att::softmax_step(p0, p1, m_reg, l_reg, alpha); }
        }
        f32x16 o[4] = {};
        {
            const float inv_l = l_reg > 0.f ? 1.0f / l_reg : 0.f, mnL = -m_reg * att::C2; f32x16 p0, p1; bf16x8 pa0, pa1, pa2, pa3;
#pragma unroll 1
            for (int J = 0; J < NTc; ++J) { att::qkt(p0, p1, c.K_lds + J * att::TILE_B, c.r32, c.hi, qr); att::mask_tile(p0, p1, cpos - J * 64 - 4 * c.hi, 0x40000000u);
#pragma unroll
                for (int r = 0; r < 16; ++r) { p0[r] = __builtin_amdgcn_exp2f(fmaf(p0[r], att::C2, mnL)) * inv_l; p1[r] = __builtin_amdgcn_exp2f(fmaf(p1[r], att::C2, mnL)) * inv_l; }
                LAS unsigned* irow = IMP + tl * 65 + J * 16 + c.hi; constexpr float IS = 67108864.0f;
#pragma unroll
                for (int jj = 0; jj < 4; ++jj) {
                    atomicAdd((unsigned*)(irow + 2 * jj), (unsigned)((p0[4 * jj] + p0[4 * jj + 1] + p0[4 * jj + 2] + 0.5f * p0[4 * jj + 3]) * IS + 0.5f)); atomicAdd((unsigned*)(irow + 2 * jj + 1), (unsigned)(0.5f * p0[4 * jj + 3] * IS + 0.5f));
                    atomicAdd((unsigned*)(irow + 2 * jj + 8), (unsigned)((p1[4 * jj] + p1[4 * jj + 1] + p1[4 * jj + 2] + 0.5f * p1[4 * jj + 3]) * IS + 0.5f)); atomicAdd((unsigned*)(irow + 2 * jj + 9), (unsigned)(0.5f * p1[4 * jj + 3] * IS + 0.5f)); }
                att::pack_p(p0, p1, pa0, pa1, pa2, pa3); att::pv_tile(o, c.vb0 + J * att::TILE_B, pa0, pa1, pa2, pa3); }
        }
        bf16_t* Og = BGP(bf16_t, BG_OB) + (rowbase + trow) * 1024 + h * HD;
        __syncthreads();
        { const float g0 = bf2f(NGb[(rowbase + pos) * 32 + h * 3 + 0]), g2 = bf2f(NGb[(rowbase + pos) * 32 + h * 3 + 2]); att::store_o<true>(o, g0, c, Og, 1024, g2, true); }
        for (int i = 0; i < 8; ++i) { const int tk = c.wid * 8 + i, s = c.lane; volatile LAS unsigned* row = (volatile LAS unsigned*)IMP + tk * 65;
            const unsigned raw = row[s]; const bool forced = (s == 0) | (s == qt) | (s == qt - 1), valid = s <= qt;
            unsigned key = ((((raw >> 6) + 1u) << 6) | (unsigned)(63 - s)); key = forced ? (0xFFFFFFC0u | (unsigned)(63 - s)) : key; key = valid ? key : 0u;
            row[s] = key; LDS_WAIT();
            int rank = 0;
#pragma unroll 16
            for (int j = 0; j < 64; ++j) rank += (row[j] > key) ? 1 : 0;
            const unsigned long long bal = __ballot(rank < 16 && key != 0u);
            if (c.lane == 0) { SELM[2 * tk] = (unsigned)bal; SELM[2 * tk + 1] = (unsigned)(bal >> 32); } }
        __syncthreads();
        const unsigned sel_lo = SELM[2 * tl], sel_hi = SELM[2 * tl + 1];
#pragma unroll
        for (int d = 0; d < 4; ++d) o[d] = f32x16{};
        m_reg = -1e30f; l_reg = 0.f;
        att::attn_loop_simple<2>(c, QKV + rowbase * 4096 + 3072 + g * HD, 4096, QKV + rowbase * 4096 + 3328 + g * HD, 4096, 0, qt + 1, qr, pos, trow, 0, sel_lo, sel_hi, qt, o, m_reg, l_reg);
        { const float g1 = bf2f(NGb[(rowbase + pos) * 32 + h * 3 + 1]); VM_WAIT(); att::store_o<true, true>(o, g1 / l_reg, c, Og, 1024, 1.0f, false, BGP(unsigned char, BG_OA) + (size_t)M * 1024 + (rowbase + trow) * 1024 + h * HD); }
    }
}

__device__ __forceinline__ void p_router(Frame F) {
    launder(F);
    LAS float* wr = (LAS float*)F.lds;
    const float* rw = INP(IN_RW); const float* gain = INP(IN_FNORM) + D;
    for (int i = F.tid; i < D * 8; i += NTHREADS) wr[i] = rw[i] * gain[i >> 3];
    LAS int* te = (LAS int*)(F.lds + 65536); LAS float* tw = (LAS float*)(F.lds + 65536 + 1024);
    const bf16_t* XB = WSP(bf16_t, WS_XBF); const u64* rsq = WSP(u64, WS_RSQ) + 3 * M;
    int* ltok = WSP(int, WS_LTOK); float* lw = WSP(float, WS_LW); int* slot = WSP(int, WS_SLOT);
    for (int chunk = blockIdx.x; chunk < M / 64; chunk += F.G) {
        __syncthreads();
        for (int i = 0; i < 8; ++i) { const int tl = F.wave * 8 + i, tok = chunk * 64 + tl;
            const u32x2* xr = (const u32x2*)(XB + (size_t)tok * D) + F.lane; float a[8] = {0.f, 0.f, 0.f, 0.f, 0.f, 0.f, 0.f, 0.f};
#pragma unroll
            for (int j = 0; j < 8; ++j) { const u32x2 xw = xr[64 * j]; const f32x4 x = {bf_lo(xw.x), bf_hi(xw.x), bf_lo(xw.y), bf_hi(xw.y)}; const int k = 4 * (F.lane + 64 * j);
#pragma unroll
                for (int q = 0; q < 4; ++q) { const f32x4 w0 = *(const LAS f32x4*)(wr + (k + q) * 8), w1 = *(const LAS f32x4*)(wr + (k + q) * 8 + 4);
                    a[0] = fmaf(x[q], w0[0], a[0]); a[1] = fmaf(x[q], w0[1], a[1]); a[2] = fmaf(x[q], w0[2], a[2]); a[3] = fmaf(x[q], w0[3], a[3]);
                    a[4] = fmaf(x[q], w1[0], a[4]); a[5] = fmaf(x[q], w1[1], a[5]); a[6] = fmaf(x[q], w1[2], a[6]); a[7] = fmaf(x[q], w1[3], a[7]); } }
            const float rstd = rstd_of(rsq, tok);
#pragma unroll
            for (int e = 0; e < 8; ++e) a[e] = wave_sum(a[e]) * rstd;
            int e1 = 0; float l1 = a[0];
#pragma unroll
            for (int e = 1; e < 8; ++e) if (a[e] > l1) { l1 = a[e]; e1 = e; }
            int e2 = -1; float l2 = -3.0e38f;
#pragma unroll
            for (int e = 0; e < 8; ++e) if (e != e1 && a[e] > l2) { l2 = a[e]; e2 = e; }
            const float ex = __expf(l2 - l1), w1 = 1.0f / (1.0f + ex), w2 = ex * w1;
            if (F.lane == 0) { te[tl] = e1; te[64 + tl] = e2; tw[tl] = w1; tw[64 + tl] = w2; } }
        __syncthreads();
        if (F.wave == 0) { const int tl = F.lane, tok = chunk * 64 + tl, e1 = te[tl], e2 = te[64 + tl]; const float w1 = tw[tl], w2 = tw[64 + tl];
            const unsigned long long lt = (1ull << tl) - 1ull;
            int myn = 0;
#pragma unroll
            for (int e = 0; e < 8; ++e) { const int n = __popcll(__ballot(e1 == e)) + __popcll(__ballot(e2 == e)); if (tl == e) myn = n; }
            int mybase = 0; if (tl < 8 && myn > 0) mybase = (int)__hip_atomic_fetch_add(F.ctl + CW_ECNT + 64 * tl, (unsigned)myn, RLX_AGENT);
#pragma unroll
            for (int e = 0; e < 8; ++e) { const unsigned long long m1 = __ballot(e1 == e), m2 = __ballot(e2 == e); const int n1 = __popcll(m1);
                const int base = __shfl(mybase, e);
                if (e1 == e) { const int p = base + __popcll(m1 & lt); ltok[e * M + p] = tok; lw[e * M + p] = w1; slot[2 * tok] = (e << 20) | p; }
                if (e2 == e) { const int p = base + n1 + __popcll(m2 & lt); ltok[e * M + p] = tok; lw[e * M + p] = w2; slot[2 * tok + 1] = (e << 20) | p; } } }
    }
}
__device__ __forceinline__ void moe_counts(Frame& F) {
    __syncthreads();
    if (F.tid < 64) {
        int cnt = 0; if (F.tid < NE) cnt = (int)__hip_atomic_load(F.ctl + CW_ECNT + 64 * F.tid, RLX_AGENT);
        const int tiles = (cnt + 255) >> 8; int incl = tiles;
#pragma unroll
        for (int d = 1; d < 8; d <<= 1) { const int t = __shfl_up(incl, d); if (F.tid >= d) incl += t; }
        if (F.tid < NE) { F.misc[8 + F.tid] = (unsigned)cnt; F.misc[16 + F.tid] = (unsigned)(incl - tiles); }
        const int acc = __shfl(incl, NE - 1);
        if (F.tid == 0) { F.misc[24] = (unsigned)acc;
            int per_round = F.G / (D / 256); asm volatile("" : "+v"(per_round));
            const int tm = (acc / per_round) * per_round, tu = (acc - tm) * (D / 256);
            F.misc[25] = (unsigned)tm; F.misc[26] = (tu > 0 && tu * 4 <= F.G) ? 4u : ((tu > 0 && tu * 2 <= F.G) ? 2u : 1u); } }
    __syncthreads();
}
__device__ __forceinline__ void p_final(Frame F) {
    launder(F);
    moe_counts(F);
    const int gw = F.vcu * NWAVES + F.wave, NGW = F.G * NWAVES, lane = F.lane;
    const bf16_t* XB = WSP(bf16_t, WS_XBF); const bf16_t* YS = WSP(bf16_t, WS_YS); const int* slot = WSP(int, WS_SLOT); const float* gf = INP(IN_FINAL);
    const int Tm = (int)F.misc[25], S = (int)F.misc[26]; const bf16_t* YT = BGP(bf16_t, BG_YT);
    for (int m = gw; m < M; m += NGW) {
        const int s0 = slot[2 * m], s1 = slot[2 * m + 1];
        const size_t r0 = (size_t)F.misc[16 + (s0 >> 20)] * 256 + (s0 & 0xfffff), r1 = (size_t)F.misc[16 + (s1 >> 20)] * 256 + (s1 & 0xfffff);
        const u32x2* xr = (const u32x2*)(XB + (size_t)m * D) + lane;
        f32x4 v[8];
#pragma unroll
        for (int j = 0; j < 8; ++j) { const u32x2 a = xr[64 * j]; v[j] = f32x4{bf_lo(a.x), bf_hi(a.x), bf_lo(a.y), bf_hi(a.y)}; }
#pragma unroll
        for (int q = 0; q < 2; ++q) { const size_t r = q ? r1 : r0; const bool tail = (int)(r >> 8) >= Tm;
            const bf16_t* base = tail ? YT + (r - (size_t)Tm * 256) * D : YS + r * D; const int nrep = tail ? S : 1;
            for (int k = 0; k < nrep; ++k) { const u32x2* y = (const u32x2*)(base + (size_t)k * YT_ROWS * D) + lane;
#pragma unroll
                for (int j = 0; j < 8; ++j) { const u32x2 a = y[64 * j]; v[j][0] += bf_lo(a.x); v[j][1] += bf_hi(a.x); v[j][2] += bf_lo(a.y); v[j][3] += bf_hi(a.y); } } }
        float s = 0.f;
#pragma unroll
        for (int j = 0; j < 8; ++j) s += (v[j][0] * v[j][0] + v[j][1] * v[j][1]) + (v[j][2] * v[j][2] + v[j][3] * v[j][3]);
        const float rstd = rsqrtf(wave_sum(s) * (1.0f / D) + NORM_EPS);
        f32x4* o = (f32x4*)(F.out + (size_t)m * D) + lane; const f32x4* gp = (const f32x4*)gf + lane;
#pragma unroll
        for (int j = 0; j < 8; ++j) o[64 * j] = v[j] * rstd * gp[64 * j];
    }
}

#ifndef MK_SPLIT
#define MK_SPLIT 0
#endif
constexpr int NPHASE = 17;
struct Args { const float* in[22]; float* out; unsigned char* ws; int ph_lo, ph_hi, li, pad; };
__global__ void __launch_bounds__(NTHREADS, 2) mega_fwd(Args args) {
    extern __shared__ __attribute__((aligned(16))) unsigned char lds_raw[];
    Frame F0;
    F0.lds = (LAS unsigned char*)lds_raw; F0.misc = (volatile LAS unsigned*)(F0.lds + LDS_MISC);
    F0.tid = threadIdx.x; F0.lane = F0.tid & 63; F0.wave = __builtin_amdgcn_readfirstlane(F0.tid >> 6);
    F0.G = gridDim.x; { const int bx = blockIdx.x; F0.vcu = (F0.G % 8 == 0) ? (bx % 8) * (F0.G / 8) + bx / 8 : bx; }
    F0.in = args.in;
    F0.out = args.out; F0.ws = args.ws; F0.ctl = (unsigned*)(args.ws + WS_CTL);
    if (F0.tid < 64) F0.misc[F0.tid] = 0u;
    __syncthreads();
    XcdBarrier bar = xcd_barrier_post(F0.ctl + CW_BAR + args.li * XCD_BAR_WORDS, F0.misc);
    const int lo = args.ph_lo, hi = args.ph_hi;
#ifndef PHMASK
#define PHMASK 0x1ffff
#endif
#define IN(k) (((PHMASK >> ((k) > 7 && (k) < 13 ? (k) - 7 : (k))) & 1) && lo <= (k) && (k) < hi)
#define SEAM(k) do { if (IN(k) && IN((k) + 1)) { XcdBarrier b2 = bar; asm volatile("" : "+s"(b2.bar)); xcd_barrier(b2); } } while (0)

    if (IN(0)) p_prologue(F0);
    SEAM(0);
    for (int layer = 0; layer < 2; ++layer) {
        const int pb = 1 + 7 * layer;
        if (IN(pb)) { Frame F = F0; launder(F); u64* rsq = WSP(u64, WS_RSQ);
            pg8::SchedDense S{WSP(unsigned char, WS_X8), WSP(unsigned char, WS_WIN + layer * SZ_WIN), D, D, M / 256, 32, F.G, (int)blockIdx.x};
            pg8::EpiIn E{BGP(bf16_t, BG_QKV), BGP(bf16_t, BG_KCB), BGP(bf16_t, BG_VCB), BGP(bf16_t, BG_GM), BGP(bf16_t, BG_NG), rsq + (2 * layer) * M, WSP(float, WS_ROPE), WSP(float, WS_ROPE) + T * 64, 1.0f / WIN8_SCALE, F.lds + LDS_WSCR};
            pg8::gemm_phase<true>(F.lds, D, S, E);
        }
        SEAM(pb);
        if (IN(pb + 1)) p_attn_a(F0, layer);
        SEAM(pb + 1);
        if (IN(pb + 2)) p_attn_b(F0, layer);
        SEAM(pb + 2);
        if (IN(pb + 3)) { Frame F = F0; launder(F);
            pg8::SchedSeg2 S{BGP(unsigned char, BG_OA), WSP(unsigned char, WS_WUP + (2 * layer) * SZ_WUP), BGP(unsigned char, BG_OA) + (size_t)M * 1024, WSP(unsigned char, WS_WUP + (2 * layer + 1) * SZ_WUP), 1024, M / 256, D / 256, F.G, (int)blockIdx.x};
            pg8::EpiMerge E{BGP(bf16_t, BG_GM), BGP(unsigned char, BG_Z), Z8_SCALE / (O8_SCALE * WUP8_SCALE)};
            pg8::gemm_phase<true>(F.lds, 1024, S, E);
        }
        SEAM(pb + 3);
        if (IN(pb + 4)) { Frame F = F0; launder(F); u64* rsq = WSP(u64, WS_RSQ);
            pg8::SchedDense S{BGP(unsigned char, BG_Z), WSP(unsigned char, WS_WO + layer * SZ_WO), D, D, M / 256, D / 256, F.G, (int)blockIdx.x};
            pg8::EpiResid E{layer == 0 ? (const void*)INP(IN_X) : (const void*)WSP(bf16_t, WS_XBF), layer != 0, WSP(bf16_t, WS_XBF), rsq + (2 * layer + 1) * M, layer == 1 ? WSP(unsigned char, WS_X8) : nullptr, 1.0f / (Z8_SCALE * WO8_SCALE)};
            pg8::gemm_phase<true>(F.lds, D, S, E);
        }
        SEAM(pb + 4);
        if (layer == 0) {
            if (IN(pb + 5)) { Frame F = F0; launder(F); u64* rsq = WSP(u64, WS_RSQ);
                pg8::SchedDense S{WSP(bf16_t, WS_XBF), WSP(bf16_t, WS_WGUD), D * 2, D * 2, M / 256, 2 * FF / 256, F.G, (int)blockIdx.x};
                pg8::EpiGateUp<false, true, false> E{BGP(bf16_t, 0), rsq + 1 * M, nullptr, F.misc};
                pg8::gemm_phase<false>(F.lds, D * 2, S, E);
            }
            SEAM(pb + 5);
            if (IN(pb + 6)) { Frame F = F0; launder(F); u64* rsq = WSP(u64, WS_RSQ);
                pg8::SchedDense S{BGP(unsigned char, 0), WSP(unsigned char, WS_WDD), FF, FF, M / 256, D / 256, F.G, (int)blockIdx.x};
                pg8::EpiResid E{WSP(bf16_t, WS_XBF), 1, WSP(bf16_t, WS_XBF), rsq + 2 * M, WSP(unsigned char, WS_X8), 1.0f / WD8_SCALE};
                pg8::gemm_phase<true>(F.lds, FF, S, E);
            }
            SEAM(pb + 6);
        } else {
            if (IN(pb + 5)) p_router(F0);
            SEAM(pb + 5);
            if (IN(pb + 6)) { Frame F = F0; launder(F); u64* rsq = WSP(u64, WS_RSQ);
                moe_counts(F);
                pg8::SchedMoE<true> S{WSP(unsigned char, WS_X8), WSP(unsigned char, WS_WGUM), WSP(int, WS_LTOK), D, D, 2 * FF / 256, F.G, (int)blockIdx.x, SZ_WGU8, F.misc, 24};
                pg8::EpiGateUp<true> E{BGP(bf16_t, 0), rsq + 3 * M, WSP(int, WS_LTOK), F.misc};
                pg8::gemm_phase<true>(F.lds, D, S, E);
            }
            SEAM(pb + 6);
            if (IN(pb + 7)) { Frame F = F0; launder(F);
                moe_counts(F);
                pg8::SchedMoE<false> S{BGP(unsigned char, 0), WSP(unsigned char, WS_WDM), nullptr, FF, FF, D / 256, F.G, (int)blockIdx.x, SZ_WD8, F.misc, 25};
                pg8::EpiMoeDown E{WSP(bf16_t, WS_YS), WSP(float, WS_LW), F.misc};
                pg8::gemm_phase<true>(F.lds, FF, S, E);
                { const int kpart = FF / (int)F.misc[26];
                  pg8::SchedMoETail St{BGP(unsigned char, 0), WSP(unsigned char, WS_WDM), FF, FF, D / 256, (int)blockIdx.x, kpart, SZ_WD8, F.misc};
                  pg8::EpiMoeDownTail Et{BGP(bf16_t, BG_YT), WSP(float, WS_LW), F.misc};
                  pg8::gemm_phase<true>(F.lds, kpart, St, Et); }
            }
            SEAM(pb + 7);
        }
    }
    if (IN(16)) p_final(F0);
#undef IN
#undef SEAM
}

extern "C" void kernel_launch(void* const* d_in, const int* in_sizes, int n_in, void* d_out, int out_size, void* d_ws, size_t ws_size, hipStream_t stream) {
    static int grid = 0;
    if (grid == 0) {
        if (n_in != 22 || in_sizes[0] != M * D || out_size != M * D || ws_size < WS_END) { fprintf(stderr, "kernel_launch: unexpected shapes (n_in %d, in0 %d, out %d, ws %zu < %zu); nothing launched\n", n_in, n_in > 0 ? in_sizes[0] : -1, out_size, ws_size, (size_t)WS_END); grid = -1; return; }
        int dev = 0, cus = 0, per_cu = 0;
        if (hipGetDevice(&dev) != hipSuccess || hipDeviceGetAttribute(&cus, hipDeviceAttributeMultiprocessorCount, dev) != hipSuccess) { grid = -1; return; }
        if (hipFuncSetAttribute((const void*)mega_fwd, hipFuncAttributeMaxDynamicSharedMemorySize, LDS_BYTES) != hipSuccess) { fprintf(stderr, "kernel_launch: hipFuncSetAttribute failed\n"); grid = -1; return; }
        if (hipOccupancyMaxActiveBlocksPerMultiprocessor(&per_cu, (const void*)mega_fwd, NTHREADS, LDS_BYTES) != hipSuccess || per_cu < 1) fprintf(stderr, "kernel_launch: occupancy query reports %d\n", per_cu);
        (void)hipGetLastError();
        grid = cus;
    }
    if (grid < 0) return;
    (void)hipMemsetAsync((char*)d_ws + WS_CTL, 0, CTL_ZERO_BYTES, stream);
    Args a{};
    for (int i = 0; i < 22; ++i) a.in[i] = (const float*)d_in[i];
    a.out = (float*)d_out; a.ws = (unsigned char*)d_ws; a.pad = 0;
#if MK_SPLIT
    for (int p = 0; p < NPHASE; ++p) { a.ph_lo = p; a.ph_hi = p + 1; a.li = p; hipLaunchKernelGGL(mega_fwd, dim3(grid), dim3(NTHREADS), LDS_BYTES, stream, a); }
#else
    a.ph_lo = 0; a.ph_hi = NPHASE; a.li = 0;
    hipLaunchKernelGGL(mega_fwd, dim3(grid), dim3(NTHREADS), LDS_BYTES, stream, a);
#endif
}
```

```cpp
#include <hip/hip_runtime.h>
#include <cstdio>
#include <cstdint>

#define LAS __attribute__((address_space(3)))
#define GAS __attribute__((address_space(1)))
typedef unsigned short bf16_t;
typedef short bf16x8 __attribute__((ext_vector_type(8)));
typedef short s16x4 __attribute__((ext_vector_type(4)));
typedef float f32x4 __attribute__((ext_vector_type(4)));
typedef float f32x2 __attribute__((ext_vector_type(2)));
typedef float f32x16 __attribute__((ext_vector_type(16)));
typedef unsigned u32x4 __attribute__((ext_vector_type(4)));
typedef unsigned u32x2 __attribute__((ext_vector_type(2)));

constexpr int NB = 4, T = 4096, D = 2048, M = NB * T, HD = 128, FF = 7168, NE = 8;
constexpr int IN_DIM = 8216, NIN = 8448;
constexpr int NCMP = 255, CMPH = 256;
constexpr float NORM_EPS = 1e-6f;
constexpr int MAXSLOT = 34816;
constexpr int YT_ROWS = 31 * 256;

constexpr size_t MiB = 1u << 20;
constexpr size_t WS_CTL = 0, CTL_ZERO_BYTES = 2 * MiB;
constexpr int CW_TMO = 0, CW_QUEUE = 1024, CW_ECNT = 2048, CW_BAR = 4096;
constexpr size_t WS_RSQ = 1 * MiB;
constexpr size_t WS_ROPE = 2 * MiB;
constexpr size_t WS_MISC = 4 * MiB;
constexpr size_t WS_CBIAS = 512 * 1024;
constexpr float CB_SCALE = 1099511627776.0f;
constexpr size_t WS_LTOK = WS_MISC + 64 * 1024;
constexpr size_t WS_LW = WS_LTOK + (size_t)NE * M * 4;
constexpr size_t WS_SLOT = WS_LW + (size_t)NE * M * 4;
constexpr size_t WS_W = 6 * MiB;
constexpr size_t SZ_WIN = (size_t)NIN * D * 2, SZ_W1 = (size_t)CMPH * 4096 * 2, SZ_W2 = (size_t)256 * 256 * 2, SZ_WUP = (size_t)D * 1024 * 2, SZ_WO = (size_t)D * D * 2;
constexpr size_t SZ_WGU = (size_t)2 * FF * D * 2, SZ_WD = (size_t)D * FF * 2;
constexpr size_t SZ_WGU8 = (size_t)2 * FF * D, SZ_WD8 = (size_t)D * FF;
constexpr float WGU8_SCALE = 32.0f, WD8_SCALE = 64.0f, WIN8_SCALE = 32.0f, WUP8_SCALE = 32.0f, WO8_SCALE = 32.0f, O8_SCALE = 16.0f, Z8_SCALE = 16.0f;
constexpr size_t WS_WIN = WS_W;
constexpr size_t WS_W1 = WS_WIN + 2 * SZ_WIN;
constexpr size_t WS_W2 = WS_W1 + 4 * SZ_W1;
constexpr size_t WS_WUP = WS_W2 + 4 * SZ_W2;
constexpr size_t WS_WO = WS_WUP + 4 * SZ_WUP;
constexpr size_t WS_WGUD = WS_WO + 2 * SZ_WO;
constexpr size_t WS_WDD = WS_WGUD + SZ_WGU;
constexpr size_t WS_WGUM = WS_WDD + SZ_WD;
constexpr size_t WS_WDM = WS_WGUM + 8 * SZ_WGU8;
constexpr size_t WS_X8 = WS_WDM + 8 * SZ_WD8;
constexpr size_t WS_XR = WS_X8 + (size_t)M * D;
constexpr size_t WS_XBF = WS_XR + (size_t)M * D * 4;
constexpr size_t WS_YS = WS_XBF + (size_t)M * D * 2;
constexpr size_t WS_BIG = WS_YS + (size_t)MAXSLOT * D * 2;
constexpr size_t SZ_BIG = (size_t)MAXSLOT * FF * 2;
constexpr size_t WS_END = WS_BIG + SZ_BIG;
constexpr size_t BG_QKV = 0;
constexpr size_t BG_GM = BG_QKV + (size_t)M * 4096 * 2;
constexpr size_t BG_NG = BG_GM + (size_t)M * 4096 * 2;
constexpr size_t BG_KCB = BG_NG + (size_t)M * 32 * 2;
constexpr size_t BG_VCB = BG_KCB + (size_t)M * 256 * 2 + 65536;
constexpr size_t BG_HC = BG_VCB + (size_t)M * 256 * 2 + 65536;
constexpr size_t BG_KCMP = BG_HC + (size_t)2 * 2048 * 256 * 2;
constexpr size_t BG_VCMP = BG_KCMP + (size_t)8 * 256 * 128 * 2;
constexpr size_t BG_OA = BG_VCMP + (size_t)8 * 256 * 128 * 2;
constexpr size_t BG_OB = BG_OA + (size_t)M * 1024 * 2;
constexpr size_t BG_Z = BG_OB + (size_t)M * 1024 * 2;
constexpr size_t BG_END = BG_Z + (size_t)M * D * 2;
static_assert(BG_END <= SZ_BIG, "attention-phase tensors fit the aliased region");
constexpr size_t BG_YT = 256 * MiB;
static_assert((size_t)MAXSLOT * FF <= BG_YT && BG_YT + (size_t)4 * YT_ROWS * D * 2 <= SZ_BIG, "tail partials fit");
static_assert(WS_SLOT + (size_t)M * 8 <= WS_W, "misc region");

constexpr int LDS_K = 0, LDS_V = 65536, LDS_WSCR = 131072  , LDS_IMP = LDS_WSCR + 2048  , LDS_SELM = LDS_IMP + 64 * 65 * 4  ;
constexpr int LDS_MISC = LDS_SELM + 512;
constexpr int LDS_BYTES = LDS_MISC + 256;
static_assert(LDS_BYTES <= 163840, "LDS");
static_assert(LDS_WSCR + 32 * 528 <= LDS_MISC, "epilogue slab fits beside the GEMM buffers");
constexpr int NWAVES = 8, NTHREADS = 512;

#define RLX_AGENT __ATOMIC_RELAXED, __HIP_MEMORY_SCOPE_AGENT
#define LDS_WAIT() asm volatile("s_waitcnt lgkmcnt(0)" ::: "memory")
#define VM_WAIT() asm volatile("s_waitcnt vmcnt(0)" ::: "memory")

typedef __bf16 bf16x2_t __attribute__((ext_vector_type(2)));
__device__ __forceinline__ unsigned cvt_pk_bf16(float lo, float hi) { f32x2 v = {lo, hi}; bf16x2_t b = __builtin_convertvector(v, bf16x2_t); return __builtin_bit_cast(unsigned, b); }
__device__ __forceinline__ float bf_lo(unsigned w) { return __uint_as_float(w << 16); }
__device__ __forceinline__ float bf_hi(unsigned w) { return __uint_as_float(w & 0xffff0000u); }
__device__ __forceinline__ float bf2f(bf16_t b) { return __uint_as_float(((unsigned)b) << 16); }
__device__ __forceinline__ float fast_sigmoid(float x) { return __builtin_amdgcn_rcpf(1.0f + __builtin_amdgcn_exp2f(-1.4426950408889634f * x)); }
__device__ __forceinline__ f32x4 sigmoid4_scaled(const f32x4& x, float c1) { const f32x4 t = x * c1; f32x4 e, sg;
#pragma unroll
    for (int j = 0; j < 4; ++j) e[j] = __builtin_amdgcn_exp2f(t[j]);
    const f32x4 d = e + 1.0f;
#pragma unroll
    for (int j = 0; j < 4; ++j) sg[j] = __builtin_amdgcn_rcpf(d[j]);
    return sg; }
__device__ __forceinline__ int opaque_tid() { int t; asm volatile("v_mov_b32 %0, %1" : "=v"(t) : "v"((int)threadIdx.x)); return t; }
typedef unsigned long long u64;
typedef int v8i __attribute__((ext_vector_type(8)));
typedef int v4i __attribute__((ext_vector_type(4)));
__device__ __forceinline__ unsigned cvt4_fp8(float a, float b, float c, float d) { unsigned w = 0u; w = __builtin_amdgcn_cvt_pk_fp8_f32(a, b, w, false); w = __builtin_amdgcn_cvt_pk_fp8_f32(c, d, w, true); return w; }
constexpr float RSQ_SCALE = 1048576.0f;
__device__ __forceinline__ float rstd_of(const u64* rsq, int row) { return rsqrtf((float)rsq[row] * (1.0f / (RSQ_SCALE * D)) + NORM_EPS); }
__device__ __forceinline__ float wave_sum(float v) {
#pragma unroll
    for (int o = 1; o < 64; o <<= 1) v += __shfl_xor(v, o);
    return v;
}

#define XB_TMO      128
#define XB_XCNT(j)  (256  + 64 * (j))
#define XB_XSUB(j)  (1280 + 64 * (j))
#define XB_XGEN(j)  (2304 + 64 * (j))
#define XB_TOP      3328
#define XB_TOPGEN   3392
#define XCD_BAR_WORDS 3456
#define XB_SPIN_CAP (1u << 18)
__device__ __forceinline__ unsigned xb_ld(unsigned* p)              { return __hip_atomic_load(p, __ATOMIC_RELAXED, __HIP_MEMORY_SCOPE_AGENT); }
__device__ __forceinline__ unsigned xb_add(unsigned* p, unsigned v) { return __hip_atomic_fetch_add(p, v, __ATOMIC_RELAXED, __HIP_MEMORY_SCOPE_AGENT); }
__device__ __forceinline__ unsigned xb_xcc_id() { return (unsigned)__builtin_amdgcn_s_getreg((3 << 11) | 20) & 0xFu; }
#define XB_SPIN(cond, bar) do { unsigned _sp = 0; while (cond) { __builtin_amdgcn_s_sleep(1); \
    if ((++_sp & 255u) == 0u) { if (xb_ld(&(bar)[XB_TMO])) break; if (_sp > XB_SPIN_CAP) { atomicAdd(&(bar)[XB_TMO], 1u); break; } } } } while (0)
struct XcdBarrier { unsigned* bar; unsigned x; volatile LAS unsigned* st; };
__device__ __forceinline__ XcdBarrier xcd_barrier_post(unsigned* bar, volatile LAS unsigned* st) {
    XcdBarrier b; b.bar = bar; b.x = xb_xcc_id(); b.st = st;
    if (threadIdx.x == 0) (void)xb_add(&bar[XB_XCNT(b.x)], 1u);
    return b;
}
__device__ __forceinline__ void xcd_barrier_complete(unsigned* bar, unsigned x, unsigned& nloc, unsigned& nx) {
    const unsigned G = gridDim.x * gridDim.y * gridDim.z;
    unsigned sum, cnt, mine, sp = 0u;
    for (;;) {
        sum = 0u; cnt = 0u; mine = 0u;
#pragma unroll
        for (unsigned j = 0; j < 16; ++j) { const unsigned c = xb_ld(&bar[XB_XCNT(j)]); sum += c; cnt += (c > 0u) ? 1u : 0u; mine = (j == x) ? c : mine; }
        if (sum == G) break;
        __builtin_amdgcn_s_sleep(1);
        if ((++sp & 255u) == 0u) { if (xb_ld(&bar[XB_TMO])) break; if (sp > XB_SPIN_CAP) { atomicAdd(&bar[XB_TMO], 1u); break; } }
    }
    nloc = mine > 0u ? mine : 1u; nx = cnt > 0u ? cnt : 1u;
}
__device__ __forceinline__ void xcd_barrier(const XcdBarrier& b) {
    asm volatile("s_waitcnt vmcnt(0)" ::: "memory");
    __syncthreads();
    if (threadIdx.x == 0) {
        unsigned* bar = b.bar;
        __builtin_amdgcn_s_waitcnt(0);
        unsigned nloc = b.st[0], nx = b.st[1];
        if (nloc == 0u) { xcd_barrier_complete(bar, b.x, nloc, nx); b.st[0] = nloc; b.st[1] = nx; }
        const unsigned old = xb_add(&bar[XB_XSUB(b.x)], 1u);
        const unsigned gen = old / nloc;
        if (old + 1u == (gen + 1u) * nloc) {
            __builtin_amdgcn_fence(__ATOMIC_RELEASE, "agent");
            asm volatile("s_waitcnt vmcnt(0)" ::: "memory");
            const unsigned og = xb_add(&bar[XB_TOP], 1u);
            const unsigned tg = og / nx;
            if (og + 1u == (tg + 1u) * nx) xb_add(&bar[XB_TOPGEN], 1u);
            else XB_SPIN(xb_ld(&bar[XB_TOPGEN]) == tg, bar);
            __builtin_amdgcn_fence(__ATOMIC_ACQUIRE, "agent");
            xb_add(&bar[XB_XGEN(b.x)], 1u);
            asm volatile("s_waitcnt vmcnt(0)" ::: "memory");
        } else {
            XB_SPIN(xb_ld(&bar[XB_XGEN(b.x)]) == gen, bar);
            __builtin_amdgcn_fence(__ATOMIC_ACQUIRE, "agent");
            asm volatile("s_waitcnt vmcnt(0)" ::: "memory");
        }
    }
    __syncthreads();
}

namespace pg8 {
constexpr int BM = 256, BK = 64, HALF = 128, HTB = HALF * BK * 2, STAGE_BYTES = 8 * HTB, NXCD = 8, WGM = 4;
__host__ __device__ __forceinline__ int lds_byte(int r, int c) { const int st = (r >> 4) * 2 + (c >> 5), rr = r & 15, cc = c & 31, ob = rr * 64 + cc * 2; return st * 1024 + (ob ^ (((ob >> 9) & 1) << 5)); }
__host__ __device__ __forceinline__ void stage_rc(int b, int& R, int& C) { const int st = b / 1024, sb = b % 1024, swz = sb ^ (((sb >> 9) & 1) << 5); R = (st >> 1) * 16 + swz / 64; C = (st & 1) * 32 + (swz % 64) / 2; }
__host__ __device__ __forceinline__ int perm32(int rho) { const int n = rho >> 4, i = rho & 15; return 8 * (i >> 2) + 4 * n + (i & 3); }

struct Unit { int pm, pn, aux; };
typedef f32x4 Acc[2][2][4][2];

__device__ __forceinline__ bool static_tile(int L, int nM, int nN, int& pm, int& pn) {
    const int nwg = nM * nN; if (L >= nwg) return false;
    int wgid = L; { const int q = nwg / NXCD, r = nwg % NXCD, xcd = wgid % NXCD, off = wgid / NXCD; wgid = (xcd < r ? xcd * (q + 1) : r * (q + 1) + (xcd - r) * q) + off; }
    const int nig = WGM * nN, gid = wgid / nig, fm = gid * WGM, gsz = (nM - fm) < WGM ? (nM - fm) : WGM;
    pm = fm + ((wgid % nig) % gsz); pn = (wgid % nig) / gsz; return true;
}

__device__ __forceinline__ void glds_s(const void* sbase, unsigned voff, unsigned lds_dst) { unsigned keep;
    asm volatile("s_mov_b32 %0, m0\n\ts_mov_b32 m0, %3\n\ts_nop 0\n\tglobal_load_lds_dwordx4 %1, %2\n\ts_mov_b32 m0, %0" : "=&s"(keep) : "v"(voff), "s"(sbase), "s"(lds_dst) : "memory"); }
__device__ __forceinline__ const char* uni_ptr(const char* p) { const unsigned long long v = (unsigned long long)p; const unsigned lo = __builtin_amdgcn_readfirstlane((unsigned)v), hi = __builtin_amdgcn_readfirstlane((unsigned)(v >> 32));
    return (const char*)(GAS const char*)(((unsigned long long)hi << 32) | lo); }
template <bool FP8, class Epi, class Sched>
__device__ __forceinline__ void gemm_phase(LAS unsigned char* lds, const int Kb, const Sched& S, const Epi& E) {
    const int tid = opaque_tid(), wid = __builtin_amdgcn_readfirstlane(tid >> 6), lane = tid & 63, wr = wid >> 2, wc = wid & 3, fr = lane & 15, fq = lane >> 4;
    const int nt = Kb / 128;
    int Rr[2], Cc[2]; unsigned voffB[2];
#pragma unroll
    for (int i = 0; i < 2; ++i) { stage_rc(tid * 16 + i * 8192, Rr[i], Cc[i]); const int Rb = Epi::PERM ? ((Rr[i] & ~31) + perm32(Rr[i] & 31)) : Rr[i];
        voffB[i] = (unsigned)(Rb * S.ldb() + Cc[i] * 2); }
    const size_t kstep = (size_t)(BK * 2);
    const size_t hstepB = (size_t)HALF * S.ldb();
    const unsigned ldsw = (unsigned)wid * 1024u;
    const unsigned ldsb = (unsigned)__builtin_amdgcn_readfirstlane((int)((unsigned)(uintptr_t)lds + ldsw));
    const int aoff = lds_byte(wr * 64 + fr, fq * 8), boff = lds_byte(wc * 32 + fr, fq * 8);
#define PG8_SA(b, h) (((b) * 2 + (h)) * HTB)
#define PG8_SB(b, h) ((4 + (b) * 2 + (h)) * HTB)
#define PG8_STAGE(bufoff, gbase, voff) do { const void* sb_ = (const void*)(gbase); _Pragma("unroll") for (int _i = 0; _i < 2; ++_i) \
        glds_s(sb_, (voff)[_i], ldsb + (unsigned)((bufoff) + _i * 8192)); } while (0)
#define PG8_LD8(p_) __builtin_shufflevector(*(const LAS v4i*)(p_), *(const LAS v4i*)((p_) + 1024), 0, 1, 2, 3, 4, 5, 6, 7)
#define PG8_LDA(dst, b, h) do { _Pragma("unroll") for (int m = 0; m < 4; ++m) dst[m] = PG8_LD8(lds + PG8_SA(b, h) + aoff + m * 2048); } while (0)
#define PG8_LDB(dst, b, h) do { _Pragma("unroll") for (int n = 0; n < 2; ++n) dst[n] = PG8_LD8(lds + PG8_SB(b, h) + boff + n * 2048); } while (0)
#define PG8_H(v_, k_) __builtin_bit_cast(bf16x8, __builtin_shufflevector(v_, v_, 4 * (k_), 4 * (k_) + 1, 4 * (k_) + 2, 4 * (k_) + 3))
#define PG8_MMA(ai, bj, At, Bt) do { __builtin_amdgcn_s_setprio(1); _Pragma("unroll") for (int m = 0; m < 4; ++m) _Pragma("unroll") for (int n = 0; n < 2; ++n) { \
        if constexpr (FP8) asm volatile("v_mfma_f32_16x16x128_f8f6f4 %0, %1, %2, %0" : "+v"(acc[ai][bj][m][n]) : "v"(Bt[n]), "v"(At[m]));   \
        else { acc[ai][bj][m][n] = __builtin_amdgcn_mfma_f32_16x16x32_bf16(PG8_H(Bt[n], 0), PG8_H(At[m], 0), acc[ai][bj][m][n], 0, 0, 0); \
               acc[ai][bj][m][n] = __builtin_amdgcn_mfma_f32_16x16x32_bf16(PG8_H(Bt[n], 1), PG8_H(At[m], 1), acc[ai][bj][m][n], 0, 0, 0); } } \
        __builtin_amdgcn_s_setprio(0); } while (0)
#define PG8_WAIT_V(n) asm volatile("s_waitcnt vmcnt(" #n ")" ::: "memory")
#define PG8_WAIT_L(n) asm volatile("s_waitcnt lgkmcnt(" #n ")" ::: "memory")
#define PG8_BAR __builtin_amdgcn_s_barrier()
#define PG8_SCHED __builtin_amdgcn_sched_barrier(0)
    Unit cur, nxt; int ui = 0;
    if (!S.next(0, cur)) return;
    Acc acc;
#pragma unroll
    for (int a = 0; a < 2; ++a)
#pragma unroll
        for (int b = 0; b < 2; ++b)
#pragma unroll
            for (int m = 0; m < 4; ++m)
#pragma unroll
                for (int n = 0; n < 2; ++n) acc[a][b][m][n] = (f32x4){0.f, 0.f, 0.f, 0.f};
    v8i At[4], B0[2], B1[2]; const int one8 = 0x7F7F7F7F;
    unsigned vA[2][2], vAn[2][2];
    S.a_off(cur, Rr, Cc, vA);
    const char* cA = uni_ptr(S.a_base(cur)); const char* cB = uni_ptr(S.b_base(cur));
    PG8_STAGE(PG8_SB(0, 0), cB, voffB); PG8_STAGE(PG8_SB(0, 1), cB + hstepB, voffB); PG8_STAGE(PG8_SA(0, 0), cA, vA[0]); PG8_STAGE(PG8_SA(0, 1), cA, vA[1]);
    if (wr == 1) PG8_BAR;
    PG8_WAIT_V(2); PG8_BAR;
    PG8_STAGE(PG8_SB(1, 0), cB + kstep, voffB); PG8_STAGE(PG8_SA(1, 0), cA + kstep, vA[0]); PG8_STAGE(PG8_SB(1, 1), cB + hstepB + kstep, voffB);
    PG8_WAIT_V(6); PG8_BAR;
    for (;;) {
        const bool has_next = S.next(ui + 1, nxt);
        const char* nA = cA; const char* nB = cB;
#pragma unroll
        for (int h = 0; h < 2; ++h)
#pragma unroll
            for (int i = 0; i < 2; ++i) vAn[h][i] = vA[h][i];
        if (has_next) { nA = uni_ptr(S.a_base(nxt)); nB = uni_ptr(S.b_base(nxt)); if (Sched::VARIES) S.a_off(nxt, Rr, Cc, vAn); }
        for (int t = 0; t < nt; t += 2) {
            const bool last = (t == nt - 2);
            const char* a1 = cA + (size_t)(t + 1) * kstep;
            const char* a2 = last ? nA : cA + (size_t)(t + 2) * kstep; const char* b2 = last ? nB : cB + (size_t)(t + 2) * kstep;
            const char* a3 = a2 + kstep; const char* b3 = b2 + kstep;
            unsigned v2[2][2];
#pragma unroll
            for (int h = 0; h < 2; ++h)
#pragma unroll
                for (int i = 0; i < 2; ++i) v2[h][i] = (Sched::VARIES && last) ? vAn[h][i] : vA[h][i];
            PG8_LDB(B0, 0, 0); PG8_LDB(B1, 0, 1); PG8_SCHED; PG8_LDA(At, 0, 0); PG8_STAGE(PG8_SA(1, 1), a1, vA[1]);
            PG8_WAIT_V(8); PG8_WAIT_L(0); PG8_BAR; PG8_MMA(0, 0, At, B0); PG8_MMA(0, 1, At, B1); PG8_BAR; PG8_SCHED;
            PG8_LDA(At, 0, 1); PG8_STAGE(PG8_SB(0, 0), b2, voffB); PG8_STAGE(PG8_SB(0, 1), b2 + hstepB, voffB); PG8_STAGE(PG8_SA(0, 0), a2, v2[0]);
            PG8_WAIT_V(8); PG8_WAIT_L(0); PG8_BAR; PG8_MMA(1, 0, At, B0); PG8_MMA(1, 1, At, B1); PG8_BAR; PG8_SCHED;
            PG8_LDB(B0, 1, 0); PG8_LDB(B1, 1, 1); PG8_SCHED; PG8_LDA(At, 1, 0); PG8_STAGE(PG8_SA(0, 1), a2, v2[1]);
            PG8_WAIT_V(8); PG8_WAIT_L(0); PG8_BAR; PG8_MMA(0, 0, At, B0); PG8_MMA(0, 1, At, B1); PG8_BAR; PG8_SCHED;
            PG8_LDA(At, 1, 1); PG8_STAGE(PG8_SB(1, 0), b3, voffB); PG8_STAGE(PG8_SB(1, 1), b3 + hstepB, voffB); PG8_STAGE(PG8_SA(1, 0), a3, v2[0]);
            PG8_WAIT_V(8); PG8_WAIT_L(0); PG8_BAR; PG8_MMA(1, 0, At, B0); PG8_MMA(1, 1, At, B1); PG8_BAR; PG8_SCHED;
        }
        if (wr == 0) PG8_BAR;
        if constexpr (FP8) asm volatile("s_nop 15\n\ts_nop 15" ::: "memory");
        E(acc, cur, wr, wc, fr, fq);
        if (!has_next) break;
        if (!E.keep(cur)) {
#pragma unroll
            for (int a = 0; a < 2; ++a)
#pragma unroll
                for (int b = 0; b < 2; ++b)
#pragma unroll
                    for (int m = 0; m < 4; ++m)
#pragma unroll
                        for (int n = 0; n < 2; ++n) acc[a][b][m][n] = (f32x4){0.f, 0.f, 0.f, 0.f};
        }
        cur = nxt; cA = nA; cB = nB; ++ui;
#pragma unroll
        for (int h = 0; h < 2; ++h)
#pragma unroll
            for (int i = 0; i < 2; ++i) vA[h][i] = vAn[h][i];
        if (wr == 1) PG8_BAR;
    }
    PG8_WAIT_V(0);
    PG8_BAR;
#undef PG8_SA
#undef PG8_SB
#undef PG8_STAGE
#undef PG8_LDA
#undef PG8_LDB
#undef PG8_MMA
#undef PG8_WAIT_V
#undef PG8_WAIT_L
#undef PG8_BAR
#undef PG8_SCHED
}

struct SchedDense {
    static constexpr bool VARIES = false;
    const void* A; const void* Bt; int lda, ldb_, nM, nN, G, c;
    __device__ __forceinline__ int ldb() const { return ldb_; }
    __device__ __forceinline__ bool next(int i, Unit& u) const { u.aux = 0; return static_tile(i * G + c, nM, nN, u.pm, u.pn); }
    __device__ __forceinline__ const char* a_base(const Unit& u) const { return (const char*)A + (size_t)u.pm * BM * lda; }
    __device__ __forceinline__ const char* b_base(const Unit& u) const { return (const char*)Bt + (size_t)u.pn * BM * ldb_; }
    __device__ __forceinline__ void a_off(const Unit&, const int (&R)[2], const int (&C)[2], unsigned (&vo)[2][2]) const {
#pragma unroll
        for (int h = 0; h < 2; ++h)
#pragma unroll
            for (int i = 0; i < 2; ++i) vo[h][i] = (unsigned)((h * HALF + R[i]) * lda + C[i] * 2); }
};
struct SchedOne {
    static constexpr bool VARIES = false;
    const void* A; const void* Bt; int lda, ldb_, pm, pn;
    __device__ __forceinline__ int ldb() const { return ldb_; }
    __device__ __forceinline__ bool next(int i, Unit& u) const { u.aux = 0; u.pm = pm; u.pn = pn; return i == 0; }
    __device__ __forceinline__ const char* a_base(const Unit& u) const { return (const char*)A + (size_t)u.pm * BM * lda; }
    __device__ __forceinline__ const char* b_base(const Unit& u) const { return (const char*)Bt + (size_t)u.pn * BM * ldb_; }
    __device__ __forceinline__ void a_off(const Unit&, const int (&R)[2], const int (&C)[2], unsigned (&vo)[2][2]) const {
#pragma unroll
        for (int h = 0; h < 2; ++h)
#pragma unroll
            for (int i = 0; i < 2; ++i) vo[h][i] = (unsigned)((h * HALF + R[i]) * lda + C[i] * 2); }
};
struct SchedSeg2 {
    static constexpr bool VARIES = false;
    const void* A0; const void* B0; const void* A1; const void* B1; int ld, nM, nN, G, c;
    __device__ __forceinline__ int ldb() const { return ld; }
    __device__ __forceinline__ bool next(int i, Unit& u) const { u.aux = i & 1; return static_tile((i >> 1) * G + c, nM, nN, u.pm, u.pn); }
    __device__ __forceinline__ const char* a_base(const Unit& u) const { return (const char*)(u.aux ? A1 : A0) + (size_t)u.pm * BM * ld; }
    __device__ __forceinline__ const char* b_base(const Unit& u) const { return (const char*)(u.aux ? B1 : B0) + (size_t)u.pn * BM * ld; }
    __device__ __forceinline__ void a_off(const Unit&, const int (&R)[2], const int (&C)[2], unsigned (&vo)[2][2]) const {
#pragma unroll
        for (int h = 0; h < 2; ++h)
#pragma unroll
            for (int i = 0; i < 2; ++i) vo[h][i] = (unsigned)((h * HALF + R[i]) * ld + C[i] * 2); }
};
template <bool GATHER> struct SchedMoE {
    static constexpr bool VARIES = GATHER;
    const void* A; const void* Bt; const int* ltok; int lda, ldb_, nN, G, c; size_t bstride; const volatile LAS unsigned* misc; int nm_word;
    __device__ __forceinline__ int ldb() const { return ldb_; }
    __device__ __forceinline__ bool next(int i, Unit& u) const {
        const int nM = (int)misc[nm_word]; if (!static_tile(i * G + c, nM, nN, u.pm, u.pn)) return false;
        int e = 0;
#pragma unroll
        for (int j = 1; j < NE; ++j) e += ((int)misc[16 + j] <= u.pm) ? 1 : 0;
        u.aux = e; return true; }
    __device__ __forceinline__ const char* a_base(const Unit& u) const { return GATHER ? (const char*)A : (const char*)A + (size_t)u.pm * BM * lda; }
    __device__ __forceinline__ const char* b_base(const Unit& u) const { return (const char*)Bt + (size_t)u.aux * bstride + (size_t)u.pn * BM * ldb_; }
    __device__ __forceinline__ void a_off(const Unit& u, const int (&R)[2], const int (&C)[2], unsigned (&vo)[2][2]) const {
        if (GATHER) {
            const int cnt = (int)misc[8 + u.aux], r0 = (u.pm - (int)misc[16 + u.aux]) * BM;
#pragma unroll
            for (int h = 0; h < 2; ++h)
#pragma unroll
                for (int i = 0; i < 2; ++i) { const int r = r0 + h * HALF + R[i]; const int tok = r < cnt ? ltok[u.aux * M + r] : 0; vo[h][i] = (unsigned)(tok * lda + C[i] * 2); }
        } else {
#pragma unroll
            for (int h = 0; h < 2; ++h)
#pragma unroll
                for (int i = 0; i < 2; ++i) vo[h][i] = (unsigned)((h * HALF + R[i]) * lda + C[i] * 2);
        } }
};

struct SchedMoETail {
    static constexpr bool VARIES = false;
    const void* A; const void* Bt; int lda, ldb_, nN, c, kpart; size_t bstride; const volatile LAS unsigned* misc;
    __device__ __forceinline__ int ldb() const { return ldb_; }
    __device__ __forceinline__ bool next(int i, Unit& u) const {
        const int S = (int)misc[26], Tm = (int)misc[25], nt = ((int)misc[24] - Tm) * nN;
        if (i != 0 || c >= nt * S) return false;
        const int j = c / S, part = c - j * S; u.pm = Tm + j / nN; u.pn = j % nN;
        int e = 0;
#pragma unroll
        for (int q = 1; q < NE; ++q) e += ((int)misc[16 + q] <= u.pm) ? 1 : 0;
        u.aux = e | (part << 8); return true; }
    __device__ __forceinline__ const char* a_base(const Unit& u) const { return (const char*)A + (size_t)u.pm * BM * lda + (size_t)(u.aux >> 8) * kpart; }
    __device__ __forceinline__ const char* b_base(const Unit& u) const { return (const char*)Bt + (size_t)(u.aux & 255) * bstride + (size_t)u.pn * BM * ldb_ + (size_t)(u.aux >> 8) * kpart; }
    __device__ __forceinline__ void a_off(const Unit&, const int (&R)[2], const int (&C)[2], unsigned (&vo)[2][2]) const {
#pragma unroll
        for (int h = 0; h < 2; ++h)
#pragma unroll
            for (int i = 0; i < 2; ++i) vo[h][i] = (unsigned)((h * HALF + R[i]) * lda + C[i] * 2); }
};

struct EpiIn {
    static constexpr bool PERM = true;
    bf16_t* QKV; bf16_t* KCb; bf16_t* VCb; bf16_t* GMb; bf16_t* NGb; const u64* rsq; const float* cosT; const float* sinT; float wscale;
    LAS unsigned char* slab;
    __device__ __forceinline__ bool keep(const Unit&) const { return false; }
    __device__ __forceinline__ void operator()(const Acc& acc, const Unit& u, int wr, int wc, int fr, int fq) const {
        const int pn = u.pn, row0 = u.pm * BM + wr * 64 + fr;
        u64 rq[2][4];
#pragma unroll
        for (int ai = 0; ai < 2; ++ai)
#pragma unroll
            for (int m = 0; m < 4; ++m) rq[ai][m] = rsq[row0 + ai * HALF + m * 16];
        const float sc = (1.0f / (RSQ_SCALE * D));
        if (pn < 32) {
            const int wid = wr * 4 + wc, lane = fq * 16 + fr;
            LAS unsigned char* wrow = slab + (wr * 16 + fr) * 528;
            const int sr = wid * 4 + (lane >> 5), cb = (lane & 31) * 16;
            const LAS unsigned char* rp = slab + sr * 528 + cb;
            const int trow = (sr >> 4) * 64 + (sr & 15);
            const bool rope = pn < 16 && ((0x57DF >> pn) & 1); const int d0 = 16 * wc + 4 * fq;
            f32x4 csa[8], sna[8];
#pragma unroll
            for (int g = 0; g < 8; ++g) { csa[g] = f32x4{1.f, 1.f, 1.f, 1.f}; sna[g] = f32x4{0.f, 0.f, 0.f, 0.f}; }
            if (rope) {
#pragma unroll
                for (int g = 0; g < 8; ++g) { const int t = (row0 + (g >> 2) * HALF + (g & 3) * 16) & (T - 1); csa[g] = *(const f32x4*)(cosT + t * 64 + d0); sna[g] = *(const f32x4*)(sinT + t * 64 + d0); } }
#pragma unroll
            for (int g = 0; g < 8; ++g) { const int ai = g >> 2, m = g & 3; const f32x4 cs = csa[g], sn = sna[g];
                const float rstd = rsqrtf((float)rq[ai][m] * sc + NORM_EPS) * wscale;
#pragma unroll
                for (int bj = 0; bj < 2; ++bj) { const f32x4 v0 = acc[ai][bj][m][0] * rstd, v1 = acc[ai][bj][m][1] * rstd;
                    if (pn < 16) { const f32x4 o1 = v0 * cs - v1 * sn, o2 = v1 * cs + v0 * sn;
                        u32x2 w1, w2; w1.x = cvt_pk_bf16(o1[0], o1[1]); w1.y = cvt_pk_bf16(o1[2], o1[3]); w2.x = cvt_pk_bf16(o2[0], o2[1]); w2.y = cvt_pk_bf16(o2[2], o2[3]);
                        *(LAS u32x2*)(wrow + (bj * HD + d0) * 2) = w1; *(LAS u32x2*)(wrow + (bj * HD + 64 + d0) * 2) = w2; }
                    else { const float c1 = -1.4426950408889634f * rstd; const f32x4 s0 = sigmoid4_scaled(acc[ai][bj][m][0], c1), s1 = sigmoid4_scaled(acc[ai][bj][m][1], c1); u32x4 w;
                        w.x = cvt_pk_bf16(s0[0], s0[1]); w.y = cvt_pk_bf16(s0[2], s0[3]); w.z = cvt_pk_bf16(s1[0], s1[1]); w.w = cvt_pk_bf16(s1[2], s1[3]);
                        *(LAS u32x4*)(wrow + (bj * HD + wc * 32 + 8 * fq) * 2) = w; } }
                asm volatile("s_waitcnt lgkmcnt(0)" ::: "memory"); __builtin_amdgcn_s_barrier(); asm volatile("" ::: "memory");
                const u32x4 ra = *(const LAS u32x4*)rp, rb = *(const LAS u32x4*)(rp + 2 * 528);
                asm volatile("s_waitcnt lgkmcnt(0)" ::: "memory"); __builtin_amdgcn_s_barrier(); asm volatile("" ::: "memory");
                const int grow = u.pm * BM + ai * HALF + m * 16 + trow;
                unsigned char* dst; size_t rstride;
                if (pn == 10 || pn == 11) { bf16_t* cbuf = pn == 10 ? KCb : VCb; dst = (unsigned char*)(cbuf + ((size_t)((grow >> 12) * 2 + (cb >> 8)) * T + (grow & (T - 1))) * HD) + (cb & 255); rstride = (size_t)HD * 2; }
                else if (pn < 16) { dst = (unsigned char*)(QKV + (size_t)grow * 4096 + pn * 256) + cb; rstride = (size_t)4096 * 2; }
                else { dst = (unsigned char*)(GMb + (size_t)grow * 4096 + (pn - 16) * 256) + cb; rstride = (size_t)4096 * 2; }
                *(u32x4*)dst = ra; *(u32x4*)(dst + 2 * rstride) = rb; }
        } else {
            if (wc == 0) {
#pragma unroll
                for (int ai = 0; ai < 2; ++ai)
#pragma unroll
                    for (int m = 0; m < 4; ++m) { const int row = row0 + ai * HALF + m * 16; const float rstd = rsqrtf((float)rq[ai][m] * sc + NORM_EPS) * wscale;
                        const f32x4 v0 = acc[ai][0][m][0] * rstd, v1 = acc[ai][0][m][1] * rstd; u32x4 w;
                        w.x = cvt_pk_bf16(fast_sigmoid(v0[0]), fast_sigmoid(v0[1])); w.y = cvt_pk_bf16(fast_sigmoid(v0[2]), fast_sigmoid(v0[3]));
                        w.z = cvt_pk_bf16(fast_sigmoid(v1[0]), fast_sigmoid(v1[1])); w.w = cvt_pk_bf16(fast_sigmoid(v1[2]), fast_sigmoid(v1[3]));
                        *(u32x4*)(NGb + (size_t)row * 32 + 8 * fq) = w; }
            }
        }
    }
};
struct EpiCmp1 {
    static constexpr bool PERM = true;
    bf16_t* H; const long long* bias;
    __device__ __forceinline__ bool keep(const Unit&) const { return false; }
    __device__ __forceinline__ void operator()(const Acc& acc, const Unit& u, int wr, int wc, int fr, int fq) const {
        const int row0 = u.pm * BM + wr * 64 + fr, col0 = wc * 32 + 8 * fq;
        f32x4 bv[2][2];
#pragma unroll
        for (int bj = 0; bj < 2; ++bj)
#pragma unroll
            for (int n = 0; n < 2; ++n) { const long long* bp = bias + col0 + bj * HALF + 4 * n; bv[bj][n] = f32x4{(float)bp[0], (float)bp[1], (float)bp[2], (float)bp[3]} * (1.0f / CB_SCALE); }
#pragma unroll
        for (int ai = 0; ai < 2; ++ai)
#pragma unroll
            for (int m = 0; m < 4; ++m) { bf16_t* rowp = H + (size_t)(row0 + ai * HALF + m * 16) * 256 + col0;
#pragma unroll
                for (int bj = 0; bj < 2; ++bj) { f32x4 v0 = acc[ai][bj][m][0] + bv[bj][0], v1 = acc[ai][bj][m][1] + bv[bj][1];
#pragma unroll
                    for (int j = 0; j < 4; ++j) { v0[j] = v0[j] * fast_sigmoid(v0[j]); v1[j] = v1[j] * fast_sigmoid(v1[j]); }
                    u32x4 w; w.x = cvt_pk_bf16(v0[0], v0[1]); w.y = cvt_pk_bf16(v0[2], v0[3]); w.z = cvt_pk_bf16(v1[0], v1[1]); w.w = cvt_pk_bf16(v1[2], v1[3]);
                    *(u32x4*)(rowp + bj * HALF) = w; } }
    }
};
struct EpiCmp2 {
    static constexpr bool PERM = true;
    bf16_t* O;
    __device__ __forceinline__ bool keep(const Unit&) const { return false; }
    __device__ __forceinline__ void operator()(const Acc& acc, const Unit& u, int wr, int wc, int fr, int fq) const {
        const int row0 = u.pm * BM + wr * 64 + fr, col0 = wc * 32 + 8 * fq;
#pragma unroll
        for (int ai = 0; ai < 2; ++ai)
#pragma unroll
            for (int m = 0; m < 4; ++m) { const int row = row0 + ai * HALF + m * 16; const float z = ((row & 255) == 255) ? 0.f : 1.f;
                const f32x4 v0 = acc[ai][0][m][0] * z, v1 = acc[ai][0][m][1] * z;
                u32x4 w; w.x = cvt_pk_bf16(v0[0], v0[1]); w.y = cvt_pk_bf16(v0[2], v0[3]); w.z = cvt_pk_bf16(v1[0], v1[1]); w.w = cvt_pk_bf16(v1[2], v1[3]);
                *(u32x4*)(O + (size_t)row * HD + col0) = w; }
    }
};
struct EpiMerge {
    static constexpr bool PERM = true;
    const bf16_t* GMb; unsigned char* Z; float zscale;
    __device__ __forceinline__ bool keep(const Unit& u) const { return u.aux == 0; }
    __device__ __forceinline__ void operator()(Acc& acc, const Unit& u, int wr, int wc, int fr, int fq) const {
        const int row0 = u.pm * BM + wr * 64 + fr, col0 = u.pn * BM + wc * 32 + 8 * fq;
        if (u.aux == 0) {
#pragma unroll
            for (int ai = 0; ai < 2; ++ai)
#pragma unroll
                for (int m = 0; m < 4; ++m) { const int row = row0 + ai * HALF + m * 16;
#pragma unroll
                    for (int bj = 0; bj < 2; ++bj) { const int col = col0 + bj * HALF;
                        const u32x4 g1 = *(const u32x4*)(GMb + (size_t)row * 4096 + 2048 + col), g0 = *(const u32x4*)(GMb + (size_t)row * 4096 + col);
                        const f32x4 g1a = {bf_lo(g1.x), bf_hi(g1.x), bf_lo(g1.y), bf_hi(g1.y)}, g1b = {bf_lo(g1.z), bf_hi(g1.z), bf_lo(g1.w), bf_hi(g1.w)};
                        const f32x4 g0a = {bf_lo(g0.x), bf_hi(g0.x), bf_lo(g0.y), bf_hi(g0.y)}, g0b = {bf_lo(g0.z), bf_hi(g0.z), bf_lo(g0.w), bf_hi(g0.w)};
#pragma unroll
                        for (int j = 0; j < 4; ++j) { acc[ai][bj][m][0][j] *= g0a[j] * __builtin_amdgcn_rcpf(fmaxf(g1a[j], 1e-30f)); acc[ai][bj][m][1][j] *= g0b[j] * __builtin_amdgcn_rcpf(fmaxf(g1b[j], 1e-30f)); } } }
        } else {
            u32x4 gc[2], gn[2];
#pragma unroll
            for (int bj = 0; bj < 2; ++bj) gc[bj] = *(const u32x4*)(GMb + (size_t)row0 * 4096 + 2048 + col0 + bj * HALF);
#pragma unroll
            for (int g = 0; g < 8; ++g) { const int ai = g >> 2, m = g & 3, row = row0 + ai * HALF + m * 16;
                if (g < 7) { const int rn = row0 + ((g + 1) >> 2) * HALF + ((g + 1) & 3) * 16;
#pragma unroll
                    for (int bj = 0; bj < 2; ++bj) gn[bj] = *(const u32x4*)(GMb + (size_t)rn * 4096 + 2048 + col0 + bj * HALF); }
#pragma unroll
                for (int bj = 0; bj < 2; ++bj) { const u32x4 g1 = gc[bj];
                    const f32x4 g1a = {bf_lo(g1.x), bf_hi(g1.x), bf_lo(g1.y), bf_hi(g1.y)}, g1b = {bf_lo(g1.z), bf_hi(g1.z), bf_lo(g1.w), bf_hi(g1.w)};
                    const f32x4 v0 = acc[ai][bj][m][0] * g1a * zscale, v1 = acc[ai][bj][m][1] * g1b * zscale;
                    u32x2 w; w.x = cvt4_fp8(v0[0], v0[1], v0[2], v0[3]); w.y = cvt4_fp8(v1[0], v1[1], v1[2], v1[3]);
                    *(u32x2*)(Z + (size_t)row * D + col0 + bj * HALF) = w; }
                gc[0] = gn[0]; gc[1] = gn[1]; }
        }
    }
};
struct EpiResid {
    static constexpr bool PERM = true;
    const void* xin; int xin16; bf16_t* XB; u64* rsq_out; unsigned char* X8; float ascale;
    __device__ __forceinline__ bool keep(const Unit&) const { return false; }
    __device__ __forceinline__ void ldx(size_t off, f32x4& a, f32x4& b) const {
        if (xin16) { const u32x4 w = *(const u32x4*)((const bf16_t*)xin + off); a = f32x4{bf_lo(w.x), bf_hi(w.x), bf_lo(w.y), bf_hi(w.y)}; b = f32x4{bf_lo(w.z), bf_hi(w.z), bf_lo(w.w), bf_hi(w.w)}; }
        else { a = *(const f32x4*)((const float*)xin + off); b = *(const f32x4*)((const float*)xin + off + 4); } }
    __device__ __forceinline__ void operator()(const Acc& acc, const Unit& u, int wr, int wc, int fr, int fq) const {
        const int row0 = u.pm * BM + wr * 64 + fr, col0 = u.pn * BM + wc * 32 + 8 * fq;
        f32x4 xc[2][2], xn[2][2];
#pragma unroll
        for (int bj = 0; bj < 2; ++bj) ldx((size_t)row0 * D + col0 + bj * HALF, xc[bj][0], xc[bj][1]);
#pragma unroll
        for (int g = 0; g < 8; ++g) { const int ai = g >> 2, m = g & 3, row = row0 + ai * HALF + m * 16; const size_t off = (size_t)row * D + col0; float ss = 0.f;
            if (g < 7) { const size_t offn = (size_t)(row0 + ((g + 1) >> 2) * HALF + ((g + 1) & 3) * 16) * D + col0;
#pragma unroll
                for (int bj = 0; bj < 2; ++bj) ldx(offn + bj * HALF, xn[bj][0], xn[bj][1]); }
#pragma unroll
            for (int bj = 0; bj < 2; ++bj) { const size_t o = off + bj * HALF; const f32x4 x0 = xc[bj][0] + acc[ai][bj][m][0] * ascale, x1 = xc[bj][1] + acc[ai][bj][m][1] * ascale;
                { u32x4 w; w.x = cvt_pk_bf16(x0[0], x0[1]); w.y = cvt_pk_bf16(x0[2], x0[3]); w.z = cvt_pk_bf16(x1[0], x1[1]); w.w = cvt_pk_bf16(x1[2], x1[3]); *(u32x4*)(XB + o) = w; }
                if (X8) { u32x2 w; w.x = cvt4_fp8(x0[0], x0[1], x0[2], x0[3]); w.y = cvt4_fp8(x1[0], x1[1], x1[2], x1[3]); *(u32x2*)(X8 + o) = w; }
                ss += (x0[0] * x0[0] + x0[1] * x0[1]) + (x0[2] * x0[2] + x0[3] * x0[3]) + (x1[0] * x1[0] + x1[1] * x1[1]) + (x1[2] * x1[2] + x1[3] * x1[3]); }
            ss += __shfl_xor(ss, 16); ss += __shfl_xor(ss, 32);
            if (fq == 0) atomicAdd(rsq_out + row, (u64)(ss * RSQ_SCALE + 0.5f));
#pragma unroll
            for (int bj = 0; bj < 2; ++bj)
#pragma unroll
                for (int n = 0; n < 2; ++n) xc[bj][n] = xn[bj][n]; }
    }
};
template <bool MOE, bool OUT8 = MOE, bool W8 = MOE> struct EpiGateUp {
    static constexpr bool PERM = true;
    bf16_t* ACT; const u64* rsq; const int* ltok; const volatile LAS unsigned* misc;
    __device__ __forceinline__ bool keep(const Unit&) const { return false; }
    __device__ __forceinline__ void operator()(const Acc& acc, const Unit& u, int wr, int wc, int fr, int fq) const {
        const int row0 = u.pm * BM + wr * 64 + fr, col0 = u.pn * 128 + wc * 32 + 8 * fq;
        int cnt = 0, r0 = 0; if (MOE) { cnt = (int)misc[8 + u.aux]; r0 = (u.pm - (int)misc[16 + u.aux]) * BM + wr * 64 + fr; }
        int srow[2][4]; u64 rq[2][4];
#pragma unroll
        for (int ai = 0; ai < 2; ++ai)
#pragma unroll
            for (int m = 0; m < 4; ++m) { srow[ai][m] = row0 + ai * HALF + m * 16; if (MOE) { const int r = r0 + ai * HALF + m * 16; srow[ai][m] = r < cnt ? ltok[u.aux * M + r] : 0; } }
#pragma unroll
        for (int ai = 0; ai < 2; ++ai)
#pragma unroll
            for (int m = 0; m < 4; ++m) rq[ai][m] = rsq[srow[ai][m]];
#pragma unroll
        for (int ai = 0; ai < 2; ++ai)
#pragma unroll
            for (int m = 0; m < 4; ++m) { const int row = row0 + ai * HALF + m * 16;
                const float rstd = rsqrtf((float)rq[ai][m] * (1.0f / (RSQ_SCALE * D)) + NORM_EPS) * (W8 ? 1.0f / WGU8_SCALE : 1.0f);
                const float c1 = -1.4426950408889634f * rstd, r2 = rstd * rstd;
                f32x4 a[2];
#pragma unroll
                for (int n = 0; n < 2; ++n) { const f32x4 g = acc[ai][0][m][n], up = acc[ai][1][m][n]; const f32x4 t = g * c1, gu = g * up; f32x4 e, sg;
#pragma unroll
                    for (int j = 0; j < 4; ++j) e[j] = __builtin_amdgcn_exp2f(t[j]);
                    const f32x4 d = e + 1.0f;
#pragma unroll
                    for (int j = 0; j < 4; ++j) sg[j] = __builtin_amdgcn_rcpf(d[j]);
                    a[n] = gu * (sg * r2); }
                if (OUT8) { u32x2 w; w.x = cvt4_fp8(a[0][0], a[0][1], a[0][2], a[0][3]); w.y = cvt4_fp8(a[1][0], a[1][1], a[1][2], a[1][3]); *(u32x2*)((unsigned char*)ACT + (size_t)row * FF + col0) = w; }
                else { u32x4 w; w.x = cvt_pk_bf16(a[0][0], a[0][1]); w.y = cvt_pk_bf16(a[0][2], a[0][3]); w.z = cvt_pk_bf16(a[1][0], a[1][1]); w.w = cvt_pk_bf16(a[1][2], a[1][3]); *(u32x4*)(ACT + (size_t)row * FF + col0) = w; } }
    }
};
struct EpiMoeDown {
    static constexpr bool PERM = true;
    bf16_t* YS; const float* lw; const volatile LAS unsigned* misc;
    __device__ __forceinline__ bool keep(const Unit&) const { return false; }
    __device__ __forceinline__ void operator()(const Acc& acc, const Unit& u, int wr, int wc, int fr, int fq) const {
        const int row0 = u.pm * BM + wr * 64 + fr, col0 = u.pn * BM + wc * 32 + 8 * fq;
        const int cnt = (int)misc[8 + u.aux], r0 = (u.pm - (int)misc[16 + u.aux]) * BM + wr * 64 + fr;
        float wg[2][4];
#pragma unroll
        for (int ai = 0; ai < 2; ++ai)
#pragma unroll
            for (int m = 0; m < 4; ++m) { const int r = r0 + ai * HALF + m * 16; wg[ai][m] = r < cnt ? lw[u.aux * M + r] * (1.0f / WD8_SCALE) : 0.f; }
#pragma unroll
        for (int ai = 0; ai < 2; ++ai)
#pragma unroll
            for (int m = 0; m < 4; ++m) { const int row = row0 + ai * HALF + m * 16; const float wgt = wg[ai][m];
#pragma unroll
                for (int bj = 0; bj < 2; ++bj) { const f32x4 v0 = acc[ai][bj][m][0] * wgt, v1 = acc[ai][bj][m][1] * wgt;
                    u32x4 w; w.x = cvt_pk_bf16(v0[0], v0[1]); w.y = cvt_pk_bf16(v0[2], v0[3]); w.z = cvt_pk_bf16(v1[0], v1[1]); w.w = cvt_pk_bf16(v1[2], v1[3]);
                    *(u32x4*)(YS + (size_t)row * D + col0 + bj * HALF) = w; } }
    }
};
struct EpiMoeDownTail {
    static constexpr bool PERM = true;
    bf16_t* YT; const float* lw; const volatile LAS unsigned* misc;
    __device__ __forceinline__ bool keep(const Unit&) const { return false; }
    __device__ __forceinline__ void operator()(const Acc& acc, const Unit& u, int wr, int wc, int fr, int fq) const {
        const int e = u.aux & 255, part = u.aux >> 8, Tm = (int)misc[25];
        const int row0 = (u.pm - Tm) * BM + wr * 64 + fr, col0 = u.pn * BM + wc * 32 + 8 * fq;
        const int cnt = (int)misc[8 + e], r0 = (u.pm - (int)misc[16 + e]) * BM + wr * 64 + fr;
        float wg[2][4];
#pragma unroll
        for (int ai = 0; ai < 2; ++ai)
#pragma unroll
            for (int m = 0; m < 4; ++m) { const int r = r0 + ai * HALF + m * 16; wg[ai][m] = r < cnt ? lw[e * M + r] * (1.0f / WD8_SCALE) : 0.f; }
        bf16_t* Y = YT + (size_t)part * YT_ROWS * D;
#pragma unroll
        for (int ai = 0; ai < 2; ++ai)
#pragma unroll
            for (int m = 0; m < 4; ++m) { const int row = row0 + ai * HALF + m * 16; const float wgt = wg[ai][m];
#pragma unroll
                for (int bj = 0; bj < 2; ++bj) { const f32x4 v0 = acc[ai][bj][m][0] * wgt, v1 = acc[ai][bj][m][1] * wgt;
                    u32x4 w; w.x = cvt_pk_bf16(v0[0], v0[1]); w.y = cvt_pk_bf16(v0[2], v0[3]); w.z = cvt_pk_bf16(v1[0], v1[1]); w.w = cvt_pk_bf16(v1[2], v1[3]);
                    *(u32x4*)(Y + (size_t)row * D + col0 + bj * HALF) = w; } }
    }
};
}

namespace att {
constexpr float SCALE = 0.08838834764831845f, LOG2E = 1.4426950408889634f, C2 = LOG2E * SCALE, THR = 8.f;
constexpr int TILE_B = 16384;
#define KSWZ(row, colB) ((row) * 256 + ((colB) ^ (((row) & 7) << 4)))
#define SBAR() __builtin_amdgcn_sched_barrier(0)
__device__ __forceinline__ int v_st(int k, int c) { const int kk = (k & ~0xC) | ((k & 4) << 1) | ((k & 8) >> 1); return ((kk >> 3) * 4 + (c >> 5)) * 512 + ((kk & 7) * 32 + (c & 31)) * 2; }
__device__ __forceinline__ int v_rd_base(int lane) { return ((lane & 3) << 3) | (((lane >> 2) & 3) << 6) | (((lane >> 4) & 1) << 5) | (((lane >> 5) & 1) << 8); }
constexpr int v_rd_off(int d0, int ks, int half) { return d0 * 512 + ks * 4096 + half * 2048; }
__device__ __forceinline__ int crow(int r, int hi) { return (r & 3) + 8 * (r >> 2) + 4 * hi; }

__device__ __forceinline__ void mask_tile(f32x16& p0, f32x16& p1, int dq, unsigned W) {
    const float NEG = -__builtin_inff();
#pragma unroll
    for (int r = 0; r < 16; ++r) { const int c = (r & 3) + 8 * (r >> 2);
        if ((unsigned)(dq - c) >= W) p0[r] = NEG;
        if ((unsigned)(dq - c - 32) >= W) p1[r] = NEG; }
}
__device__ __forceinline__ void mask_all(f32x16& p0, f32x16& p1, bool keep) {
    const float NEG = -__builtin_inff();
#pragma unroll
    for (int r = 0; r < 16; ++r) { p0[r] = keep ? p0[r] : NEG; p1[r] = keep ? p1[r] : NEG; }
}
__device__ __forceinline__ float rowmax32(const f32x16& p0, const f32x16& p1) {
    float pmax = p0[0];
#pragma unroll
    for (int r = 1; r < 16; ++r) pmax = fmaxf(pmax, p0[r]);
#pragma unroll
    for (int r = 0; r < 16; ++r) pmax = fmaxf(pmax, p1[r]);
    auto rr = __builtin_amdgcn_permlane32_swap(__float_as_uint(pmax), __float_as_uint(pmax), false, false);
    return fmaxf(__uint_as_float(rr[0]), __uint_as_float(rr[1]));
}
__device__ __forceinline__ float rowsum32(const f32x16& p0, const f32x16& p1) {
    float ps = 0.f;
#pragma unroll
    for (int r = 0; r < 16; ++r) ps += p0[r];
#pragma unroll
    for (int r = 0; r < 16; ++r) ps += p1[r];
    auto rr = __builtin_amdgcn_permlane32_swap(__float_as_uint(ps), __float_as_uint(ps), false, false);
    return __uint_as_float(rr[0]) + __uint_as_float(rr[1]);
}
__device__ __forceinline__ void pack_p(const f32x16& p0, const f32x16& p1, bf16x8& pa0, bf16x8& pa1, bf16x8& pa2, bf16x8& pa3) {
#define PK4(P, B_, OUT) do { unsigned a0 = cvt_pk_bf16(P[B_+0], P[B_+1]), a1 = cvt_pk_bf16(P[B_+2], P[B_+3]);                          \
        unsigned b0 = cvt_pk_bf16(P[B_+4], P[B_+5]), b1 = cvt_pk_bf16(P[B_+6], P[B_+7]);                                             \
        auto r0 = __builtin_amdgcn_permlane32_swap(a0, b0, false, false); auto r1 = __builtin_amdgcn_permlane32_swap(a1, b1, false, false); \
        u32x4 w = {r0[0], r1[0], r0[1], r1[1]}; OUT = *reinterpret_cast<bf16x8*>(&w); } while (0)
    PK4(p0, 0, pa0); PK4(p0, 8, pa1); PK4(p1, 0, pa2); PK4(p1, 8, pa3);
#undef PK4
}
__device__ __forceinline__ void softmax_step(f32x16& p0, f32x16& p1, float& m_reg, float& l_reg, float& alpha) {
    const float pmax = rowmax32(p0, p1); float mn;
    if (__builtin_expect(__all((pmax - m_reg) * SCALE <= THR), 1)) { mn = m_reg; alpha = 1.f; }
    else { mn = fmaxf(m_reg, pmax); alpha = __builtin_amdgcn_exp2f((m_reg - mn) * C2); m_reg = mn; }
    const float mnL = -mn * C2;
#pragma unroll
    for (int r = 0; r < 16; ++r) { p0[r] = __builtin_amdgcn_exp2f(fmaf(p0[r], C2, mnL)); p1[r] = __builtin_amdgcn_exp2f(fmaf(p1[r], C2, mnL)); }
    l_reg = l_reg * alpha + rowsum32(p0, p1);
}
__device__ __forceinline__ void qkt(f32x16& p0, f32x16& p1, const LAS char* K_lds, int r32, int hi, const bf16x8* qr) {
    p0 = f32x16{}; p1 = f32x16{};
    const LAS char* kb[4];
#pragma unroll
    for (int dd = 0; dd < 4; ++dd) kb[dd] = K_lds + KSWZ(r32, (dd * 16 + hi * 8) * 2);
#pragma unroll
    for (int d0 = 0; d0 < 8; ++d0) { const LAS char* a = kb[d0 & 3] + (d0 >> 2) * 128;
        const bf16x8 b0 = *reinterpret_cast<const LAS bf16x8*>(a);
        const bf16x8 b1 = *reinterpret_cast<const LAS bf16x8*>(a + 32 * 256);
        p0 = __builtin_amdgcn_mfma_f32_32x32x16_bf16(b0, qr[d0], p0, 0, 0, 0);
        p1 = __builtin_amdgcn_mfma_f32_32x32x16_bf16(b1, qr[d0], p1, 0, 0, 0); }
}
__device__ __forceinline__ void pv_tile(f32x16* o, int vb0, bf16x8 pa0, bf16x8 pa1, bf16x8 pa2, bf16x8 pa3) {
#define TRRD(dst, off) asm volatile("ds_read_b64_tr_b16 %0, %1 offset:%2" : "=&v"(dst) : "v"(vb0), "i"(off) : "memory")
#define PV_D0(d0) do { s16x4 l0, l1, l2, l3, h0, h1, h2, h3; constexpr int b_ = v_rd_off(d0, 0, 0); \
        TRRD(l0, b_); TRRD(h0, b_ + 2048); TRRD(l1, b_ + 4096); TRRD(h1, b_ + 6144); TRRD(l2, b_ + 8192); TRRD(h2, b_ + 10240); TRRD(l3, b_ + 12288); TRRD(h3, b_ + 14336); \
        asm volatile("s_waitcnt lgkmcnt(0)" ::: "memory"); SBAR();   \
        o[d0] = __builtin_amdgcn_mfma_f32_32x32x16_bf16(pa0, (bf16x8){l0[0], l0[1], l0[2], l0[3], h0[0], h0[1], h0[2], h0[3]}, o[d0], 0, 0, 0);   \
        o[d0] = __builtin_amdgcn_mfma_f32_32x32x16_bf16(pa1, (bf16x8){l1[0], l1[1], l1[2], l1[3], h1[0], h1[1], h1[2], h1[3]}, o[d0], 0, 0, 0);   \
        o[d0] = __builtin_amdgcn_mfma_f32_32x32x16_bf16(pa2, (bf16x8){l2[0], l2[1], l2[2], l2[3], h2[0], h2[1], h2[2], h2[3]}, o[d0], 0, 0, 0);   \
        o[d0] = __builtin_amdgcn_mfma_f32_32x32x16_bf16(pa3, (bf16x8){l3[0], l3[1], l3[2], l3[3], h3[0], h3[1], h3[2], h3[3]}, o[d0], 0, 0, 0); } while (0)
    PV_D0(0); PV_D0(1); PV_D0(2); PV_D0(3);
#undef PV_D0
#undef TRRD
}

struct Ctx {
    int tid, wid, lane, r32, hi, sr, sc, kws, vst0, vst1, vb0;
    LAS char* K_lds; LAS char* V_lds; LAS float* wscr;
};
__device__ __forceinline__ Ctx make_ctx(LAS unsigned char* lds) {
    Ctx c; c.tid = opaque_tid(); c.wid = __builtin_amdgcn_readfirstlane(c.tid >> 6); c.lane = c.tid & 63; c.r32 = c.lane & 31; c.hi = c.lane >> 5;
    c.sr = c.tid >> 4; c.sc = (c.tid & 15) * 8; c.kws = KSWZ(c.sr, c.sc * 2); c.vst0 = v_st(c.sr, c.sc); c.vst1 = v_st(32 + c.sr, c.sc);
    c.K_lds = (LAS char*)(lds + LDS_K); c.V_lds = (LAS char*)(lds + LDS_V); c.wscr = (LAS float*)(lds + LDS_WSCR) + c.wid * 64;
    c.vb0 = (int)(unsigned)(uintptr_t)c.V_lds + v_rd_base(c.lane);
    return c;
}
__device__ __forceinline__ void glds16(const void* sbase, unsigned voff, unsigned lds_dst) { unsigned keep;
    asm volatile("s_mov_b32 %0, m0\n\ts_mov_b32 m0, %3\n\ts_nop 0\n\tglobal_load_lds_dwordx4 %1, %2\n\ts_mov_b32 m0, %0" : "=&s"(keep) : "v"(voff), "s"(sbase), "s"(lds_dst) : "memory"); }
__device__ __forceinline__ const void* uniform_ptr(const void* p) { const unsigned long long v = (unsigned long long)p; const unsigned lo = __builtin_amdgcn_readfirstlane((unsigned)v), hi = __builtin_amdgcn_readfirstlane((unsigned)(v >> 32));
    return (const void*)(GAS const void*)(((unsigned long long)hi << 32) | lo); }
struct Dma { unsigned ko[2], vo[2]; };
__device__ __forceinline__ Dma make_dma(const Ctx& c, int ldk, int ldv) {
    Dma d;
#pragma unroll
    for (int i = 0; i < 2; ++i) { const int p = c.wid * 2 + i, row = 4 * p + (c.lane >> 4); d.ko[i] = (unsigned)(row * ldk + (((c.lane & 15) ^ (row & 7)) * 8)) * 2u;
        const int st = 2 * p + (c.lane >> 5), kk = (st >> 2) * 8 + ((c.lane & 31) >> 2), k = (kk & ~0xC) | ((kk & 4) << 1) | ((kk & 8) >> 1); d.vo[i] = (unsigned)(k * ldv + (st & 3) * 32 + (c.lane & 3) * 8) * 2u; }
    return d;
}
__device__ __forceinline__ void dma_tile(const Ctx& c, const Dma& d, const bf16_t* Kg, int ldk, const bf16_t* Vg, int ldv, int key0, int slot) {
    const void* kb = uniform_ptr(Kg + (size_t)key0 * ldk); const void* vb = uniform_ptr(Vg + (size_t)key0 * ldv);
#pragma unroll
    for (int i = 0; i < 2; ++i) {
        glds16(kb, d.ko[i], (unsigned)__builtin_amdgcn_readfirstlane((int)(unsigned)(uintptr_t)(c.K_lds + slot * TILE_B + (c.wid * 2 + i) * 1024)));
        glds16(vb, d.vo[i], (unsigned)__builtin_amdgcn_readfirstlane((int)(unsigned)(uintptr_t)(c.V_lds + slot * TILE_B + (c.wid * 2 + i) * 1024))); }
}
#define ATT_BAR() do { asm volatile("s_waitcnt lgkmcnt(0)" ::: "memory"); __builtin_amdgcn_s_barrier(); asm volatile("" ::: "memory"); } while (0)
__device__ __forceinline__ void rescale_o(f32x16* o, float alpha, const Ctx& c) {
    if (__any(alpha < 1.f)) { if (c.hi == 0) c.wscr[32 + c.r32] = alpha; LDS_WAIT();
#pragma unroll
        for (int d = 0; d < 4; ++d)
#pragma unroll
            for (int r = 0; r < 16; ++r) o[d][r] *= c.wscr[32 + crow(r, c.hi)];
        LDS_WAIT(); }
}
template <int MODE>
__device__ __forceinline__ void attn_loop_simple(const Ctx& c, const bf16_t* Kg, int ldk, const bf16_t* Vg, int ldv, int j_lo, int NT, const bf16x8* qr,
                                          int qpos, int qlo, int W, unsigned sel_lo, unsigned sel_hi, int diag, f32x16* o, float& m_reg, float& l_reg) {
    f32x16 p0, p1; bf16x8 pa0, pa1, pa2, pa3; float alpha;
    const Dma d = make_dma(c, ldk, ldv);
    dma_tile(c, d, Kg, ldk, Vg, ldv, j_lo * 64, 0);
    if (NT > 1) dma_tile(c, d, Kg, ldk, Vg, ldv, j_lo * 64 + 64, 1);
    int slot = 0, slot2 = 2;
    for (int t = 0; t < NT; ++t) { const int jt = j_lo + t, kb_ = jt * 64, bo = slot * TILE_B;
        if (t + 1 < NT) asm volatile("s_waitcnt vmcnt(4)" ::: "memory"); else asm volatile("s_waitcnt vmcnt(0)" ::: "memory");
        ATT_BAR();
        if (t + 2 < NT) dma_tile(c, d, Kg, ldk, Vg, ldv, kb_ + 128, slot2);
        SBAR(); qkt(p0, p1, c.K_lds + bo, c.r32, c.hi, qr);
        if (MODE == 0) { if (kb_ + 63 > qlo || kb_ <= qlo + 31 - W) mask_tile(p0, p1, qpos - kb_ - 4 * c.hi, (unsigned)W); }
        else { const unsigned bit = (jt < 32 ? (sel_lo >> jt) : (sel_hi >> (jt - 32))) & 1u; mask_all(p0, p1, bit != 0u);
               if (jt == diag) mask_tile(p0, p1, qpos - kb_ - 4 * c.hi, 0x40000000u); }
        softmax_step(p0, p1, m_reg, l_reg, alpha); pack_p(p0, p1, pa0, pa1, pa2, pa3); rescale_o(o, alpha, c);
        pv_tile(o, c.vb0 + bo, pa0, pa1, pa2, pa3);
        slot = slot == 2 ? 0 : slot + 1; slot2 = slot2 == 2 ? 0 : slot2 + 1; }
    ATT_BAR();
}
template <int MODE>
__device__ __forceinline__ void attn_loop(const Ctx& c, const bf16_t* Kg, int ldk, const bf16_t* Vg, int ldv, int j_lo, int NT, const bf16x8* qr,
                                          int qpos, int qlo, int W, unsigned sel_lo, unsigned sel_hi, int diag, f32x16* o, float& m_reg, float& l_reg) {
    f32x16 pA0, pA1, pB0, pB1; bf16x8 pa0, pa1, pa2, pa3; float alpha;
    const Dma d = make_dma(c, ldk, ldv);
    dma_tile(c, d, Kg, ldk, Vg, ldv, j_lo * 64, 0);
    if (NT > 1) { dma_tile(c, d, Kg, ldk, Vg, ldv, j_lo * 64 + 64, 1); asm volatile("s_waitcnt vmcnt(4)" ::: "memory"); } else asm volatile("s_waitcnt vmcnt(0)" ::: "memory");
    ATT_BAR();
    if (NT > 2) dma_tile(c, d, Kg, ldk, Vg, ldv, j_lo * 64 + 128, 2);
    SBAR(); qkt(pA0, pA1, c.K_lds, c.r32, c.hi, qr);
#define ATT_STEP(PX0, PX1, PY0, PY1, t_) do { const int t = (t_), jt = j_lo + t, kb_ = jt * 64;                                          \
        if (t + 1 < NT) { if (t + 2 < NT) asm volatile("s_waitcnt vmcnt(4)" ::: "memory"); else asm volatile("s_waitcnt vmcnt(0)" ::: "memory"); }     \
        ATT_BAR();                                                                           \
        if (t + 3 < NT) dma_tile(c, d, Kg, ldk, Vg, ldv, kb_ + 192, (t + 3) & 3);                           \
        SBAR(); if (t + 1 < NT) qkt(PY0, PY1, c.K_lds + ((t + 1) & 3) * TILE_B, c.r32, c.hi, qr);          \
        SBAR();                                                                                  \
        if (MODE == 0) { if (kb_ + 63 > qlo || kb_ <= qlo + 31 - W) mask_tile(PX0, PX1, qpos - kb_ - 4 * c.hi, (unsigned)W); }            \
        else { const unsigned bit = (jt < 32 ? (sel_lo >> jt) : (sel_hi >> (jt - 32))) & 1u; mask_all(PX0, PX1, bit != 0u);               \
               if (jt == diag) mask_tile(PX0, PX1, qpos - kb_ - 4 * c.hi, 0x40000000u); }                                                \
        softmax_step(PX0, PX1, m_reg, l_reg, alpha); pack_p(PX0, PX1, pa0, pa1, pa2, pa3); rescale_o(o, alpha, c);                        \
        pv_tile(o, c.vb0 + (t & 3) * TILE_B, pa0, pa1, pa2, pa3); } while (0)
    for (int t2 = 0; t2 < NT; t2 += 2) { ATT_STEP(pA0, pA1, pB0, pB1, t2); if (t2 + 1 < NT) ATT_STEP(pB0, pB1, pA0, pA1, t2 + 1); }
#undef ATT_STEP
    ATT_BAR();
}
__device__ __forceinline__ void load_q(bf16x8* qr, const bf16_t* qrow, int hi) {
#pragma unroll
    for (int d0 = 0; d0 < 8; ++d0) qr[d0] = *(const bf16x8*)(qrow + d0 * 16 + hi * 8);
    asm volatile("" :: "v"(qr[0]), "v"(qr[1]), "v"(qr[2]), "v"(qr[3]), "v"(qr[4]), "v"(qr[5]), "v"(qr[6]), "v"(qr[7]));
}
template <bool ADD, bool OUT8 = false>
__device__ __forceinline__ void store_o(const f32x16* o, float frow, const Ctx& c, bf16_t* Og, int ldo, float fold_row = 1.0f, bool has_fold = false, unsigned char* O8 = nullptr) {
    if (c.hi == 0) { c.wscr[c.r32] = frow; c.wscr[32 + c.r32] = fold_row; } LDS_WAIT();
    LAS float* stg = (LAS float*)(c.K_lds + c.wid * 16384);
#pragma unroll
    for (int r = 0; r < 16; ++r) { const int row = crow(r, c.hi); const float f = c.wscr[row];
#pragma unroll
        for (int d0 = 0; d0 < 4; ++d0) stg[row * 128 + d0 * 32 + c.r32] = o[d0][r] * f; }
    LDS_WAIT();
    const int cc = c.lane & 15, rq = c.lane >> 4;
#pragma unroll
    for (int hb = 0; hb < 8; hb += 4) {
        int hbv = hb; asm volatile("" : "+v"(hbv));
        u32x4 old[4];
        if (ADD) {
#pragma unroll
            for (int i = 0; i < 4; ++i) old[i] = *(const u32x4*)(Og + (size_t)(rq + 4 * (hbv + i)) * 1024 + cc * 8);
        }
#pragma unroll
        for (int i = 0; i < 4; ++i) { const int row = rq + 4 * (hbv + i);
            f32x4 v0 = *(const LAS f32x4*)(stg + row * 128 + cc * 8), v1 = *(const LAS f32x4*)(stg + row * 128 + cc * 8 + 4);
            if (ADD) { const float fo = has_fold ? c.wscr[32 + row] : 1.0f;
                v0[0] = fmaf(bf_lo(old[i].x), fo, v0[0]); v0[1] = fmaf(bf_hi(old[i].x), fo, v0[1]); v0[2] = fmaf(bf_lo(old[i].y), fo, v0[2]); v0[3] = fmaf(bf_hi(old[i].y), fo, v0[3]);
                v1[0] = fmaf(bf_lo(old[i].z), fo, v1[0]); v1[1] = fmaf(bf_hi(old[i].z), fo, v1[1]); v1[2] = fmaf(bf_lo(old[i].w), fo, v1[2]); v1[3] = fmaf(bf_hi(old[i].w), fo, v1[3]); }
            if constexpr (OUT8) { u32x2 w; w.x = cvt4_fp8(v0[0] * O8_SCALE, v0[1] * O8_SCALE, v0[2] * O8_SCALE, v0[3] * O8_SCALE); w.y = cvt4_fp8(v1[0] * O8_SCALE, v1[1] * O8_SCALE, v1[2] * O8_SCALE, v1[3] * O8_SCALE);
                *(u32x2*)(O8 + (size_t)row * ldo + cc * 8) = w; }
            else { u32x4 w; w.x = cvt_pk_bf16(v0[0], v0[1]); w.y = cvt_pk_bf16(v0[2], v0[3]); w.z = cvt_pk_bf16(v1[0], v1[1]); w.w = cvt_pk_bf16(v1[2], v1[3]);
                *(u32x4*)(Og + (size_t)row * ldo + cc * 8) = w; } }
        asm volatile("" ::: "memory");
    }
    LDS_WAIT();
}
}

struct Frame {
    LAS unsigned char* lds; volatile LAS unsigned* misc; unsigned* ctl;
    int tid, lane, wave, G, vcu;
    const float* const* in; float* out; unsigned char* ws;
};
__device__ __forceinline__ void launder(Frame& F) { unsigned long long w_ = (unsigned long long)F.ws; asm volatile("" : "+s"(w_)); F.ws = (unsigned char*)(GAS unsigned char*)w_; F.out = (float*)(GAS float*)F.out; F.ctl = (unsigned*)(GAS unsigned*)F.ctl; asm volatile("" : "+v"(F.tid)); F.lane = F.tid & 63; F.wave = __builtin_amdgcn_readfirstlane(F.tid >> 6); }
enum { IN_X = 0, IN_ANORM, IN_WIN, IN_SINK, IN_PEK, IN_PEV, IN_WK1, IN_WK2, IN_WV1, IN_WV2, IN_WUPA, IN_WUPB, IN_WO, IN_FNORM, IN_DWG, IN_DWU, IN_DWD, IN_RW, IN_MWG, IN_MWU, IN_MWD, IN_FINAL };
#define INP(i) ((const float*)(const GAS float*)F.in[i])
#define WSP(T_, off) ((T_*)(F.ws + (off)))
#define BGP(T_, off) ((T_*)(F.ws + WS_BIG + (off)))

__device__ __forceinline__ int queue_pop(Frame& F, int q) {
    __syncthreads();
    if (F.tid == 0) F.misc[2] = __hip_atomic_fetch_add(F.ctl + CW_QUEUE + 64 * q, 1u, RLX_AGENT);
    __syncthreads();
    return (int)F.misc[2];
}

__device__ __forceinline__ int tr_drow(int mode, int n, int nn) {
    if (mode == 0) return n;
    if (mode == 1) { if (n < 4096) { const int d = n & 127; return (n & ~127) + 32 * ((d >> 4) & 3) + 8 * ((d >> 2) & 3) + 4 * (d >> 6) + (d & 3); }
                     return n < 4120 ? 8192 + (n - 4096) : 4096 + (n - 4120); }
    return 256 * (n >> 7) + 128 * nn + (n & 127);
}
__device__ __forceinline__ void tr_item(int mode, int nn, const float* W, int ld, int nsrc, const float* gain, int K, bf16_t* WT, int item, int nblk, int lane) {
    const int kb = item / nblk, nb = item - kb * nblk, kg = lane & 7, nq = lane >> 3, k0 = 64 * kb + 8 * kg, n = 32 * nb + 4 * nq;
    if (n >= nsrc) return;
    const float* p = W + (size_t)k0 * ld + n; f32x4 v[8];
#pragma unroll
    for (int j = 0; j < 8; ++j) v[j] = __builtin_nontemporal_load((const f32x4*)(p + (size_t)j * ld));
    if (gain) { const f32x4 g0 = *(const f32x4*)(gain + k0), g1 = *(const f32x4*)(gain + k0 + 4);
#pragma unroll
        for (int j = 0; j < 4; ++j) { v[j] = v[j] * g0[j]; v[4 + j] = v[4 + j] * g1[j]; } }
    const int c = tr_drow(mode, n, nn);
#pragma unroll
    for (int q = 0; q < 4; ++q) { u32x4 o; o.x = cvt_pk_bf16(v[0][q], v[1][q]); o.y = cvt_pk_bf16(v[2][q], v[3][q]); o.z = cvt_pk_bf16(v[4][q], v[5][q]); o.w = cvt_pk_bf16(v[6][q], v[7][q]);
        *(u32x4*)(WT + (size_t)(c + q) * K + k0) = o; }
}
__device__ __forceinline__ void tr_item8(int mode, int nn, const float* W, int ld, int nsrc, const float* gain, float scale, int K, unsigned char* WT, int item, int nblk, int lane) {
    const int kb = item / nblk, nb = item - kb * nblk, kg = lane & 7, nq = lane >> 3, k0 = 128 * kb + 16 * kg, n = 32 * nb + 4 * nq;
    if (n >= nsrc) return;
    const float* p = W + (size_t)k0 * ld + n; f32x4 v[16];
#pragma unroll
    for (int j = 0; j < 16; ++j) v[j] = __builtin_nontemporal_load((const f32x4*)(p + (size_t)j * ld));
#pragma unroll
    for (int j4 = 0; j4 < 4; ++j4) { f32x4 g = {scale, scale, scale, scale}; if (gain) g = *(const f32x4*)(gain + k0 + 4 * j4) * scale;
#pragma unroll
        for (int j = 0; j < 4; ++j) v[4 * j4 + j] = v[4 * j4 + j] * g[j]; }
    const int c = tr_drow(mode, n, nn);
#pragma unroll
    for (int q = 0; q < 4; ++q) { u32x4 o; o.x = cvt4_fp8(v[0][q], v[1][q], v[2][q], v[3][q]); o.y = cvt4_fp8(v[4][q], v[5][q], v[6][q], v[7][q]); o.z = cvt4_fp8(v[8][q], v[9][q], v[10][q], v[11][q]); o.w = cvt4_fp8(v[12][q], v[13][q], v[14][q], v[15][q]);
        __builtin_nontemporal_store(o, (u32x4*)(WT + (size_t)(c + q) * K + k0)); }
}
__device__ __forceinline__ void p_prologue(Frame F) {
    launder(F);
    const int gw = F.vcu * NWAVES + F.wave, NGW = F.G * NWAVES, lane = F.lane;
    constexpr int NB_IN = (IN_DIM + 31) / 32;
    { long long* cb = WSP(long long, WS_CBIAS);
      for (int u = gw; u < 1024; u += NGW) { const int q = u >> 8, l = q >> 1, kv = q & 1, nb = (u >> 6) & 3, kc = u & 63, n = nb * 64 + lane;
          const float* pe = INP(kv ? IN_PEV : IN_PEK) + (size_t)l * 4096 + kc * 64; const float* w1 = INP(kv ? IN_WV1 : IN_WK1) + (size_t)l * 4096 * 256 + (size_t)kc * 64 * 256 + n;
          float wv[64];
#pragma unroll
          for (int k = 0; k < 64; ++k) wv[k] = w1[(size_t)k * 256];
          float a0 = 0.f, a1 = 0.f, a2 = 0.f, a3 = 0.f;
#pragma unroll
          for (int k = 0; k < 64; k += 4) { a0 = fmaf(pe[k], wv[k], a0); a1 = fmaf(pe[k + 1], wv[k + 1], a1); a2 = fmaf(pe[k + 2], wv[k + 2], a2); a3 = fmaf(pe[k + 3], wv[k + 3], a3); }
          const float sum = (a0 + a1) + (a2 + a3);
          atomicAdd((unsigned long long*)(cb + q * 256 + n), (unsigned long long)(long long)rintf(sum * CB_SCALE)); } }
    constexpr int I_WIN = (D / 128) * NB_IN, I_W1 = (4096 / 64) * (256 / 32), I_W2 = (256 / 64) * (128 / 32), I_WUP = (1024 / 128) * (D / 32), I_WO = (D / 128) * (D / 32);
    {   constexpr int BI_G = (D / 128) * (FF / 256), BI_D = (FF / 128) * (D / 256), NBI = 16 * BI_G + 9 * BI_D;
        LAS unsigned char* tile = F.lds;
        for (int bi = F.vcu; bi < NBI; bi += F.G) {
            const float* W; const float* gain = nullptr; float scale; unsigned char* dst; int ld, Kd, mode = 0, nn = 0, kb, nb;
            if (bi < 16 * BI_G) { const int q = bi / BI_G, r = bi - q * BI_G, e = q >> 1; nn = q & 1; mode = 2; W = INP(nn ? IN_MWU : IN_MWG) + (size_t)e * D * FF; ld = FF; gain = INP(IN_FNORM) + D; scale = WGU8_SCALE;
                dst = WSP(unsigned char, WS_WGUM + (size_t)e * SZ_WGU8); Kd = D; kb = r / (FF / 256); nb = r - kb * (FF / 256); }
            else { const int r0 = bi - 16 * BI_G, e = r0 / BI_D, r = r0 - e * BI_D; ld = D; scale = WD8_SCALE;
                if (e < 8) { W = INP(IN_MWD) + (size_t)e * FF * D; dst = WSP(unsigned char, WS_WDM + (size_t)e * SZ_WD8); } else { W = INP(IN_DWD); dst = WSP(unsigned char, WS_WDD); }
                Kd = FF; kb = r / (D / 256); nb = r - kb * (D / 256); }
            const int k0 = 128 * kb + 16 * F.wave, n = 256 * nb + 4 * lane;
            const float* p = W + (size_t)k0 * ld + n; f32x4 v[16];
#pragma unroll
            for (int j = 0; j < 16; ++j) v[j] = __builtin_nontemporal_load((const f32x4*)(p + (size_t)j * ld));
#pragma unroll
            for (int j = 0; j < 16; ++j) { const float g = gain ? gain[k0 + j] * scale : scale; v[j] = v[j] * g; }
#pragma unroll
            for (int q = 0; q < 4; ++q) { u32x4 o; o.x = cvt4_fp8(v[0][q], v[1][q], v[2][q], v[3][q]); o.y = cvt4_fp8(v[4][q], v[5][q], v[6][q], v[7][q]); o.z = cvt4_fp8(v[8][q], v[9][q], v[10][q], v[11][q]); o.w = cvt4_fp8(v[12][q], v[13][q], v[14][q], v[15][q]);
                *(LAS u32x4*)(tile + (4 * lane + q) * 144 + 16 * F.wave) = o; }
            __syncthreads();
#pragma unroll
            for (int i = 0; i < 4; ++i) { const int nrow = 32 * F.wave + 8 * i + (lane >> 3), ch = lane & 7;
                const u32x4 o = *(const LAS u32x4*)(tile + nrow * 144 + 16 * ch);
                __builtin_nontemporal_store(o, (u32x4*)(dst + (size_t)tr_drow(mode, 256 * nb + nrow, nn) * Kd + 128 * kb + 16 * ch)); }
            __syncthreads();
        }
    }
    constexpr int I_G = (D / 64) * (FF / 32);
    constexpr int NITEMS = 2 * I_WIN + 4 * I_W1 + 4 * I_W2 + 4 * I_WUP + 2 * I_WO + 2 * I_G;
    for (int it = gw; it < NITEMS; it += NGW) {
        int r = it;
        if (r < 2 * I_G) { const int nn = r / I_G; r -= nn * I_G;
            tr_item(2, nn, INP(nn ? IN_DWU : IN_DWG), FF, FF, INP(IN_FNORM), D, WSP(bf16_t, WS_WGUD), r, FF / 32, lane); continue; } r -= 2 * I_G;
        if (r < 2 * I_WIN) { const int l = r / I_WIN; r -= l * I_WIN;
            tr_item8(1, 0, INP(IN_WIN) + (size_t)l * D * IN_DIM, IN_DIM, IN_DIM, INP(IN_ANORM) + l * D, WIN8_SCALE, D, WSP(unsigned char, WS_WIN + l * SZ_WIN), r, NB_IN, lane); continue; } r -= 2 * I_WIN;
        if (r < 4 * I_W1) { const int q = r / I_W1; r -= q * I_W1; const int l = q >> 1, kv = q & 1;
            tr_item(0, 0, INP(kv ? IN_WV1 : IN_WK1) + (size_t)l * 4096 * 256, 256, 256, nullptr, 4096, WSP(bf16_t, WS_W1 + q * SZ_W1), r, 256 / 32, lane); continue; } r -= 4 * I_W1;
        if (r < 4 * I_W2) { const int q = r / I_W2; r -= q * I_W2; const int l = q >> 1, kv = q & 1;
            tr_item(0, 0, INP(kv ? IN_WV2 : IN_WK2) + (size_t)l * 256 * 128, 128, 128, nullptr, 256, WSP(bf16_t, WS_W2 + q * SZ_W2), r, 128 / 32, lane); continue; } r -= 4 * I_W2;
        if (r < 4 * I_WUP) { const int q = r / I_WUP; r -= q * I_WUP; const int l = q >> 1, ab = q & 1;
            tr_item8(0, 0, INP(ab ? IN_WUPB : IN_WUPA) + (size_t)l * 1024 * D, D, D, nullptr, WUP8_SCALE, 1024, WSP(unsigned char, WS_WUP + q * SZ_WUP), r, D / 32, lane); continue; } r -= 4 * I_WUP;
        { const int l = r / I_WO; r -= l * I_WO;
            tr_item8(0, 0, INP(IN_WO) + (size_t)l * D * D, D, D, nullptr, WO8_SCALE, D, WSP(unsigned char, WS_WO + l * SZ_WO), r, D / 32, lane); }
    }
    { const int gt = gw * 64 + lane, NGT = NGW * 64; const u32x4 z = {0u, 0u, 0u, 0u};
      for (int i = gt; i < 2 * (NIN - IN_DIM) * (D / 16); i += NGT) { const int l = i / ((NIN - IN_DIM) * (D / 16)), j = i - l * ((NIN - IN_DIM) * (D / 16)); *((u32x4*)(WSP(unsigned char, WS_WIN + l * SZ_WIN) + (size_t)IN_DIM * D) + j) = z; }
      for (int i = gt; i < 4 * 128 * (256 / 8); i += NGT) { const int q = i / (128 * 32), j = i - q * (128 * 32); *((u32x4*)(WSP(bf16_t, WS_W2 + q * SZ_W2) + (size_t)128 * 256) + j) = z; } }
    { const float* x = INP(IN_X); unsigned char* x8 = WSP(unsigned char, WS_X8); u64* rsq = WSP(u64, WS_RSQ);
      for (int m = gw; m < M; m += NGW) { const f32x4* xr = (const f32x4*)(x + (size_t)m * D) + lane; f32x4 v[8]; float s = 0.f;
#pragma unroll
          for (int j = 0; j < 8; ++j) { v[j] = xr[64 * j]; s += (v[j][0] * v[j][0] + v[j][1] * v[j][1]) + (v[j][2] * v[j][2] + v[j][3] * v[j][3]); }
          s = wave_sum(s); if (lane == 0) rsq[m] = (u64)(s * RSQ_SCALE + 0.5f);
          unsigned* o4 = (unsigned*)(x8 + (size_t)m * D) + lane;
#pragma unroll
          for (int j = 0; j < 8; ++j) o4[64 * j] = cvt4_fp8(v[j][0], v[j][1], v[j][2], v[j][3]); } }
    { float* cosT = WSP(float, WS_ROPE); float* sinT = cosT + T * 64; const int gt = gw * 64 + lane, NGT = NGW * 64;
      for (int i = gt; i < T * 64; i += NGT) { const int t = i >> 6, d = i & 63; const float inv = (float)exp(-9.210340371976184 * (double)d / 64.0); const float ang = (float)t * inv;
          cosT[i] = (float)cos((double)ang); sinT[i] = (float)sin((double)ang); } }
}

__device__ __forceinline__ void p_attn_a(Frame F, int layer) {
    launder(F);
    bf16_t* QKV = BGP(bf16_t, BG_QKV); const bf16_t* NGb = BGP(bf16_t, BG_NG);
#ifndef NO_CMP
    if (blockIdx.x < 16) {
        const int kv = blockIdx.x >> 3, pm = blockIdx.x & 7, q = layer * 2 + kv;
        bf16_t* H = BGP(bf16_t, BG_HC) + (size_t)kv * 2048 * 256;
        { pg8::SchedOne S{BGP(bf16_t, kv ? BG_VCB : BG_KCB), WSP(bf16_t, WS_W1 + q * SZ_W1), 2048 * 2, 4096 * 2, pm, 0};
          pg8::EpiCmp1 E{H, WSP(long long, WS_CBIAS) + q * 256};
          pg8::gemm_phase<false>(F.lds, 4096 * 2, S, E); }
        VM_WAIT(); __syncthreads(); __builtin_amdgcn_fence(__ATOMIC_ACQUIRE, "agent"); VM_WAIT(); __syncthreads();
        { pg8::SchedOne S{H, WSP(bf16_t, WS_W2 + q * SZ_W2), 256 * 2, 256 * 2, pm, 0};
          pg8::EpiCmp2 E{BGP(bf16_t, kv ? BG_VCMP : BG_KCMP)};
          pg8::gemm_phase<false>(F.lds, 256 * 2, S, E); }
        __syncthreads();
    }
#endif
    const att::Ctx c = att::make_ctx(F.lds);
    const float* sinks = INP(IN_SINK) + layer * 8;
    const int nstat = (int)F.G - 16; bool first = blockIdx.x >= 16;
    for (;;) {
        int u = first ? (int)blockIdx.x - 16 : nstat + queue_pop(F, layer * 2 + 0); first = false; if (u >= 1024 + 64) break;
        if (u < 64) {
            pg8::SchedOne S{WSP(unsigned char, WS_X8), WSP(unsigned char, WS_WIN + layer * SZ_WIN), D, D, u, 32};
            pg8::EpiIn E{BGP(bf16_t, BG_QKV), BGP(bf16_t, BG_KCB), BGP(bf16_t, BG_VCB), BGP(bf16_t, BG_GM), BGP(bf16_t, BG_NG), WSP(u64, WS_RSQ) + (2 * layer) * M, WSP(float, WS_ROPE), WSP(float, WS_ROPE) + T * 64, 1.0f / WIN8_SCALE, F.lds + LDS_WSCR};
            pg8::gemm_phase<true>(F.lds, D, S, E); __syncthreads(); continue; }
        u -= 64;
        const bool swa = u >= 512; const int v = u & 511, qt = 63 - (v >> 3), bg = v & 7, b = bg >> 1, g = bg & 1;
        const int t0 = qt * 64, h = 4 * g + (c.wid >> 1), trow = t0 + 32 * (c.wid & 1);
        const size_t rowbase = (size_t)b * T;
        const int qcol = (swa ? 0 : 1536) + h * HD, kcol = (swa ? 1024 : 3584) + g * HD, vcol = (swa ? 1280 : 3840) + g * HD, W = swa ? 128 : 512;
        bf16x8 qr[8]; att::load_q(qr, QKV + (rowbase + trow + c.r32) * 4096 + qcol, c.hi);
        const int j_lo = (t0 - W + 1) > 0 ? (t0 - W + 1) / 64 : 0, NT = qt - j_lo + 1;
        f32x16 o[4] = {}; float m_reg = -1e30f, l_reg = 0.f;
        att::attn_loop<0>(c, QKV + rowbase * 4096 + kcol, 4096, QKV + rowbase * 4096 + vcol, 4096, j_lo, NT, qr, trow + c.r32, trow, W, 0u, 0u, -1, o, m_reg, l_reg);
        float f;
        if (swa) { const float lt = l_reg + __builtin_amdgcn_exp2f(sinks[h] * att::LOG2E - m_reg * att::C2); f = 1.0f / lt; }
        else f = 1.0f / l_reg;
        if (swa) att::store_o<false, true>(o, f, c, nullptr, 1024, 1.0f, false, BGP(unsigned char, BG_OA) + (rowbase + trow) * 1024 + h * HD);
        else att::store_o<false>(o, f, c, BGP(bf16_t, BG_OB) + (rowbase + trow) * 1024 + h * HD, 1024);
    }
}

__device__ __forceinline__ void p_attn_b(Frame F, int layer) {
    launder(F);
    const bf16_t* QKV = BGP(bf16_t, BG_QKV); const bf16_t* NGb = BGP(bf16_t, BG_NG);
    const att::Ctx c = att::make_ctx(F.lds);
    LAS unsigned* IMP = (LAS unsigned*)(F.lds + LDS_IMP);
    volatile LAS unsigned* SELM = (volatile LAS unsigned*)(F.lds + LDS_SELM);
    bool first = true;
    for (;;) {
        const int u = first ? (int)blockIdx.x : (int)F.G + queue_pop(F, layer * 2 + 1); first = false; if (u >= 512) break;
        const int qt = 63 - (u >> 3), bg = u & 7, b = bg >> 1, g = bg & 1;
        const int t0 = qt * 64, h = 4 * g + (c.wid >> 1), trow = t0 + 32 * (c.wid & 1), tl = 32 * (c.wid & 1) + c.r32;
        const size_t rowbase = (size_t)b * T; const int pos = trow + c.r32;
        for (int i = c.tid; i < 64 * 65; i += NTHREADS) IMP[i] = 0u;
        bf16x8 qr[8]; att::load_q(qr, QKV + (rowbase + pos) * 4096 + 1536 + h * HD, c.hi);
        const int maxc = (t0 + 63 - 31) >> 4, NTc = (maxc >> 6) + 1;
        const bf16_t* Kc = BGP(bf16_t, BG_KCMP) + (size_t)bg * 256 * HD; const bf16_t* Vc = BGP(bf16_t, BG_VCMP) + (size_t)bg * 256 * HD;
        { const att::Dma dc = att::make_dma(c, HD, HD); for (int j = 0; j < NTc; ++j) att::dma_tile(c, dc, Kc, HD, Vc, HD, j * 64, j); }
        VM_WAIT(); __syncthreads();
        const int cpos = (pos - 31) >> 4;
        float m_reg = -1e30f, l_reg = 0.f;
        {
            f32x16 p0, p1; float alpha;
#pragma unroll 1
            for (int J = 0; J < NTc; ++J) { att::qkt(p0, p1, c.K_lds + J * att::TILE_B, c.r32, c.hi, qr); att::mask_tile(p0, p1, cpos - J * 64 - 4 * c.hi, 0x40000000u); att::softmax_step(p0, p1, m_reg, l_reg, alpha); }
        }
        f32x16 o[4] = {};
        {
            const float inv_l = l_reg > 0.f ? 1.0f / l_reg : 0.f, mnL = -m_reg * att::C2; f32x16 p0, p1; bf16x8 pa0, pa1, pa2, pa3;
#pragma unroll 1
            for (int J = 0; J < NTc; ++J) { att::qkt(p0, p1, c.K_lds + J * att::TILE_B, c.r32, c.hi, qr); att::mask_tile(p0, p1, cpos - J * 64 - 4 * c.hi, 0x40000000u);
#pragma unroll
                for (int r = 0; r < 16; ++r) { p0[r] = __builtin_amdgcn_exp2f(fmaf(p0[r], att::C2, mnL)) * inv_l; p1[r] = __builtin_amdgcn_exp2f(fmaf(p1[r], att::C2, mnL)) * inv_l; }
                LAS unsigned* irow = IMP + tl * 65 + J * 16 + c.hi; constexpr float IS = 67108864.0f;
#pragma unroll
                for (int jj = 0; jj < 4; ++jj) {
                    atomicAdd((unsigned*)(irow + 2 * jj), (unsigned)((p0[4 * jj] + p0[4 * jj + 1] + p0[4 * jj + 2] + 0.5f * p0[4 * jj + 3]) * IS + 0.5f)); atomicAdd((unsigned*)(irow + 2 * jj + 1), (unsigned)(0.5f * p0[4 * jj + 3] * IS + 0.5f));
                    atomicAdd((unsigned*)(irow + 2 * jj + 8), (unsigned)((p1[4 * jj] + p1[4 * jj + 1] + p1[4 * jj + 2] + 0.5f * p1[4 * jj + 3]) * IS + 0.5f)); atomicAdd((unsigned*)(irow + 2 * jj + 9), (unsigned)(0.5f * p1[4 * jj + 3] * IS + 0.5f)); }
                att::pack_p(p0, p1, pa0, pa1, pa2, pa3); att::pv_tile(o, c.vb0 + J * att::TILE_B, pa0, pa1, pa2, pa3); }
        }
        bf16_t* Og = BGP(bf16_t, BG_OB) + (rowbase + trow) * 1024 + h * HD;
        __syncthreads();
        { const float g0 = bf2f(NGb[(rowbase + pos) * 32 + h * 3 + 0]), g2 = bf2f(NGb[(rowbase + pos) * 32 + h * 3 + 2]); att::store_o<true>(o, g0, c, Og, 1024, g2, true); }
        for (int i = 0; i < 8; ++i) { const int tk = c.wid * 8 + i, s = c.lane; volatile LAS unsigned* row = (volatile LAS unsigned*)IMP + tk * 65;
            const unsigned raw = row[s]; const bool forced = (s == 0) | (s == qt) | (s == qt - 1), valid = s <= qt;
            unsigned key = ((((raw >> 6) + 1u) << 6) | (unsigned)(63 - s)); key = forced ? (0xFFFFFFC0u | (unsigned)(63 - s)) : key; key = valid ? key : 0u;
            row[s] = key; LDS_WAIT();
            int rank = 0;
#pragma unroll 16
            for (int j = 0; j < 64; ++j) rank += (row[j] > key) ? 1 : 0;
            const unsigned long long bal = __ballot(rank < 16 && key != 0u);
            if (c.lane == 0) { SELM[2 * tk] = (unsigned)bal; SELM[2 * tk + 1] = (unsigned)(bal >> 32); } }
        __syncthreads();
        const unsigned sel_lo = SELM[2 * tl], sel_hi = SELM[2 * tl + 1];
#pragma unroll
        for (int d = 0; d < 4; ++d) o[d] = f32x16{};
        m_reg = -1e30f; l_reg = 0.f;
        att::attn_loop_simple<2>(c, QKV + rowbase * 4096 + 3072 + g * HD, 4096, QKV + rowbase * 4096 + 3328 + g * HD, 4096, 0, qt + 1, qr, pos, trow, 0, sel_lo, sel_hi, qt, o, m_reg, l_reg);
        { const float g1 = bf2f(NGb[(rowbase + pos) * 32 + h * 3 + 1]); VM_WAIT(); att::store_o<true, true>(o, g1 / l_reg, c, Og, 1024, 1.0f, false, BGP(unsigned char, BG_OA) + (size_t)M * 1024 + (rowbase + trow) * 1024 + h * HD); }
    }
}

__device__ __forceinline__ void p_router(Frame F) {
    launder(F);
    LAS float* wr = (LAS float*)F.lds;
    const float* rw = INP(IN_RW); const float* gain = INP(IN_FNORM) + D;
    for (int i = F.tid; i < D * 8; i += NTHREADS) wr[i] = rw[i] * gain[i >> 3];
    LAS int* te = (LAS int*)(F.lds + 65536); LAS float* tw = (LAS float*)(F.lds + 65536 + 1024);
    const bf16_t* XB = WSP(bf16_t, WS_XBF); const u64* rsq = WSP(u64, WS_RSQ) + 3 * M;
    int* ltok = WSP(int, WS_LTOK); float* lw = WSP(float, WS_LW); int* slot = WSP(int, WS_SLOT);
    for (int chunk = blockIdx.x; chunk < M / 64; chunk += F.G) {
        __syncthreads();
        for (int i = 0; i < 8; ++i) { const int tl = F.wave * 8 + i, tok = chunk * 64 + tl;
            const u32x2* xr = (const u32x2*)(XB + (size_t)tok * D) + F.lane; float a[8] = {0.f, 0.f, 0.f, 0.f, 0.f, 0.f, 0.f, 0.f};
#pragma unroll
            for (int j = 0; j < 8; ++j) { const u32x2 xw = xr[64 * j]; const f32x4 x = {bf_lo(xw.x), bf_hi(xw.x), bf_lo(xw.y), bf_hi(xw.y)}; const int k = 4 * (F.lane + 64 * j);
#pragma unroll
                for (int q = 0; q < 4; ++q) { const f32x4 w0 = *(const LAS f32x4*)(wr + (k + q) * 8), w1 = *(const LAS f32x4*)(wr + (k + q) * 8 + 4);
                    a[0] = fmaf(x[q], w0[0], a[0]); a[1] = fmaf(x[q], w0[1], a[1]); a[2] = fmaf(x[q], w0[2], a[2]); a[3] = fmaf(x[q], w0[3], a[3]);
                    a[4] = fmaf(x[q], w1[0], a[4]); a[5] = fmaf(x[q], w1[1], a[5]); a[6] = fmaf(x[q], w1[2], a[6]); a[7] = fmaf(x[q], w1[3], a[7]); } }
            const float rstd = rstd_of(rsq, tok);
#pragma unroll
            for (int e = 0; e < 8; ++e) a[e] = wave_sum(a[e]) * rstd;
            int e1 = 0; float l1 = a[0];
#pragma unroll
            for (int e = 1; e < 8; ++e) if (a[e] > l1) { l1 = a[e]; e1 = e; }
            int e2 = -1; float l2 = -3.0e38f;
#pragma unroll
            for (int e = 0; e < 8; ++e) if (e != e1 && a[e] > l2) { l2 = a[e]; e2 = e; }
            const float ex = __expf(l2 - l1), w1 = 1.0f / (1.0f + ex), w2 = ex * w1;
            if (F.lane == 0) { te[tl] = e1; te[64 + tl] = e2; tw[tl] = w1; tw[64 + tl] = w2; } }
        __syncthreads();
        if (F.wave == 0) { const int tl = F.lane, tok = chunk * 64 + tl, e1 = te[tl], e2 = te[64 + tl]; const float w1 = tw[tl], w2 = tw[64 + tl];
            const unsigned long long lt = (1ull << tl) - 1ull;
            int myn = 0;
#pragma unroll
            for (int e = 0; e < 8; ++e) { const int n = __popcll(__ballot(e1 == e)) + __popcll(__ballot(e2 == e)); if (tl == e) myn = n; }
            int mybase = 0; if (tl < 8 && myn > 0) mybase = (int)__hip_atomic_fetch_add(F.ctl + CW_ECNT + 64 * tl, (unsigned)myn, RLX_AGENT);
#pragma unroll
            for (int e = 0; e < 8; ++e) { const unsigned long long m1 = __ballot(e1 == e), m2 = __ballot(e2 == e); const int n1 = __popcll(m1);
                const int base = __shfl(mybase, e);
                if (e1 == e) { const int p = base + __popcll(m1 & lt); ltok[e * M + p] = tok; lw[e * M + p] = w1; slot[2 * tok] = (e << 20) | p; }
                if (e2 == e) { const int p = base + n1 + __popcll(m2 & lt); ltok[e * M + p] = tok; lw[e * M + p] = w2; slot[2 * tok + 1] = (e << 20) | p; } } }
    }
}
__device__ __forceinline__ void moe_counts(Frame& F) {
    __syncthreads();
    if (F.tid < 64) {
        int cnt = 0; if (F.tid < NE) cnt = (int)__hip_atomic_load(F.ctl + CW_ECNT + 64 * F.tid, RLX_AGENT);
        const int tiles = (cnt + 255) >> 8; int incl = tiles;
#pragma unroll
        for (int d = 1; d < 8; d <<= 1) { const int t = __shfl_up(incl, d); if (F.tid >= d) incl += t; }
        if (F.tid < NE) { F.misc[8 + F.tid] = (unsigned)cnt; F.misc[16 + F.tid] = (unsigned)(incl - tiles); }
        const int acc = __shfl(incl, NE - 1);
        if (F.tid == 0) { F.misc[24] = (unsigned)acc;
            int per_round = F.G / (D / 256); asm volatile("" : "+v"(per_round));
            const int tm = (acc / per_round) * per_round, tu = (acc - tm) * (D / 256);
            F.misc[25] = (unsigned)tm; F.misc[26] = (tu > 0 && tu * 4 <= F.G) ? 4u : ((tu > 0 && tu * 2 <= F.G) ? 2u : 1u); } }
    __syncthreads();
}
__device__ __forceinline__ void p_final(Frame F) {
    launder(F);
    moe_counts(F);
    const int gw = F.vcu * NWAVES + F.wave, NGW = F.G * NWAVES, lane = F.lane;
    const bf16_t* XB = WSP(bf16_t, WS_XBF); const bf16_t* YS = WSP(bf16_t, WS_YS); const int* slot = WSP(int, WS_SLOT); const float* gf = INP(IN_FINAL);
    const int Tm = (int)F.misc[25], S = (int)F.misc[26]; const bf16_t* YT = BGP(bf16_t, BG_YT);
    for (int m = gw; m < M; m += NGW) {
        const int s0 = slot[2 * m], s1 = slot[2 * m + 1];
        const size_t r0 = (size_t)F.misc[16 + (s0 >> 20)] * 256 + (s0 & 0xfffff), r1 = (size_t)F.misc[16 + (s1 >> 20)] * 256 + (s1 & 0xfffff);
        const u32x2* xr = (const u32x2*)(XB + (size_t)m * D) + lane;
        f32x4 v[8];
#pragma unroll
        for (int j = 0; j < 8; ++j) { const u32x2 a = xr[64 * j]; v[j] = f32x4{bf_lo(a.x), bf_hi(a.x), bf_lo(a.y), bf_hi(a.y)}; }
#pragma unroll
        for (int q = 0; q < 2; ++q) { const size_t r = q ? r1 : r0; const bool tail = (int)(r >> 8) >= Tm;
            const bf16_t* base = tail ? YT + (r - (size_t)Tm * 256) * D : YS + r * D; const int nrep = tail ? S : 1;
            for (int k = 0; k < nrep; ++k) { const u32x2* y = (const u32x2*)(base + (size_t)k * YT_ROWS * D) + lane;
#pragma unroll
                for (int j = 0; j < 8; ++j) { const u32x2 a = y[64 * j]; v[j][0] += bf_lo(a.x); v[j][1] += bf_hi(a.x); v[j][2] += bf_lo(a.y); v[j][3] += bf_hi(a.y); } } }
        float s = 0.f;
#pragma unroll
        for (int j = 0; j < 8; ++j) s += (v[j][0] * v[j][0] + v[j][1] * v[j][1]) + (v[j][2] * v[j][2] + v[j][3] * v[j][3]);
        const float rstd = rsqrtf(wave_sum(s) * (1.0f / D) + NORM_EPS);
        f32x4* o = (f32x4*)(F.out + (size_t)m * D) + lane; const f32x4* gp = (const f32x4*)gf + lane;
#pragma unroll
        for (int j = 0; j < 8; ++j) o[64 * j] = v[j] * rstd * gp[64 * j];
    }
}

#ifndef MK_SPLIT
#define MK_SPLIT 0
#endif
constexpr int NPHASE = 17;
struct Args { const float* in[22]; float* out; unsigned char* ws; int ph_lo, ph_hi, li, pad; };
__global__ void __launch_bounds__(NTHREADS, 2) mega_fwd(Args args) {
    extern __shared__ __attribute__((aligned(16))) unsigned char lds_raw[];
    Frame F0;
    F0.lds = (LAS unsigned char*)lds_raw; F0.misc = (volatile LAS unsigned*)(F0.lds + LDS_MISC);
    F0.tid = threadIdx.x; F0.lane = F0.tid & 63; F0.wave = __builtin_amdgcn_readfirstlane(F0.tid >> 6);
    F0.G = gridDim.x; { const int bx = blockIdx.x; F0.vcu = (F0.G % 8 == 0) ? (bx % 8) * (F0.G / 8) + bx / 8 : bx; }
    F0.in = args.in;
    F0.out = args.out; F0.ws = args.ws; F0.ctl = (unsigned*)(args.ws + WS_CTL);
    if (F0.tid < 64) F0.misc[F0.tid] = 0u;
    __syncthreads();
    XcdBarrier bar = xcd_barrier_post(F0.ctl + CW_BAR + args.li * XCD_BAR_WORDS, F0.misc);
    const int lo = args.ph_lo, hi = args.ph_hi;
#ifndef PHMASK
#define PHMASK 0x1ffff
#endif
#define IN(k) (((PHMASK >> ((k) > 7 && (k) < 13 ? (k) - 7 : (k))) & 1) && lo <= (k) && (k) < hi)
#define SEAM(k) do { if (IN(k) && IN((k) + 1)) { XcdBarrier b2 = bar; asm volatile("" : "+s"(b2.bar)); xcd_barrier(b2); } } while (0)

    if (IN(0)) p_prologue(F0);
    SEAM(0);
    for (int layer = 0; layer < 2; ++layer) {
        const int pb = 1 + 7 * layer;
        if (IN(pb)) { Frame F = F0; launder(F); u64* rsq = WSP(u64, WS_RSQ);
            pg8::SchedDense S{WSP(unsigned char, WS_X8), WSP(unsigned char, WS_WIN + layer * SZ_WIN), D, D, M / 256, 32, F.G, (int)blockIdx.x};
            pg8::EpiIn E{BGP(bf16_t, BG_QKV), BGP(bf16_t, BG_KCB), BGP(bf16_t, BG_VCB), BGP(bf16_t, BG_GM), BGP(bf16_t, BG_NG), rsq + (2 * layer) * M, WSP(float, WS_ROPE), WSP(float, WS_ROPE) + T * 64, 1.0f / WIN8_SCALE, F.lds + LDS_WSCR};
            pg8::gemm_phase<true>(F.lds, D, S, E);
        }
        SEAM(pb);
        if (IN(pb + 1)) p_attn_a(F0, layer);
        SEAM(pb + 1);
        if (IN(pb + 2)) p_attn_b(F0, layer);
        SEAM(pb + 2);
        if (IN(pb + 3)) { Frame F = F0; launder(F);
            pg8::SchedSeg2 S{BGP(unsigned char, BG_OA), WSP(unsigned char, WS_WUP + (2 * layer) * SZ_WUP), BGP(unsigned char, BG_OA) + (size_t)M * 1024, WSP(unsigned char, WS_WUP + (2 * layer + 1) * SZ_WUP), 1024, M / 256, D / 256, F.G, (int)blockIdx.x};
            pg8::EpiMerge E{BGP(bf16_t, BG_GM), BGP(unsigned char, BG_Z), Z8_SCALE / (O8_SCALE * WUP8_SCALE)};
            pg8::gemm_phase<true>(F.lds, 1024, S, E);
        }
        SEAM(pb + 3);
        if (IN(pb + 4)) { Frame F = F0; launder(F); u64* rsq = WSP(u64, WS_RSQ);
            pg8::SchedDense S{BGP(unsigned char, BG_Z), WSP(unsigned char, WS_WO + layer * SZ_WO), D, D, M / 256, D / 256, F.G, (int)blockIdx.x};
            pg8::EpiResid E{layer == 0 ? (const void*)INP(IN_X) : (const void*)WSP(bf16_t, WS_XBF), layer != 0, WSP(bf16_t, WS_XBF), rsq + (2 * layer + 1) * M, layer == 1 ? WSP(unsigned char, WS_X8) : nullptr, 1.0f / (Z8_SCALE * WO8_SCALE)};
            pg8::gemm_phase<true>(F.lds, D, S, E);
        }
        SEAM(pb + 4);
        if (layer == 0) {
            if (IN(pb + 5)) { Frame F = F0; launder(F); u64* rsq = WSP(u64, WS_RSQ);
                pg8::SchedDense S{WSP(bf16_t, WS_XBF), WSP(bf16_t, WS_WGUD), D * 2, D * 2, M / 256, 2 * FF / 256, F.G, (int)blockIdx.x};
                pg8::EpiGateUp<false, true, false> E{BGP(bf16_t, 0), rsq + 1 * M, nullptr, F.misc};
                pg8::gemm_phase<false>(F.lds, D * 2, S, E);
            }
            SEAM(pb + 5);
            if (IN(pb + 6)) { Frame F = F0; launder(F); u64* rsq = WSP(u64, WS_RSQ);
                pg8::SchedDense S{BGP(unsigned char, 0), WSP(unsigned char, WS_WDD), FF, FF, M / 256, D / 256, F.G, (int)blockIdx.x};
                pg8::EpiResid E{WSP(bf16_t, WS_XBF), 1, WSP(bf16_t, WS_XBF), rsq + 2 * M, WSP(unsigned char, WS_X8), 1.0f / WD8_SCALE};
                pg8::gemm_phase<true>(F.lds, FF, S, E);
            }
            SEAM(pb + 6);
        } else {
            if (IN(pb + 5)) p_router(F0);
            SEAM(pb + 5);
            if (IN(pb + 6)) { Frame F = F0; launder(F); u64* rsq = WSP(u64, WS_RSQ);
                moe_counts(F);
                pg8::SchedMoE<true> S{WSP(unsigned char, WS_X8), WSP(unsigned char, WS_WGUM), WSP(int, WS_LTOK), D, D, 2 * FF / 256, F.G, (int)blockIdx.x, SZ_WGU8, F.misc, 24};
                pg8::EpiGateUp<true> E{BGP(bf16_t, 0), rsq + 3 * M, WSP(int, WS_LTOK), F.misc};
                pg8::gemm_phase<true>(F.lds, D, S, E);
            }
            SEAM(pb + 6);
            if (IN(pb + 7)) { Frame F = F0; launder(F);
                moe_counts(F);
                pg8::SchedMoE<false> S{BGP(unsigned char, 0), WSP(unsigned char, WS_WDM), nullptr, FF, FF, D / 256, F.G, (int)blockIdx.x, SZ_WD8, F.misc, 25};
                pg8::EpiMoeDown E{WSP(bf16_t, WS_YS), WSP(float, WS_LW), F.misc};
                pg8::gemm_phase<true>(F.lds, FF, S, E);
                { const int kpart = FF / (int)F.misc[26];
                  pg8::SchedMoETail St{BGP(unsigned char, 0), WSP(unsigned char, WS_WDM), FF, FF, D / 256, (int)blockIdx.x, kpart, SZ_WD8, F.misc};
                  pg8::EpiMoeDownTail Et{BGP(bf16_t, BG_YT), WSP(float, WS_LW), F.misc};
                  pg8::gemm_phase<true>(F.lds, kpart, St, Et); }
            }
            SEAM(pb + 7);
        }
    }
    if (IN(16)) p_final(F0);
#undef IN
#undef SEAM
}

extern "C" void kernel_launch(void* const* d_in, const int* in_sizes, int n_in, void* d_out, int out_size, void* d_ws, size_t ws_size, hipStream_t stream) {
    static int grid = 0;
    if (grid == 0) {
        if (n_in != 22 || in_sizes[0] != M * D || out_size != M * D || ws_size < WS_END) { fprintf(stderr, "kernel_launch: unexpected shapes (n_in %d, in0 %d, out %d, ws %zu < %zu); nothing launched\n", n_in, n_in > 0 ? in_sizes[0] : -1, out_size, ws_size, (size_t)WS_END); grid = -1; return; }
        int dev = 0, cus = 0, per_cu = 0;
        if (hipGetDevice(&dev) != hipSuccess || hipDeviceGetAttribute(&cus, hipDeviceAttributeMultiprocessorCount, dev) != hipSuccess) { grid = -1; return; }
        if (hipFuncSetAttribute((const void*)mega_fwd, hipFuncAttributeMaxDynamicSharedMemorySize, LDS_BYTES) != hipSuccess) { fprintf(stderr, "kernel_launch: hipFuncSetAttribute failed\n"); grid = -1; return; }
        if (hipOccupancyMaxActiveBlocksPerMultiprocessor(&per_cu, (const void*)mega_fwd, NTHREADS, LDS_BYTES) != hipSuccess || per_cu < 1) fprintf(stderr, "kernel_launch: occupancy query reports %d\n", per_cu);
        (void)hipGetLastError();
        grid = cus;
    }
    if (grid < 0) return;
    (void)hipMemsetAsync((char*)d_ws + WS_CTL, 0, CTL_ZERO_BYTES, stream);
    Args a{};
    for (int i = 0; i < 22; ++i) a.in[i] = (const float*)d_in[i];
    a.out = (float*)d_out; a.ws = (unsigned char*)d_ws; a.pad = 0;
#if MK_SPLIT
    for (int p = 0; p < NPHASE; ++p) { a.ph_lo = p; a.ph_hi = p + 1; a.li = p; hipLaunchKernelGGL(mega_fwd, dim3(grid), dim3(NTHREADS), LDS_BYTES, stream, a); }
#else
    a.ph_lo = 0; a.ph_hi = NPHASE; a.li = 0;
    hipLaunchKernelGGL(mega_fwd, dim3(grid), dim3(NTHREADS), LDS_BYTES, stream, a);
#endif
}
```

```cpp
#include <hip/hip_runtime.h>
#include <cstdio>
#include <cstdint>

#define LAS __attribute__((address_space(3)))
#define GAS __attribute__((address_space(1)))
typedef unsigned short bf16_t;
typedef short bf16x8 __attribute__((ext_vector_type(8)));
typedef short s16x4 __attribute__((ext_vector_type(4)));
typedef float f32x4 __attribute__((ext_vector_type(4)));
typedef float f32x2 __attribute__((ext_vector_type(2)));
typedef float f32x16 __attribute__((ext_vector_type(16)));
typedef unsigned u32x4 __attribute__((ext_vector_type(4)));
typedef unsigned u32x2 __attribute__((ext_vector_type(2)));

constexpr int NB = 4, T = 4096, D = 2048, M = NB * T, HD = 128, FF = 7168, NE = 8;
constexpr int IN_DIM = 8216, NIN = 8448;
constexpr int NCMP = 255, CMPH = 256;
constexpr float NORM_EPS = 1e-6f;
constexpr int MAXSLOT = 34816;
constexpr int YT_ROWS = 31 * 256;

constexpr size_t MiB = 1u << 20;
constexpr size_t WS_CTL = 0, CTL_ZERO_BYTES = 2 * MiB;
constexpr int CW_TMO = 0, CW_QUEUE = 1024, CW_ECNT = 2048, CW_BAR = 4096;
constexpr size_t WS_RSQ = 1 * MiB;
constexpr size_t WS_ROPE = 2 * MiB;
constexpr size_t WS_MISC = 4 * MiB;
constexpr size_t WS_CBIAS = 512 * 1024;
constexpr float CB_SCALE = 1099511627776.0f;
constexpr size_t WS_LTOK = WS_MISC + 64 * 1024;
constexpr size_t WS_LW = WS_LTOK + (size_t)NE * M * 4;
constexpr size_t WS_SLOT = WS_LW + (size_t)NE * M * 4;
constexpr size_t WS_W = 6 * MiB;
constexpr size_t SZ_WIN = (size_t)NIN * D * 2, SZ_W1 = (size_t)CMPH * 4096 * 2, SZ_W2 = (size_t)256 * 256 * 2, SZ_WUP = (size_t)D * 1024 * 2, SZ_WO = (size_t)D * D * 2;
constexpr size_t SZ_WGU = (size_t)2 * FF * D * 2, SZ_WD = (size_t)D * FF * 2;
constexpr size_t SZ_WGU8 = (size_t)2 * FF * D, SZ_WD8 = (size_t)D * FF;
constexpr float WGU8_SCALE = 32.0f, WD8_SCALE = 64.0f, WIN8_SCALE = 32.0f, WUP8_SCALE = 32.0f, WO8_SCALE = 32.0f, O8_SCALE = 16.0f, Z8_SCALE = 16.0f;
constexpr size_t WS_WIN = WS_W;
constexpr size_t WS_W1 = WS_WIN + 2 * SZ_WIN;
constexpr size_t WS_W2 = WS_W1 + 4 * SZ_W1;
constexpr size_t WS_WUP = WS_W2 + 4 * SZ_W2;
constexpr size_t WS_WO = WS_WUP + 4 * SZ_WUP;
constexpr size_t WS_WGUD = WS_WO + 2 * SZ_WO;
constexpr size_t WS_WDD = WS_WGUD + SZ_WGU;
constexpr size_t WS_WGUM = WS_WDD + SZ_WD;
constexpr size_t WS_WDM = WS_WGUM + 8 * SZ_WGU8;
constexpr size_t WS_X8 = WS_WDM + 8 * SZ_WD8;
constexpr size_t WS_XR = WS_X8 + (size_t)M * D;
constexpr size_t WS_XBF = WS_XR + (size_t)M * D * 4;
constexpr size_t WS_YS = WS_XBF + (size_t)M * D * 2;
constexpr size_t WS_BIG = WS_YS + (size_t)MAXSLOT * D * 2;
constexpr size_t SZ_BIG = (size_t)MAXSLOT * FF * 2;
constexpr size_t WS_END = WS_BIG + SZ_BIG;
constexpr size_t BG_QKV = 0;
constexpr size_t BG_GM = BG_QKV + (size_t)M * 4096 * 2;
constexpr size_t BG_NG = BG_GM + (size_t)M * 4096 * 2;
constexpr size_t BG_KCB = BG_NG + (size_t)M * 32 * 2;
constexpr size_t BG_VCB = BG_KCB + (size_t)M * 256 * 2 + 65536;
constexpr size_t BG_HC = BG_VCB + (size_t)M * 256 * 2 + 65536;
constexpr size_t BG_KCMP = BG_HC + (size_t)2 * 2048 * 256 * 2;
constexpr size_t BG_VCMP = BG_KCMP + (size_t)8 * 256 * 128 * 2;
constexpr size_t BG_OA = BG_VCMP + (size_t)8 * 256 * 128 * 2;
constexpr size_t BG_OB = BG_OA + (size_t)M * 1024 * 2;
constexpr size_t BG_Z = BG_OB + (size_t)M * 1024 * 2;
constexpr size_t BG_END = BG_Z + (size_t)M * D * 2;
static_assert(BG_END <= SZ_BIG, "attention-phase tensors fit the aliased region");
constexpr size_t BG_YT = 256 * MiB;
static_assert((size_t)MAXSLOT * FF <= BG_YT && BG_YT + (size_t)4 * YT_ROWS * D * 2 <= SZ_BIG, "tail partials fit");
static_assert(WS_SLOT + (size_t)M * 8 <= WS_W, "misc region");

constexpr int LDS_K = 0, LDS_V = 65536, LDS_WSCR = 131072  , LDS_IMP = LDS_WSCR + 2048  , LDS_SELM = LDS_IMP + 64 * 65 * 4  ;
constexpr int LDS_MISC = LDS_SELM + 512;
constexpr int LDS_BYTES = LDS_MISC + 256;
static_assert(LDS_BYTES <= 163840, "LDS");
static_assert(LDS_WSCR + 32 * 528 <= LDS_MISC, "epilogue slab fits beside the GEMM buffers");
constexpr int NWAVES = 8, NTHREADS = 512;

#define RLX_AGENT __ATOMIC_RELAXED, __HIP_MEMORY_SCOPE_AGENT
#define LDS_WAIT() asm volatile("s_waitcnt lgkmcnt(0)" ::: "memory")
#define VM_WAIT() asm volatile("s_waitcnt vmcnt(0)" ::: "memory")

typedef __bf16 bf16x2_t __attribute__((ext_vector_type(2)));
__device__ __forceinline__ unsigned cvt_pk_bf16(float lo, float hi) { f32x2 v = {lo, hi}; bf16x2_t b = __builtin_convertvector(v, bf16x2_t); return __builtin_bit_cast(unsigned, b); }
__device__ __forceinline__ float bf_lo(unsigned w) { return __uint_as_float(w << 16); }
__device__ __forceinline__ float bf_hi(unsigned w) { return __uint_as_float(w & 0xffff0000u); }
__device__ __forceinline__ float bf2f(bf16_t b) { return __uint_as_float(((unsigned)b) << 16); }
__device__ __forceinline__ float fast_sigmoid(float x) { return __builtin_amdgcn_rcpf(1.0f + __builtin_amdgcn_exp2f(-1.4426950408889634f * x)); }
__device__ __forceinline__ f32x4 sigmoid4_scaled(const f32x4& x, float c1) { const f32x4 t = x * c1; f32x4 e, sg;
#pragma unroll
    for (int j = 0; j < 4; ++j) e[j] = __builtin_amdgcn_exp2f(t[j]);
    const f32x4 d = e + 1.0f;
#pragma unroll
    for (int j = 0; j < 4; ++j) sg[j] = __builtin_amdgcn_rcpf(d[j]);
    return sg; }
__device__ __forceinline__ int opaque_tid() { int t; asm volatile("v_mov_b32 %0, %1" : "=v"(t) : "v"((int)threadIdx.x)); return t; }
typedef unsigned long long u64;
typedef int v8i __attribute__((ext_vector_type(8)));
typedef int v4i __attribute__((ext_vector_type(4)));
__device__ __forceinline__ unsigned cvt4_fp8(float a, float b, float c, float d) { unsigned w = 0u; w = __builtin_amdgcn_cvt_pk_fp8_f32(a, b, w, false); w = __builtin_amdgcn_cvt_pk_fp8_f32(c, d, w, true); return w; }
constexpr float RSQ_SCALE = 1048576.0f;
__device__ __forceinline__ float rstd_of(const u64* rsq, int row) { return rsqrtf((float)rsq[row] * (1.0f / (RSQ_SCALE * D)) + NORM_EPS); }
__device__ __forceinline__ float wave_sum(float v) {
#pragma unroll
    for (int o = 1; o < 64; o <<= 1) v += __shfl_xor(v, o);
    return v;
}

#define XB_TMO      128
#define XB_XCNT(j)  (256  + 64 * (j))
#define XB_XSUB(j)  (1280 + 64 * (j))
#define XB_XGEN(j)  (2304 + 64 * (j))
#define XB_TOP      3328
#define XB_TOPGEN   3392
#define XCD_BAR_WORDS 3456
#define XB_SPIN_CAP (1u << 18)
__device__ __forceinline__ unsigned xb_ld(unsigned* p)              { return __hip_atomic_load(p, __ATOMIC_RELAXED, __HIP_MEMORY_SCOPE_AGENT); }
__device__ __forceinline__ unsigned xb_add(unsigned* p, unsigned v) { return __hip_atomic_fetch_add(p, v, __ATOMIC_RELAXED, __HIP_MEMORY_SCOPE_AGENT); }
__device__ __forceinline__ unsigned xb_xcc_id() { return (unsigned)__builtin_amdgcn_s_getreg((3 << 11) | 20) & 0xFu; }
#define XB_SPIN(cond, bar) do { unsigned _sp = 0; while (cond) { __builtin_amdgcn_s_sleep(1); \
    if ((++_sp & 255u) == 0u) { if (xb_ld(&(bar)[XB_TMO])) break; if (_sp > XB_SPIN_CAP) { atomicAdd(&(bar)[XB_TMO], 1u); break; } } } } while (0)
struct XcdBarrier { unsigned* bar; unsigned x; volatile LAS unsigned* st; };
__device__ __forceinline__ XcdBarrier xcd_barrier_post(unsigned* bar, volatile LAS unsigned* st) {
    XcdBarrier b; b.bar = bar; b.x = xb_xcc_id(); b.st = st;
    if (threadIdx.x == 0) (void)xb_add(&bar[XB_XCNT(b.x)], 1u);
    return b;
}
__device__ __forceinline__ void xcd_barrier_complete(unsigned* bar, unsigned x, unsigned& nloc, unsigned& nx) {
    const unsigned G = gridDim.x * gridDim.y * gridDim.z;
    unsigned sum, cnt, mine, sp = 0u;
    for (;;) {
        sum = 0u; cnt = 0u; mine = 0u;
#pragma unroll
        for (unsigned j = 0; j < 16; ++j) { const unsigned c = xb_ld(&bar[XB_XCNT(j)]); sum += c; cnt += (c > 0u) ? 1u : 0u; mine = (j == x) ? c : mine; }
        if (sum == G) break;
        __builtin_amdgcn_s_sleep(1);
        if ((++sp & 255u) == 0u) { if (xb_ld(&bar[XB_TMO])) break; if (sp > XB_SPIN_CAP) { atomicAdd(&bar[XB_TMO], 1u); break; } }
    }
    nloc = mine > 0u ? mine : 1u; nx = cnt > 0u ? cnt : 1u;
}
__device__ __forceinline__ void xcd_barrier(const XcdBarrier& b) {
    asm volatile("s_waitcnt vmcnt(0)" ::: "memory");
    __syncthreads();
    if (threadIdx.x == 0) {
        unsigned* bar = b.bar;
        __builtin_amdgcn_s_waitcnt(0);
        unsigned nloc = b.st[0], nx = b.st[1];
        if (nloc == 0u) { xcd_barrier_complete(bar, b.x, nloc, nx); b.st[0] = nloc; b.st[1] = nx; }
        const unsigned old = xb_add(&bar[XB_XSUB(b.x)], 1u);
        const unsigned gen = old / nloc;
        if (old + 1u == (gen + 1u) * nloc) {
            __builtin_amdgcn_fence(__ATOMIC_RELEASE, "agent");
            asm volatile("s_waitcnt vmcnt(0)" ::: "memory");
            const unsigned og = xb_add(&bar[XB_TOP], 1u);
            const unsigned tg = og / nx;
            if (og + 1u == (tg + 1u) * nx) xb_add(&bar[XB_TOPGEN], 1u);
            else XB_SPIN(xb_ld(&bar[XB_TOPGEN]) == tg, bar);
            __builtin_amdgcn_fence(__ATOMIC_ACQUIRE, "agent");
            xb_add(&bar[XB_XGEN(b.x)], 1u);
            asm volatile("s_waitcnt vmcnt(0)" ::: "memory");
        } else {
            XB_SPIN(xb_ld(&bar[XB_XGEN(b.x)]) == gen, bar);
            __builtin_amdgcn_fence(__ATOMIC_ACQUIRE, "agent");
            asm volatile("s_waitcnt vmcnt(0)" ::: "memory");
        }
    }
    __syncthreads();
}

namespace pg8 {
constexpr int BM = 256, BK = 64, HALF = 128, HTB = HALF * BK * 2, STAGE_BYTES = 8 * HTB, NXCD = 8, WGM = 4;
__host__ __device__ __forceinline__ int lds_byte(int r, int c) { const int st = (r >> 4) * 2 + (c >> 5), rr = r & 15, cc = c & 31, ob = rr * 64 + cc * 2; return st * 1024 + (ob ^ (((ob >> 9) & 1) << 5)); }
__host__ __device__ __forceinline__ void stage_rc(int b, int& R, int& C) { const int st = b / 1024, sb = b % 1024, swz = sb ^ (((sb >> 9) & 1) << 5); R = (st >> 1) * 16 + swz / 64; C = (st & 1) * 32 + (swz % 64) / 2; }
__host__ __device__ __forceinline__ int perm32(int rho) { const int n = rho >> 4, i = rho & 15; return 8 * (i >> 2) + 4 * n + (i & 3); }

struct Unit { int pm, pn, aux; };
typedef f32x4 Acc[2][2][4][2];

__device__ __forceinline__ bool static_tile(int L, int nM, int nN, int& pm, int& pn) {
    const int nwg = nM * nN; if (L >= nwg) return false;
    int wgid = L; { const int q = nwg / NXCD, r = nwg % NXCD, xcd = wgid % NXCD, off = wgid / NXCD; wgid = (xcd < r ? xcd * (q + 1) : r * (q + 1) + (xcd - r) * q) + off; }
    const int nig = WGM * nN, gid = wgid / nig, fm = gid * WGM, gsz = (nM - fm) < WGM ? (nM - fm) : WGM;
    pm = fm + ((wgid % nig) % gsz); pn = (wgid % nig) / gsz; return true;
}

__device__ __forceinline__ void glds_s(const void* sbase, unsigned voff, unsigned lds_dst) { unsigned keep;
    asm volatile("s_mov_b32 %0, m0\n\ts_mov_b32 m0, %3\n\ts_nop 0\n\tglobal_load_lds_dwordx4 %1, %2\n\ts_mov_b32 m0, %0" : "=&s"(keep) : "v"(voff), "s"(sbase), "s"(lds_dst) : "memory"); }
__device__ __forceinline__ const char* uni_ptr(const char* p) { const unsigned long long v = (unsigned long long)p; const unsigned lo = __builtin_amdgcn_readfirstlane((unsigned)v), hi = __builtin_amdgcn_readfirstlane((unsigned)(v >> 32));
    return (const char*)(GAS const char*)(((unsigned long long)hi << 32) | lo); }
template <bool FP8, class Epi, class Sched>
__device__ __forceinline__ void gemm_phase(LAS unsigned char* lds, const int Kb, const Sched& S, const Epi& E) {
    const int tid = opaque_tid(), wid = __builtin_amdgcn_readfirstlane(tid >> 6), lane = tid & 63, wr = wid >> 2, wc = wid & 3, fr = lane & 15, fq = lane >> 4;
    const int nt = Kb / 128;
    int Rr[2], Cc[2]; unsigned voffB[2];
#pragma unroll
    for (int i = 0; i < 2; ++i) { stage_rc(tid * 16 + i * 8192, Rr[i], Cc[i]); const int Rb = Epi::PERM ? ((Rr[i] & ~31) + perm32(Rr[i] & 31)) : Rr[i];
        voffB[i] = (unsigned)(Rb * S.ldb() + Cc[i] * 2); }
    const size_t kstep = (size_t)(BK * 2);
    const size_t hstepB = (size_t)HALF * S.ldb();
    const unsigned ldsw = (unsigned)wid * 1024u;
    const unsigned ldsb = (unsigned)__builtin_amdgcn_readfirstlane((int)((unsigned)(uintptr_t)lds + ldsw));
    const int aoff = lds_byte(wr * 64 + fr, fq * 8), boff = lds_byte(wc * 32 + fr, fq * 8);
#define PG8_SA(b, h) (((b) * 2 + (h)) * HTB)
#define PG8_SB(b, h) ((4 + (b) * 2 + (h)) * HTB)
#define PG8_STAGE(bufoff, gbase, voff) do { const void* sb_ = (const void*)(gbase); _Pragma("unroll") for (int _i = 0; _i < 2; ++_i) \
        glds_s(sb_, (voff)[_i], ldsb + (unsigned)((bufoff) + _i * 8192)); } while (0)
#define PG8_LD8(p_) __builtin_shufflevector(*(const LAS v4i*)(p_), *(const LAS v4i*)((p_) + 1024), 0, 1, 2, 3, 4, 5, 6, 7)
#define PG8_LDA(dst, b, h) do { _Pragma("unroll") for (int m = 0; m < 4; ++m) dst[m] = PG8_LD8(lds + PG8_SA(b, h) + aoff + m * 2048); } while (0)
#define PG8_LDB(dst, b, h) do { _Pragma("unroll") for (int n = 0; n < 2; ++n) dst[n] = PG8_LD8(lds + PG8_SB(b, h) + boff + n * 2048); } while (0)
#define PG8_H(v_, k_) __builtin_bit_cast(bf16x8, __builtin_shufflevector(v_, v_, 4 * (k_), 4 * (k_) + 1, 4 * (k_) + 2, 4 * (k_) + 3))
#define PG8_MMA(ai, bj, At, Bt) do { __builtin_amdgcn_s_setprio(1); _Pragma("unroll") for (int m = 0; m < 4; ++m) _Pragma("unroll") for (int n = 0; n < 2; ++n) { \
        if constexpr (FP8) asm volatile("v_mfma_f32_16x16x128_f8f6f4 %0, %1, %2, %0" : "+v"(acc[ai][bj][m][n]) : "v"(Bt[n]), "v"(At[m]));   \
        else { acc[ai][bj][m][n] = __builtin_amdgcn_mfma_f32_16x16x32_bf16(PG8_H(Bt[n], 0), PG8_H(At[m], 0), acc[ai][bj][m][n], 0, 0, 0); \
               acc[ai][bj][m][n] = __builtin_amdgcn_mfma_f32_16x16x32_bf16(PG8_H(Bt[n], 1), PG8_H(At[m], 1), acc[ai][bj][m][n], 0, 0, 0); } } \
        __builtin_amdgcn_s_setprio(0); } while (0)
#define PG8_WAIT_V(n) asm volatile("s_waitcnt vmcnt(" #n ")" ::: "memory")
#define PG8_WAIT_L(n) asm volatile("s_waitcnt lgkmcnt(" #n ")" ::: "memory")
#define PG8_BAR __builtin_amdgcn_s_barrier()
#define PG8_SCHED __builtin_amdgcn_sched_barrier(0)
    Unit cur, nxt; int ui = 0;
    if (!S.next(0, cur)) return;
    Acc acc;
#pragma unroll
    for (int a = 0; a < 2; ++a)
#pragma unroll
        for (int b = 0; b < 2; ++b)
#pragma unroll
            for (int m = 0; m < 4; ++m)
#pragma unroll
                for (int n = 0; n < 2; ++n) acc[a][b][m][n] = (f32x4){0.f, 0.f, 0.f, 0.f};
    v8i At[4], B0[2], B1[2]; const int one8 = 0x7F7F7F7F;
    unsigned vA[2][2], vAn[2][2];
    S.a_off(cur, Rr, Cc, vA);
    const char* cA = uni_ptr(S.a_base(cur)); const char* cB = uni_ptr(S.b_base(cur));
    PG8_STAGE(PG8_SB(0, 0), cB, voffB); PG8_STAGE(PG8_SB(0, 1), cB + hstepB, voffB); PG8_STAGE(PG8_SA(0, 0), cA, vA[0]); PG8_STAGE(PG8_SA(0, 1), cA, vA[1]);
    if (wr == 1) PG8_BAR;
    PG8_WAIT_V(2); PG8_BAR;
    PG8_STAGE(PG8_SB(1, 0), cB + kstep, voffB); PG8_STAGE(PG8_SA(1, 0), cA + kstep, vA[0]); PG8_STAGE(PG8_SB(1, 1), cB + hstepB + kstep, voffB);
    PG8_WAIT_V(6); PG8_BAR;
    for (;;) {
        const bool has_next = S.next(ui + 1, nxt);
        const char* nA = cA; const char* nB = cB;
#pragma unroll
        for (int h = 0; h < 2; ++h)
#pragma unroll
            for (int i = 0; i < 2; ++i) vAn[h][i] = vA[h][i];
        if (has_next) { nA = uni_ptr(S.a_base(nxt)); nB = uni_ptr(S.b_base(nxt)); if (Sched::VARIES) S.a_off(nxt, Rr, Cc, vAn); }
        for (int t = 0; t < nt; t += 2) {
            const bool last = (t == nt - 2);
            const char* a1 = cA + (size_t)(t + 1) * kstep;
            const char* a2 = last ? nA : cA + (size_t)(t + 2) * kstep; const char* b2 = last ? nB : cB + (size_t)(t + 2) * kstep;
            const char* a3 = a2 + kstep; const char* b3 = b2 + kstep;
            unsigned v2[2][2];
#pragma unroll
            for (int h = 0; h < 2; ++h)
#pragma unroll
                for (int i = 0; i < 2; ++i) v2[h][i] = (Sched::VARIES && last) ? vAn[h][i] : vA[h][i];
            PG8_LDB(B0, 0, 0); PG8_LDB(B1, 0, 1); PG8_SCHED; PG8_LDA(At, 0, 0); PG8_STAGE(PG8_SA(1, 1), a1, vA[1]);
            if (!(FP8 && t == 0 && ui > 0)) PG8_WAIT_V(8);
            PG8_WAIT_L(0); PG8_BAR; PG8_MMA(0, 0, At, B0); PG8_MMA(0, 1, At, B1); PG8_BAR; PG8_SCHED;
            PG8_LDA(At, 0, 1); PG8_STAGE(PG8_SB(0, 0), b2, voffB); PG8_STAGE(PG8_SB(0, 1), b2 + hstepB, voffB); PG8_STAGE(PG8_SA(0, 0), a2, v2[0]);
            PG8_WAIT_V(8); PG8_WAIT_L(0); PG8_BAR; PG8_MMA(1, 0, At, B0); PG8_MMA(1, 1, At, B1); PG8_BAR; PG8_SCHED;
            PG8_LDB(B0, 1, 0); PG8_LDB(B1, 1, 1); PG8_SCHED; PG8_LDA(At, 1, 0); PG8_STAGE(PG8_SA(0, 1), a2, v2[1]);
            PG8_WAIT_V(8); PG8_WAIT_L(0); PG8_BAR; PG8_MMA(0, 0, At, B0); PG8_MMA(0, 1, At, B1); PG8_BAR; PG8_SCHED;
            PG8_LDA(At, 1, 1); PG8_STAGE(PG8_SB(1, 0), b3, voffB); PG8_STAGE(PG8_SB(1, 1), b3 + hstepB, voffB); PG8_STAGE(PG8_SA(1, 0), a3, v2[0]);
            PG8_WAIT_V(8); PG8_WAIT_L(0); PG8_BAR; PG8_MMA(1, 0, At, B0); PG8_MMA(1, 1, At, B1); PG8_BAR; PG8_SCHED;
        }
        PG8_WAIT_V(6);
        if (wr == 0) PG8_BAR;
        if constexpr (FP8) asm volatile("s_nop 15\n\ts_nop 15" ::: "memory");
        E(acc, cur, wr, wc, fr, fq);
        if (!has_next) break;
        if (!E.keep(cur)) {
#pragma unroll
            for (int a = 0; a < 2; ++a)
#pragma unroll
                for (int b = 0; b < 2; ++b)
#pragma unroll
                    for (int m = 0; m < 4; ++m)
#pragma unroll
                        for (int n = 0; n < 2; ++n) acc[a][b][m][n] = (f32x4){0.f, 0.f, 0.f, 0.f};
        }
        cur = nxt; cA = nA; cB = nB; ++ui;
#pragma unroll
        for (int h = 0; h < 2; ++h)
#pragma unroll
            for (int i = 0; i < 2; ++i) vA[h][i] = vAn[h][i];
        if (wr == 1) PG8_BAR;
    }
    PG8_WAIT_V(0);
    PG8_BAR;
#undef PG8_SA
#undef PG8_SB
#undef PG8_STAGE
#undef PG8_LDA
#undef PG8_LDB
#undef PG8_MMA
#undef PG8_WAIT_V
#undef PG8_WAIT_L
#undef PG8_BAR
#undef PG8_SCHED
}

struct SchedDense {
    static constexpr bool VARIES = false;
    const void* A; const void* Bt; int lda, ldb_, nM, nN, G, c;
    __device__ __forceinline__ int ldb() const { return ldb_; }
    __device__ __forceinline__ bool next(int i, Unit& u) const { u.aux = 0; return static_tile(i * G + c, nM, nN, u.pm, u.pn); }
    __device__ __forceinline__ const char* a_base(const Unit& u) const { return (const char*)A + (size_t)u.pm * BM * lda; }
    __device__ __forceinline__ const char* b_base(const Unit& u) const { return (const char*)Bt + (size_t)u.pn * BM * ldb_; }
    __device__ __forceinline__ void a_off(const Unit&, const int (&R)[2], const int (&C)[2], unsigned (&vo)[2][2]) const {
#pragma unroll
        for (int h = 0; h < 2; ++h)
#pragma unroll
            for (int i = 0; i < 2; ++i) vo[h][i] = (unsigned)((h * HALF + R[i]) * lda + C[i] * 2); }
};
struct SchedOne {
    static constexpr bool VARIES = false;
    const void* A; const void* Bt; int lda, ldb_, pm, pn;
    __device__ __forceinline__ int ldb() const { return ldb_; }
    __device__ __forceinline__ bool next(int i, Unit& u) const { u.aux = 0; u.pm = pm; u.pn = pn; return i == 0; }
    __device__ __forceinline__ const char* a_base(const Unit& u) const { return (const char*)A + (size_t)u.pm * BM * lda; }
    __device__ __forceinline__ const char* b_base(const Unit& u) const { return (const char*)Bt + (size_t)u.pn * BM * ldb_; }
    __device__ __forceinline__ void a_off(const Unit&, const int (&R)[2], const int (&C)[2], unsigned (&vo)[2][2]) const {
#pragma unroll
        for (int h = 0; h < 2; ++h)
#pragma unroll
            for (int i = 0; i < 2; ++i) vo[h][i] = (unsigned)((h * HALF + R[i]) * lda + C[i] * 2); }
};
struct SchedSeg2 {
    static constexpr bool VARIES = false;
    const void* A0; const void* B0; const void* A1; const void* B1; int ld, nM, nN, G, c;
    __device__ __forceinline__ int ldb() const { return ld; }
    __device__ __forceinline__ bool next(int i, Unit& u) const { u.aux = i & 1; return static_tile((i >> 1) * G + c, nM, nN, u.pm, u.pn); }
    __device__ __forceinline__ const char* a_base(const Unit& u) const { return (const char*)(u.aux ? A1 : A0) + (size_t)u.pm * BM * ld; }
    __device__ __forceinline__ const char* b_base(const Unit& u) const { return (const char*)(u.aux ? B1 : B0) + (size_t)u.pn * BM * ld; }
    __device__ __forceinline__ void a_off(const Unit&, const int (&R)[2], const int (&C)[2], unsigned (&vo)[2][2]) const {
#pragma unroll
        for (int h = 0; h < 2; ++h)
#pragma unroll
            for (int i = 0; i < 2; ++i) vo[h][i] = (unsigned)((h * HALF + R[i]) * ld + C[i] * 2); }
};
template <bool GATHER> struct SchedMoE {
    static constexpr bool VARIES = GATHER;
    const void* A; const void* Bt; const int* ltok; int lda, ldb_, nN, G, c; size_t bstride; const volatile LAS unsigned* misc; int nm_word;
    __device__ __forceinline__ int ldb() const { return ldb_; }
    __device__ __forceinline__ bool next(int i, Unit& u) const {
        const int nM = (int)misc[nm_word]; if (!static_tile(i * G + c, nM, nN, u.pm, u.pn)) return false;
        int e = 0;
#pragma unroll
        for (int j = 1; j < NE; ++j) e += ((int)misc[16 + j] <= u.pm) ? 1 : 0;
        u.aux = e; return true; }
    __device__ __forceinline__ const char* a_base(const Unit& u) const { return GATHER ? (const char*)A : (const char*)A + (size_t)u.pm * BM * lda; }
    __device__ __forceinline__ const char* b_base(const Unit& u) const { return (const char*)Bt + (size_t)u.aux * bstride + (size_t)u.pn * BM * ldb_; }
    __device__ __forceinline__ void a_off(const Unit& u, const int (&R)[2], const int (&C)[2], unsigned (&vo)[2][2]) const {
        if (GATHER) {
            const int cnt = (int)misc[8 + u.aux], r0 = (u.pm - (int)misc[16 + u.aux]) * BM;
#pragma unroll
            for (int h = 0; h < 2; ++h)
#pragma unroll
                for (int i = 0; i < 2; ++i) { const int r = r0 + h * HALF + R[i]; const int tok = r < cnt ? ltok[u.aux * M + r] : 0; vo[h][i] = (unsigned)(tok * lda + C[i] * 2); }
        } else {
#pragma unroll
            for (int h = 0; h < 2; ++h)
#pragma unroll
                for (int i = 0; i < 2; ++i) vo[h][i] = (unsigned)((h * HALF + R[i]) * lda + C[i] * 2);
        } }
};

struct SchedMoETail {
    static constexpr bool VARIES = false;
    const void* A; const void* Bt; int lda, ldb_, nN, c, kpart; size_t bstride; const volatile LAS unsigned* misc;
    __device__ __forceinline__ int ldb() const { return ldb_; }
    __device__ __forceinline__ bool next(int i, Unit& u) const {
        const int S = (int)misc[26], Tm = (int)misc[25], nt = ((int)misc[24] - Tm) * nN;
        if (i != 0 || c >= nt * S) return false;
        const int j = c / S, part = c - j * S; u.pm = Tm + j / nN; u.pn = j % nN;
        int e = 0;
#pragma unroll
        for (int q = 1; q < NE; ++q) e += ((int)misc[16 + q] <= u.pm) ? 1 : 0;
        u.aux = e | (part << 8); return true; }
    __device__ __forceinline__ const char* a_base(const Unit& u) const { return (const char*)A + (size_t)u.pm * BM * lda + (size_t)(u.aux >> 8) * kpart; }
    __device__ __forceinline__ const char* b_base(const Unit& u) const { return (const char*)Bt + (size_t)(u.aux & 255) * bstride + (size_t)u.pn * BM * ldb_ + (size_t)(u.aux >> 8) * kpart; }
    __device__ __forceinline__ void a_off(const Unit&, const int (&R)[2], const int (&C)[2], unsigned (&vo)[2][2]) const {
#pragma unroll
        for (int h = 0; h < 2; ++h)
#pragma unroll
            for (int i = 0; i < 2; ++i) vo[h][i] = (unsigned)((h * HALF + R[i]) * lda + C[i] * 2); }
};

struct EpiIn {
    static constexpr bool PERM = true;
    bf16_t* QKV; bf16_t* KCb; bf16_t* VCb; bf16_t* GMb; bf16_t* NGb; const u64* rsq; const float* cosT; const float* sinT; float wscale;
    LAS unsigned char* slab;
    __device__ __forceinline__ bool keep(const Unit&) const { return false; }
    __device__ __forceinline__ void operator()(const Acc& acc, const Unit& u, int wr, int wc, int fr, int fq) const {
        const int pn = u.pn, row0 = u.pm * BM + wr * 64 + fr;
        u64 rq[2][4];
#pragma unroll
        for (int ai = 0; ai < 2; ++ai)
#pragma unroll
            for (int m = 0; m < 4; ++m) rq[ai][m] = rsq[row0 + ai * HALF + m * 16];
        const float sc = (1.0f / (RSQ_SCALE * D));
        if (pn < 32) {
            const int wid = wr * 4 + wc, lane = fq * 16 + fr;
            LAS unsigned char* wrow = slab + (wr * 16 + fr) * 528;
            const int sr = wid * 4 + (lane >> 5), cb = (lane & 31) * 16;
            const LAS unsigned char* rp = slab + sr * 528 + cb;
            const int trow = (sr >> 4) * 64 + (sr & 15);
            const bool rope = pn < 16 && ((0x57DF >> pn) & 1); const int d0 = 16 * wc + 4 * fq;
            f32x4 csa[8], sna[8];
#pragma unroll
            for (int g = 0; g < 8; ++g) { csa[g] = f32x4{1.f, 1.f, 1.f, 1.f}; sna[g] = f32x4{0.f, 0.f, 0.f, 0.f}; }
            if (rope) {
#pragma unroll
                for (int g = 0; g < 8; ++g) { const int t = (row0 + (g >> 2) * HALF + (g & 3) * 16) & (T - 1); csa[g] = *(const f32x4*)(cosT + t * 64 + d0); sna[g] = *(const f32x4*)(sinT + t * 64 + d0); } }
#pragma unroll
            for (int g = 0; g < 8; ++g) { const int ai = g >> 2, m = g & 3; const f32x4 cs = csa[g], sn = sna[g];
                const float rstd = rsqrtf((float)rq[ai][m] * sc + NORM_EPS) * wscale;
#pragma unroll
                for (int bj = 0; bj < 2; ++bj) { const f32x4 v0 = acc[ai][bj][m][0] * rstd, v1 = acc[ai][bj][m][1] * rstd;
                    if (pn < 16) { const f32x4 o1 = v0 * cs - v1 * sn, o2 = v1 * cs + v0 * sn;
                        u32x2 w1, w2; w1.x = cvt_pk_bf16(o1[0], o1[1]); w1.y = cvt_pk_bf16(o1[2], o1[3]); w2.x = cvt_pk_bf16(o2[0], o2[1]); w2.y = cvt_pk_bf16(o2[2], o2[3]);
                        *(LAS u32x2*)(wrow + (bj * HD + d0) * 2) = w1; *(LAS u32x2*)(wrow + (bj * HD + 64 + d0) * 2) = w2; }
                    else { const float c1 = -1.4426950408889634f * rstd; const f32x4 s0 = sigmoid4_scaled(acc[ai][bj][m][0], c1), s1 = sigmoid4_scaled(acc[ai][bj][m][1], c1); u32x4 w;
                        w.x = cvt_pk_bf16(s0[0], s0[1]); w.y = cvt_pk_bf16(s0[2], s0[3]); w.z = cvt_pk_bf16(s1[0], s1[1]); w.w = cvt_pk_bf16(s1[2], s1[3]);
                        *(LAS u32x4*)(wrow + (bj * HD + wc * 32 + 8 * fq) * 2) = w; } }
                asm volatile("s_waitcnt lgkmcnt(0)" ::: "memory"); __builtin_amdgcn_s_barrier(); asm volatile("" ::: "memory");
                const u32x4 ra = *(const LAS u32x4*)rp, rb = *(const LAS u32x4*)(rp + 2 * 528);
                asm volatile("s_waitcnt lgkmcnt(0)" ::: "memory"); __builtin_amdgcn_s_barrier(); asm volatile("" ::: "memory");
                const int grow = u.pm * BM + ai * HALF + m * 16 + trow;
                unsigned char* dst; size_t rstride;
                if (pn == 10 || pn == 11) { bf16_t* cbuf = pn == 10 ? KCb : VCb; dst = (unsigned char*)(cbuf + ((size_t)((grow >> 12) * 2 + (cb >> 8)) * T + (grow & (T - 1))) * HD) + (cb & 255); rstride = (size_t)HD * 2; }
                else if (pn < 16) { dst = (unsigned char*)(QKV + (size_t)grow * 4096 + pn * 256) + cb; rstride = (size_t)4096 * 2; }
                else { dst = (unsigned char*)(GMb + (size_t)grow * 4096 + (pn - 16) * 256) + cb; rstride = (size_t)4096 * 2; }
                *(u32x4*)dst = ra; *(u32x4*)(dst + 2 * rstride) = rb; }
        } else {
            if (wc == 0) {
#pragma unroll
                for (int ai = 0; ai < 2; ++ai)
#pragma unroll
                    for (int m = 0; m < 4; ++m) { const int row = row0 + ai * HALF + m * 16; const float rstd = rsqrtf((float)rq[ai][m] * sc + NORM_EPS) * wscale;
                        const f32x4 v0 = acc[ai][0][m][0] * rstd, v1 = acc[ai][0][m][1] * rstd; u32x4 w;
                        w.x = cvt_pk_bf16(fast_sigmoid(v0[0]), fast_sigmoid(v0[1])); w.y = cvt_pk_bf16(fast_sigmoid(v0[2]), fast_sigmoid(v0[3]));
                        w.z = cvt_pk_bf16(fast_sigmoid(v1[0]), fast_sigmoid(v1[1])); w.w = cvt_pk_bf16(fast_sigmoid(v1[2]), fast_sigmoid(v1[3]));
                        *(u32x4*)(NGb + (size_t)row * 32 + 8 * fq) = w; }
            }
        }
    }
};
struct EpiCmp1 {
    static constexpr bool PERM = true;
    bf16_t* H; const long long* bias;
    __device__ __forceinline__ bool keep(const Unit&) const { return false; }
    __device__ __forceinline__ void operator()(const Acc& acc, const Unit& u, int wr, int wc, int fr, int fq) const {
        const int row0 = u.pm * BM + wr * 64 + fr, col0 = wc * 32 + 8 * fq;
        f32x4 bv[2][2];
#pragma unroll
        for (int bj = 0; bj < 2; ++bj)
#pragma unroll
            for (int n = 0; n < 2; ++n) { const long long* bp = bias + col0 + bj * HALF + 4 * n; bv[bj][n] = f32x4{(float)bp[0], (float)bp[1], (float)bp[2], (float)bp[3]} * (1.0f / CB_SCALE); }
#pragma unroll
        for (int ai = 0; ai < 2; ++ai)
#pragma unroll
            for (int m = 0; m < 4; ++m) { bf16_t* rowp = H + (size_t)(row0 + ai * HALF + m * 16) * 256 + col0;
#pragma unroll
                for (int bj = 0; bj < 2; ++bj) { f32x4 v0 = acc[ai][bj][m][0] + bv[bj][0], v1 = acc[ai][bj][m][1] + bv[bj][1];
#pragma unroll
                    for (int j = 0; j < 4; ++j) { v0[j] = v0[j] * fast_sigmoid(v0[j]); v1[j] = v1[j] * fast_sigmoid(v1[j]); }
                    u32x4 w; w.x = cvt_pk_bf16(v0[0], v0[1]); w.y = cvt_pk_bf16(v0[2], v0[3]); w.z = cvt_pk_bf16(v1[0], v1[1]); w.w = cvt_pk_bf16(v1[2], v1[3]);
                    *(u32x4*)(rowp + bj * HALF) = w; } }
    }
};
struct EpiCmp2 {
    static constexpr bool PERM = true;
    bf16_t* O;
    __device__ __forceinline__ bool keep(const Unit&) const { return false; }
    __device__ __forceinline__ void operator()(const Acc& acc, const Unit& u, int wr, int wc, int fr, int fq) const {
        const int row0 = u.pm * BM + wr * 64 + fr, col0 = wc * 32 + 8 * fq;
#pragma unroll
        for (int ai = 0; ai < 2; ++ai)
#pragma unroll
            for (int m = 0; m < 4; ++m) { const int row = row0 + ai * HALF + m * 16; const float z = ((row & 255) == 255) ? 0.f : 1.f;
                const f32x4 v0 = acc[ai][0][m][0] * z, v1 = acc[ai][0][m][1] * z;
                u32x4 w; w.x = cvt_pk_bf16(v0[0], v0[1]); w.y = cvt_pk_bf16(v0[2], v0[3]); w.z = cvt_pk_bf16(v1[0], v1[1]); w.w = cvt_pk_bf16(v1[2], v1[3]);
                *(u32x4*)(O + (size_t)row * HD + col0) = w; }
    }
};
struct EpiMerge {
    static constexpr bool PERM = true;
    const bf16_t* GMb; unsigned char* Z; float zscale;
    __device__ __forceinline__ bool keep(const Unit& u) const { return u.aux == 0; }
    __device__ __forceinline__ void operator()(Acc& acc, const Unit& u, int wr, int wc, int fr, int fq) const {
        const int row0 = u.pm * BM + wr * 64 + fr, col0 = u.pn * BM + wc * 32 + 8 * fq;
        if (u.aux == 0) {
#pragma unroll
            for (int ai = 0; ai < 2; ++ai)
#pragma unroll
                for (int m = 0; m < 4; ++m) { const int row = row0 + ai * HALF + m * 16;
#pragma unroll
                    for (int bj = 0; bj < 2; ++bj) { const int col = col0 + bj * HALF;
                        const u32x4 g1 = *(const u32x4*)(GMb + (size_t)row * 4096 + 2048 + col), g0 = *(const u32x4*)(GMb + (size_t)row * 4096 + col);
                        const f32x4 g1a = {bf_lo(g1.x), bf_hi(g1.x), bf_lo(g1.y), bf_hi(g1.y)}, g1b = {bf_lo(g1.z), bf_hi(g1.z), bf_lo(g1.w), bf_hi(g1.w)};
                        const f32x4 g0a = {bf_lo(g0.x), bf_hi(g0.x), bf_lo(g0.y), bf_hi(g0.y)}, g0b = {bf_lo(g0.z), bf_hi(g0.z), bf_lo(g0.w), bf_hi(g0.w)};
#pragma unroll
                        for (int j = 0; j < 4; ++j) { acc[ai][bj][m][0][j] *= g0a[j] * __builtin_amdgcn_rcpf(fmaxf(g1a[j], 1e-30f)); acc[ai][bj][m][1][j] *= g0b[j] * __builtin_amdgcn_rcpf(fmaxf(g1b[j], 1e-30f)); } } }
        } else {
            u32x4 gc[2], gn[2];
#pragma unroll
            for (int bj = 0; bj < 2; ++bj) gc[bj] = *(const u32x4*)(GMb + (size_t)row0 * 4096 + 2048 + col0 + bj * HALF);
#pragma unroll
            for (int g = 0; g < 8; ++g) { const int ai = g >> 2, m = g & 3, row = row0 + ai * HALF + m * 16;
                if (g < 7) { const int rn = row0 + ((g + 1) >> 2) * HALF + ((g + 1) & 3) * 16;
#pragma unroll
                    for (int bj = 0; bj < 2; ++bj) gn[bj] = *(const u32x4*)(GMb + (size_t)rn * 4096 + 2048 + col0 + bj * HALF); }
#pragma unroll
                for (int bj = 0; bj < 2; ++bj) { const u32x4 g1 = gc[bj];
                    const f32x4 g1a = {bf_lo(g1.x), bf_hi(g1.x), bf_lo(g1.y), bf_hi(g1.y)}, g1b = {bf_lo(g1.z), bf_hi(g1.z), bf_lo(g1.w), bf_hi(g1.w)};
                    const f32x4 v0 = acc[ai][bj][m][0] * g1a * zscale, v1 = acc[ai][bj][m][1] * g1b * zscale;
                    u32x2 w; w.x = cvt4_fp8(v0[0], v0[1], v0[2], v0[3]); w.y = cvt4_fp8(v1[0], v1[1], v1[2], v1[3]);
                    *(u32x2*)(Z + (size_t)row * D + col0 + bj * HALF) = w; }
                gc[0] = gn[0]; gc[1] = gn[1]; }
        }
    }
};
struct EpiResid {
    static constexpr bool PERM = true;
    const void* xin; int xin16; bf16_t* XB; u64* rsq_out; unsigned char* X8; float ascale;
    __device__ __forceinline__ bool keep(const Unit&) const { return false; }
    __device__ __forceinline__ void ldx(size_t off, f32x4& a, f32x4& b) const {
        if (xin16) { const u32x4 w = *(const u32x4*)((const bf16_t*)xin + off); a = f32x4{bf_lo(w.x), bf_hi(w.x), bf_lo(w.y), bf_hi(w.y)}; b = f32x4{bf_lo(w.z), bf_hi(w.z), bf_lo(w.w), bf_hi(w.w)}; }
        else { a = *(const f32x4*)((const float*)xin + off); b = *(const f32x4*)((const float*)xin + off + 4); } }
    __device__ __forceinline__ void operator()(const Acc& acc, const Unit& u, int wr, int wc, int fr, int fq) const {
        const int row0 = u.pm * BM + wr * 64 + fr, col0 = u.pn * BM + wc * 32 + 8 * fq;
        f32x4 xc[2][2], xn[2][2];
#pragma unroll
        for (int bj = 0; bj < 2; ++bj) ldx((size_t)row0 * D + col0 + bj * HALF, xc[bj][0], xc[bj][1]);
#pragma unroll
        for (int g = 0; g < 8; ++g) { const int ai = g >> 2, m = g & 3, row = row0 + ai * HALF + m * 16; const size_t off = (size_t)row * D + col0; float ss = 0.f;
            if (g < 7) { const size_t offn = (size_t)(row0 + ((g + 1) >> 2) * HALF + ((g + 1) & 3) * 16) * D + col0;
#pragma unroll
                for (int bj = 0; bj < 2; ++bj) ldx(offn + bj * HALF, xn[bj][0], xn[bj][1]); }
#pragma unroll
            for (int bj = 0; bj < 2; ++bj) { const size_t o = off + bj * HALF; const f32x4 x0 = xc[bj][0] + acc[ai][bj][m][0] * ascale, x1 = xc[bj][1] + acc[ai][bj][m][1] * ascale;
                { u32x4 w; w.x = cvt_pk_bf16(x0[0], x0[1]); w.y = cvt_pk_bf16(x0[2], x0[3]); w.z = cvt_pk_bf16(x1[0], x1[1]); w.w = cvt_pk_bf16(x1[2], x1[3]); *(u32x4*)(XB + o) = w; }
                if (X8) { u32x2 w; w.x = cvt4_fp8(x0[0], x0[1], x0[2], x0[3]); w.y = cvt4_fp8(x1[0], x1[1], x1[2], x1[3]); *(u32x2*)(X8 + o) = w; }
                ss += (x0[0] * x0[0] + x0[1] * x0[1]) + (x0[2] * x0[2] + x0[3] * x0[3]) + (x1[0] * x1[0] + x1[1] * x1[1]) + (x1[2] * x1[2] + x1[3] * x1[3]); }
            ss += __shfl_xor(ss, 16); ss += __shfl_xor(ss, 32);
            if (fq == 0) atomicAdd(rsq_out + row, (u64)(ss * RSQ_SCALE + 0.5f));
#pragma unroll
            for (int bj = 0; bj < 2; ++bj)
#pragma unroll
                for (int n = 0; n < 2; ++n) xc[bj][n] = xn[bj][n]; }
    }
};
template <bool MOE, bool OUT8 = MOE, bool W8 = MOE> struct EpiGateUp {
    static constexpr bool PERM = true;
    bf16_t* ACT; const u64* rsq; const int* ltok; const volatile LAS unsigned* misc;
    __device__ __forceinline__ bool keep(const Unit&) const { return false; }
    __device__ __forceinline__ void operator()(const Acc& acc, const Unit& u, int wr, int wc, int fr, int fq) const {
        const int row0 = u.pm * BM + wr * 64 + fr, col0 = u.pn * 128 + wc * 32 + 8 * fq;
        int cnt = 0, r0 = 0; if (MOE) { cnt = (int)misc[8 + u.aux]; r0 = (u.pm - (int)misc[16 + u.aux]) * BM + wr * 64 + fr; }
        int srow[2][4]; u64 rq[2][4];
#pragma unroll
        for (int ai = 0; ai < 2; ++ai)
#pragma unroll
            for (int m = 0; m < 4; ++m) { srow[ai][m] = row0 + ai * HALF + m * 16; if (MOE) { const int r = r0 + ai * HALF + m * 16; srow[ai][m] = r < cnt ? ltok[u.aux * M + r] : 0; } }
#pragma unroll
        for (int ai = 0; ai < 2; ++ai)
#pragma unroll
            for (int m = 0; m < 4; ++m) rq[ai][m] = rsq[srow[ai][m]];
#pragma unroll
        for (int ai = 0; ai < 2; ++ai)
#pragma unroll
            for (int m = 0; m < 4; ++m) { const int row = row0 + ai * HALF + m * 16;
                const float rstd = rsqrtf((float)rq[ai][m] * (1.0f / (RSQ_SCALE * D)) + NORM_EPS) * (W8 ? 1.0f / WGU8_SCALE : 1.0f);
                const float c1 = -1.4426950408889634f * rstd, r2 = rstd * rstd;
                f32x4 a[2];
#pragma unroll
                for (int n = 0; n < 2; ++n) { const f32x4 g = acc[ai][0][m][n], up = acc[ai][1][m][n]; const f32x4 t = g * c1, gu = g * up; f32x4 e, sg;
#pragma unroll
                    for (int j = 0; j < 4; ++j) e[j] = __builtin_amdgcn_exp2f(t[j]);
                    const f32x4 d = e + 1.0f;
#pragma unroll
                    for (int j = 0; j < 4; ++j) sg[j] = __builtin_amdgcn_rcpf(d[j]);
                    a[n] = gu * (sg * r2); }
                if (OUT8) { u32x2 w; w.x = cvt4_fp8(a[0][0], a[0][1], a[0][2], a[0][3]); w.y = cvt4_fp8(a[1][0], a[1][1], a[1][2], a[1][3]); *(u32x2*)((unsigned char*)ACT + (size_t)row * FF + col0) = w; }
                else { u32x4 w; w.x = cvt_pk_bf16(a[0][0], a[0][1]); w.y = cvt_pk_bf16(a[0][2], a[0][3]); w.z = cvt_pk_bf16(a[1][0], a[1][1]); w.w = cvt_pk_bf16(a[1][2], a[1][3]); *(u32x4*)(ACT + (size_t)row * FF + col0) = w; } }
    }
};
struct EpiMoeDown {
    static constexpr bool PERM = true;
    bf16_t* YS; const float* lw; const volatile LAS unsigned* misc;
    __device__ __forceinline__ bool keep(const Unit&) const { return false; }
    __device__ __forceinline__ void operator()(const Acc& acc, const Unit& u, int wr, int wc, int fr, int fq) const {
        const int row0 = u.pm * BM + wr * 64 + fr, col0 = u.pn * BM + wc * 32 + 8 * fq;
        const int cnt = (int)misc[8 + u.aux], r0 = (u.pm - (int)misc[16 + u.aux]) * BM + wr * 64 + fr;
        float wg[2][4];
#pragma unroll
        for (int ai = 0; ai < 2; ++ai)
#pragma unroll
            for (int m = 0; m < 4; ++m) { const int r = r0 + ai * HALF + m * 16; wg[ai][m] = r < cnt ? lw[u.aux * M + r] * (1.0f / WD8_SCALE) : 0.f; }
#pragma unroll
        for (int ai = 0; ai < 2; ++ai)
#pragma unroll
            for (int m = 0; m < 4; ++m) { const int row = row0 + ai * HALF + m * 16; const float wgt = wg[ai][m];
#pragma unroll
                for (int bj = 0; bj < 2; ++bj) { const f32x4 v0 = acc[ai][bj][m][0] * wgt, v1 = acc[ai][bj][m][1] * wgt;
                    u32x4 w; w.x = cvt_pk_bf16(v0[0], v0[1]); w.y = cvt_pk_bf16(v0[2], v0[3]); w.z = cvt_pk_bf16(v1[0], v1[1]); w.w = cvt_pk_bf16(v1[2], v1[3]);
                    *(u32x4*)(YS + (size_t)row * D + col0 + bj * HALF) = w; } }
    }
};
struct EpiMoeDownTail {
    static constexpr bool PERM = true;
    bf16_t* YT; const float* lw; const volatile LAS unsigned* misc;
    __device__ __forceinline__ bool keep(const Unit&) const { return false; }
    __device__ __forceinline__ void operator()(const Acc& acc, const Unit& u, int wr, int wc, int fr, int fq) const {
        const int e = u.aux & 255, part = u.aux >> 8, Tm = (int)misc[25];
        const int row0 = (u.pm - Tm) * BM + wr * 64 + fr, col0 = u.pn * BM + wc * 32 + 8 * fq;
        const int cnt = (int)misc[8 + e], r0 = (u.pm - (int)misc[16 + e]) * BM + wr * 64 + fr;
        float wg[2][4];
#pragma unroll
        for (int ai = 0; ai < 2; ++ai)
#pragma unroll
            for (int m = 0; m < 4; ++m) { const int r = r0 + ai * HALF + m * 16; wg[ai][m] = r < cnt ? lw[e * M + r] * (1.0f / WD8_SCALE) : 0.f; }
        bf16_t* Y = YT + (size_t)part * YT_ROWS * D;
#pragma unroll
        for (int ai = 0; ai < 2; ++ai)
#pragma unroll
            for (int m = 0; m < 4; ++m) { const int row = row0 + ai * HALF + m * 16; const float wgt = wg[ai][m];
#pragma unroll
                for (int bj = 0; bj < 2; ++bj) { const f32x4 v0 = acc[ai][bj][m][0] * wgt, v1 = acc[ai][bj][m][1] * wgt;
                    u32x4 w; w.x = cvt_pk_bf16(v0[0], v0[1]); w.y = cvt_pk_bf16(v0[2], v0[3]); w.z = cvt_pk_bf16(v1[0], v1[1]); w.w = cvt_pk_bf16(v1[2], v1[3]);
                    *(u32x4*)(Y + (size_t)row * D + col0 + bj * HALF) = w; } }
    }
};
}

namespace att {
constexpr float SCALE = 0.08838834764831845f, LOG2E = 1.4426950408889634f, C2 = LOG2E * SCALE, THR = 8.f;
constexpr int TILE_B = 16384;
#define KSWZ(row, colB) ((row) * 256 + ((colB) ^ (((row) & 7) << 4)))
#define SBAR() __builtin_amdgcn_sched_barrier(0)
__device__ __forceinline__ int v_st(int k, int c) { const int kk = (k & ~0xC) | ((k & 4) << 1) | ((k & 8) >> 1); return ((kk >> 3) * 4 + (c >> 5)) * 512 + ((kk & 7) * 32 + (c & 31)) * 2; }
__device__ __forceinline__ int v_rd_base(int lane) { return ((lane & 3) << 3) | (((lane >> 2) & 3) << 6) | (((lane >> 4) & 1) << 5) | (((lane >> 5) & 1) << 8); }
constexpr int v_rd_off(int d0, int ks, int half) { return d0 * 512 + ks * 4096 + half * 2048; }
__device__ __forceinline__ int crow(int r, int hi) { return (r & 3) + 8 * (r >> 2) + 4 * hi; }

__device__ __forceinline__ void mask_tile(f32x16& p0, f32x16& p1, int dq, unsigned W) {
    const float NEG = -__builtin_inff();
#pragma unroll
    for (int r = 0; r < 16; ++r) { const int c = (r & 3) + 8 * (r >> 2);
        if ((unsigned)(dq - c) >= W) p0[r] = NEG;
        if ((unsigned)(dq - c - 32) >= W) p1[r] = NEG; }
}
__device__ __forceinline__ void mask_all(f32x16& p0, f32x16& p1, bool keep) {
    const float NEG = -__builtin_inff();
#pragma unroll
    for (int r = 0; r < 16; ++r) { p0[r] = keep ? p0[r] : NEG; p1[r] = keep ? p1[r] : NEG; }
}
__device__ __forceinline__ float rowmax32(const f32x16& p0, const f32x16& p1) {
    float pmax = p0[0];
#pragma unroll
    for (int r = 1; r < 16; ++r) pmax = fmaxf(pmax, p0[r]);
#pragma unroll
    for (int r = 0; r < 16; ++r) pmax = fmaxf(pmax, p1[r]);
    auto rr = __builtin_amdgcn_permlane32_swap(__float_as_uint(pmax), __float_as_uint(pmax), false, false);
    return fmaxf(__uint_as_float(rr[0]), __uint_as_float(rr[1]));
}
__device__ __forceinline__ float rowsum32(const f32x16& p0, const f32x16& p1) {
    float ps = 0.f;
#pragma unroll
    for (int r = 0; r < 16; ++r) ps += p0[r];
#pragma unroll
    for (int r = 0; r < 16; ++r) ps += p1[r];
    auto rr = __builtin_amdgcn_permlane32_swap(__float_as_uint(ps), __float_as_uint(ps), false, false);
    return __uint_as_float(rr[0]) + __uint_as_float(rr[1]);
}
__device__ __forceinline__ void pack_p(const f32x16& p0, const f32x16& p1, bf16x8& pa0, bf16x8& pa1, bf16x8& pa2, bf16x8& pa3) {
#define PK4(P, B_, OUT) do { unsigned a0 = cvt_pk_bf16(P[B_+0], P[B_+1]), a1 = cvt_pk_bf16(P[B_+2], P[B_+3]);                          \
        unsigned b0 = cvt_pk_bf16(P[B_+4], P[B_+5]), b1 = cvt_pk_bf16(P[B_+6], P[B_+7]);                                             \
        auto r0 = __builtin_amdgcn_permlane32_swap(a0, b0, false, false); auto r1 = __builtin_amdgcn_permlane32_swap(a1, b1, false, false); \
        u32x4 w = {r0[0], r1[0], r0[1], r1[1]}; OUT = *reinterpret_cast<bf16x8*>(&w); } while (0)
    PK4(p0, 0, pa0); PK4(p0, 8, pa1); PK4(p1, 0, pa2); PK4(p1, 8, pa3);
#undef PK4
}
__device__ __forceinline__ void softmax_step(f32x16& p0, f32x16& p1, float& m_reg, float& l_reg, float& alpha) {
    const float pmax = rowmax32(p0, p1); float mn;
    if (__builtin_expect(__all((pmax - m_reg) * SCALE <= THR), 1)) { mn = m_reg; alpha = 1.f; }
    else { mn = fmaxf(m_reg, pmax); alpha = __builtin_amdgcn_exp2f((m_reg - mn) * C2); m_reg = mn; }
    const float mnL = -mn * C2;
#pragma unroll
    for (int r = 0; r < 16; ++r) { p0[r] = __builtin_amdgcn_exp2f(fmaf(p0[r], C2, mnL)); p1[r] = __builtin_amdgcn_exp2f(fmaf(p1[r], C2, mnL)); }
    l_reg = l_reg * alpha + rowsum32(p0, p1);
}
__device__ __forceinline__ void softmax_step_keep(f32x16& p0, f32x16& p1, float& m_reg, float& l_reg, float& alpha, bool keep) {
    const float NEG = -__builtin_inff();
    const float pm = rowmax32(p0, p1), pmax = keep ? pm : NEG; float mn;
    if (__builtin_expect(__all((pmax - m_reg) * SCALE <= THR), 1)) { mn = m_reg; alpha = 1.f; }
    else { mn = fmaxf(m_reg, pmax); alpha = __builtin_amdgcn_exp2f((m_reg - mn) * C2); m_reg = mn; }
    const float c2 = keep ? C2 : 0.f, mnL = keep ? -mn * C2 : NEG;
#pragma unroll
    for (int r = 0; r < 16; ++r) { p0[r] = __builtin_amdgcn_exp2f(fmaf(p0[r], c2, mnL)); p1[r] = __builtin_amdgcn_exp2f(fmaf(p1[r], c2, mnL)); }
    l_reg = l_reg * alpha + rowsum32(p0, p1);
}
__device__ __forceinline__ void qkt(f32x16& p0, f32x16& p1, const LAS char* K_lds, int r32, int hi, const bf16x8* qr) {
    p0 = f32x16{}; p1 = f32x16{};
    const LAS char* kb[4];
#pragma unroll
    for (int dd = 0; dd < 4; ++dd) kb[dd] = K_lds + KSWZ(r32, (dd * 16 + hi * 8) * 2);
#pragma unroll
    for (int d0 = 0; d0 < 8; ++d0) { const LAS char* a = kb[d0 & 3] + (d0 >> 2) * 128;
        const bf16x8 b0 = *reinterpret_cast<const LAS bf16x8*>(a);
        const bf16x8 b1 = *reinterpret_cast<const LAS bf16x8*>(a + 32 * 256);
        p0 = __builtin_amdgcn_mfma_f32_32x32x16_bf16(b0, qr[d0], p0, 0, 0, 0);
        p1 = __builtin_amdgcn_mfma_f32_32x32x16_bf16(b1, qr[d0], p1, 0, 0, 0); }
}
__device__ __forceinline__ void pv_tile(f32x16* o, int vb0, bf16x8 pa0, bf16x8 pa1, bf16x8 pa2, bf16x8 pa3) {
#define TRRD(dst, off) asm volatile("ds_read_b64_tr_b16 %0, %1 offset:%2" : "=&v"(dst) : "v"(vb0), "i"(off) : "memory")
#define PV_D0(d0) do { s16x4 l0, l1, l2, l3, h0, h1, h2, h3; constexpr int b_ = v_rd_off(d0, 0, 0); \
        TRRD(l0, b_); TRRD(h0, b_ + 2048); TRRD(l1, b_ + 4096); TRRD(h1, b_ + 6144); TRRD(l2, b_ + 8192); TRRD(h2, b_ + 10240); TRRD(l3, b_ + 12288); TRRD(h3, b_ + 14336); \
        asm volatile("s_waitcnt lgkmcnt(0)" ::: "memory"); SBAR();   \
        o[d0] = __builtin_amdgcn_mfma_f32_32x32x16_bf16(pa0, (bf16x8){l0[0], l0[1], l0[2], l0[3], h0[0], h0[1], h0[2], h0[3]}, o[d0], 0, 0, 0);   \
        o[d0] = __builtin_amdgcn_mfma_f32_32x32x16_bf16(pa1, (bf16x8){l1[0], l1[1], l1[2], l1[3], h1[0], h1[1], h1[2], h1[3]}, o[d0], 0, 0, 0);   \
        o[d0] = __builtin_amdgcn_mfma_f32_32x32x16_bf16(pa2, (bf16x8){l2[0], l2[1], l2[2], l2[3], h2[0], h2[1], h2[2], h2[3]}, o[d0], 0, 0, 0);   \
        o[d0] = __builtin_amdgcn_mfma_f32_32x32x16_bf16(pa3, (bf16x8){l3[0], l3[1], l3[2], l3[3], h3[0], h3[1], h3[2], h3[3]}, o[d0], 0, 0, 0); } while (0)
    PV_D0(0); PV_D0(1); PV_D0(2); PV_D0(3);
#undef PV_D0
#undef TRRD
}

struct Ctx {
    int tid, wid, lane, r32, hi, sr, sc, kws, vst0, vst1, vb0;
    LAS char* K_lds; LAS char* V_lds; LAS float* wscr;
};
__device__ __forceinline__ Ctx make_ctx(LAS unsigned char* lds) {
    Ctx c; c.tid = opaque_tid(); c.wid = __builtin_amdgcn_readfirstlane(c.tid >> 6); c.lane = c.tid & 63; c.r32 = c.lane & 31; c.hi = c.lane >> 5;
    c.sr = c.tid >> 4; c.sc = (c.tid & 15) * 8; c.kws = KSWZ(c.sr, c.sc * 2); c.vst0 = v_st(c.sr, c.sc); c.vst1 = v_st(32 + c.sr, c.sc);
    c.K_lds = (LAS char*)(lds + LDS_K); c.V_lds = (LAS char*)(lds + LDS_V); c.wscr = (LAS float*)(lds + LDS_WSCR) + c.wid * 64;
    c.vb0 = (int)(unsigned)(uintptr_t)c.V_lds + v_rd_base(c.lane);
    return c;
}
__device__ __forceinline__ void glds16(const void* sbase, unsigned voff, unsigned lds_dst) { unsigned keep;
    asm volatile("s_mov_b32 %0, m0\n\ts_mov_b32 m0, %3\n\ts_nop 0\n\tglobal_load_lds_dwordx4 %1, %2\n\ts_mov_b32 m0, %0" : "=&s"(keep) : "v"(voff), "s"(sbase), "s"(lds_dst) : "memory"); }
__device__ __forceinline__ const void* uniform_ptr(const void* p) { const unsigned long long v = (unsigned long long)p; const unsigned lo = __builtin_amdgcn_readfirstlane((unsigned)v), hi = __builtin_amdgcn_readfirstlane((unsigned)(v >> 32));
    return (const void*)(GAS const void*)(((unsigned long long)hi << 32) | lo); }
struct Dma { unsigned ko[2], vo[2]; };
__device__ __forceinline__ Dma make_dma(const Ctx& c, int ldk, int ldv) {
    Dma d;
#pragma unroll
    for (int i = 0; i < 2; ++i) { const int p = c.wid * 2 + i, row = 4 * p + (c.lane >> 4); d.ko[i] = (unsigned)(row * ldk + (((c.lane & 15) ^ (row & 7)) * 8)) * 2u;
        const int st = 2 * p + (c.lane >> 5), kk = (st >> 2) * 8 + ((c.lane & 31) >> 2), k = (kk & ~0xC) | ((kk & 4) << 1) | ((kk & 8) >> 1); d.vo[i] = (unsigned)(k * ldv + (st & 3) * 32 + (c.lane & 3) * 8) * 2u; }
    return d;
}
__device__ __forceinline__ void dma_tile(const Ctx& c, const Dma& d, const bf16_t* Kg, int ldk, const bf16_t* Vg, int ldv, int key0, int slot) {
    const void* kb = uniform_ptr(Kg + (size_t)key0 * ldk); const void* vb = uniform_ptr(Vg + (size_t)key0 * ldv);
#pragma unroll
    for (int i = 0; i < 2; ++i) {
        glds16(kb, d.ko[i], (unsigned)__builtin_amdgcn_readfirstlane((int)(unsigned)(uintptr_t)(c.K_lds + slot * TILE_B + (c.wid * 2 + i) * 1024)));
        glds16(vb, d.vo[i], (unsigned)__builtin_amdgcn_readfirstlane((int)(unsigned)(uintptr_t)(c.V_lds + slot * TILE_B + (c.wid * 2 + i) * 1024))); }
}
#define ATT_BAR() do { asm volatile("s_waitcnt lgkmcnt(0)" ::: "memory"); __builtin_amdgcn_s_barrier(); asm volatile("" ::: "memory"); } while (0)
__device__ __forceinline__ void rescale_o(f32x16* o, float alpha, const Ctx& c) {
    if (__any(alpha < 1.f)) { if (c.hi == 0) c.wscr[32 + c.r32] = alpha; LDS_WAIT();
#pragma unroll
        for (int d = 0; d < 4; ++d)
#pragma unroll
            for (int r = 0; r < 16; ++r) o[d][r] *= c.wscr[32 + crow(r, c.hi)];
        LDS_WAIT(); }
}
template <int MODE>
__device__ __forceinline__ void attn_loop_simple(const Ctx& c, const bf16_t* Kg, int ldk, const bf16_t* Vg, int ldv, int j_lo, int NT, const bf16x8* qr,
                                          int qpos, int qlo, int W, unsigned sel_lo, unsigned sel_hi, int diag, f32x16* o, float& m_reg, float& l_reg) {
    f32x16 p0, p1; bf16x8 pa0, pa1, pa2, pa3; float alpha;
    const Dma d = make_dma(c, ldk, ldv);
    dma_tile(c, d, Kg, ldk, Vg, ldv, j_lo * 64, 0);
    if (NT > 1) dma_tile(c, d, Kg, ldk, Vg, ldv, j_lo * 64 + 64, 1);
    int slot = 0, slot2 = 2;
    for (int t = 0; t < NT; ++t) { const int jt = j_lo + t, kb_ = jt * 64, bo = slot * TILE_B;
        if (t + 1 < NT) asm volatile("s_waitcnt vmcnt(4)" ::: "memory"); else asm volatile("s_waitcnt vmcnt(0)" ::: "memory");
        ATT_BAR();
        if (t + 2 < NT) dma_tile(c, d, Kg, ldk, Vg, ldv, kb_ + 128, slot2);
        SBAR(); qkt(p0, p1, c.K_lds + bo, c.r32, c.hi, qr); bool keep = true;
        if (MODE == 0) { if (kb_ + 63 > qlo || kb_ <= qlo + 31 - W) mask_tile(p0, p1, qpos - kb_ - 4 * c.hi, (unsigned)W); }
        else { const unsigned bit = (jt < 32 ? (sel_lo >> jt) : (sel_hi >> (jt - 32))) & 1u; keep = bit != 0u;
               if (jt == diag) mask_tile(p0, p1, qpos - kb_ - 4 * c.hi, 0x40000000u); }
        if (MODE == 2) softmax_step_keep(p0, p1, m_reg, l_reg, alpha, keep); else softmax_step(p0, p1, m_reg, l_reg, alpha); pack_p(p0, p1, pa0, pa1, pa2, pa3); rescale_o(o, alpha, c);
        pv_tile(o, c.vb0 + bo, pa0, pa1, pa2, pa3);
        slot = slot == 2 ? 0 : slot + 1; slot2 = slot2 == 2 ? 0 : slot2 + 1; }
    ATT_BAR();
}
template <int MODE>
__device__ __forceinline__ void attn_loop(const Ctx& c, const bf16_t* Kg, int ldk, const bf16_t* Vg, int ldv, int j_lo, int NT, const bf16x8* qr,
                                          int qpos, int qlo, int W, unsigned sel_lo, unsigned sel_hi, int diag, f32x16* o, float& m_reg, float& l_reg) {
    f32x16 pA0, pA1, pB0, pB1; bf16x8 pa0, pa1, pa2, pa3; float alpha;
    const Dma d = make_dma(c, ldk, ldv);
    dma_tile(c, d, Kg, ldk, Vg, ldv, j_lo * 64, 0);
    if (NT > 1) { dma_tile(c, d, Kg, ldk, Vg, ldv, j_lo * 64 + 64, 1); asm volatile("s_waitcnt vmcnt(4)" ::: "memory"); } else asm volatile("s_waitcnt vmcnt(0)" ::: "memory");
    ATT_BAR();
    if (NT > 2) dma_tile(c, d, Kg, ldk, Vg, ldv, j_lo * 64 + 128, 2);
    SBAR(); qkt(pA0, pA1, c.K_lds, c.r32, c.hi, qr);
#define ATT_STEP(PX0, PX1, PY0, PY1, t_) do { const int t = (t_), jt = j_lo + t, kb_ = jt * 64;                                          \
        if (t + 1 < NT) { if (t + 2 < NT) asm volatile("s_waitcnt vmcnt(4)" ::: "memory"); else asm volatile("s_waitcnt vmcnt(0)" ::: "memory"); }     \
        ATT_BAR();                                                                           \
        if (t + 3 < NT) dma_tile(c, d, Kg, ldk, Vg, ldv, kb_ + 192, (t + 3) & 3);                           \
        SBAR(); if (t + 1 < NT) qkt(PY0, PY1, c.K_lds + ((t + 1) & 3) * TILE_B, c.r32, c.hi, qr);          \
        SBAR();                                                                                  \
        if (MODE == 0) { if (kb_ + 63 > qlo || kb_ <= qlo + 31 - W) mask_tile(PX0, PX1, qpos - kb_ - 4 * c.hi, (unsigned)W); }            \
        else { const unsigned bit = (jt < 32 ? (sel_lo >> jt) : (sel_hi >> (jt - 32))) & 1u; mask_all(PX0, PX1, bit != 0u);               \
               if (jt == diag) mask_tile(PX0, PX1, qpos - kb_ - 4 * c.hi, 0x40000000u); }                                                \
        softmax_step(PX0, PX1, m_reg, l_reg, alpha); pack_p(PX0, PX1, pa0, pa1, pa2, pa3); rescale_o(o, alpha, c);                        \
        pv_tile(o, c.vb0 + (t & 3) * TILE_B, pa0, pa1, pa2, pa3); } while (0)
    for (int t2 = 0; t2 < NT; t2 += 2) { ATT_STEP(pA0, pA1, pB0, pB1, t2); if (t2 + 1 < NT) ATT_STEP(pB0, pB1, pA0, pA1, t2 + 1); }
#undef ATT_STEP
    ATT_BAR();
}
__device__ __forceinline__ void load_q(bf16x8* qr, const bf16_t* qrow, int hi) {
#pragma unroll
    for (int d0 = 0; d0 < 8; ++d0) qr[d0] = *(const bf16x8*)(qrow + d0 * 16 + hi * 8);
    asm volatile("" :: "v"(qr[0]), "v"(qr[1]), "v"(qr[2]), "v"(qr[3]), "v"(qr[4]), "v"(qr[5]), "v"(qr[6]), "v"(qr[7]));
}
template <bool ADD, bool OUT8 = false>
__device__ __forceinline__ void store_o(const f32x16* o, float frow, const Ctx& c, bf16_t* Og, int ldo, float fold_row = 1.0f, bool has_fold = false, unsigned char* O8 = nullptr) {
    if (c.hi == 0) { c.wscr[c.r32] = frow; c.wscr[32 + c.r32] = fold_row; } LDS_WAIT();
    LAS float* stg = (LAS float*)(c.K_lds + c.wid * 16384);
#pragma unroll
    for (int r = 0; r < 16; ++r) { const int row = crow(r, c.hi); const float f = c.wscr[row];
#pragma unroll
        for (int d0 = 0; d0 < 4; ++d0) stg[row * 128 + d0 * 32 + c.r32] = o[d0][r] * f; }
    LDS_WAIT();
    const int cc = c.lane & 15, rq = c.lane >> 4;
#pragma unroll
    for (int hb = 0; hb < 8; hb += 4) {
        int hbv = hb; asm volatile("" : "+v"(hbv));
        u32x4 old[4];
        if (ADD) {
#pragma unroll
            for (int i = 0; i < 4; ++i) old[i] = *(const u32x4*)(Og + (size_t)(rq + 4 * (hbv + i)) * 1024 + cc * 8);
        }
#pragma unroll
        for (int i = 0; i < 4; ++i) { const int row = rq + 4 * (hbv + i);
            f32x4 v0 = *(const LAS f32x4*)(stg + row * 128 + cc * 8), v1 = *(const LAS f32x4*)(stg + row * 128 + cc * 8 + 4);
            if (ADD) { const float fo = has_fold ? c.wscr[32 + row] : 1.0f;
                v0[0] = fmaf(bf_lo(old[i].x), fo, v0[0]); v0[1] = fmaf(bf_hi(old[i].x), fo, v0[1]); v0[2] = fmaf(bf_lo(old[i].y), fo, v0[2]); v0[3] = fmaf(bf_hi(old[i].y), fo, v0[3]);
                v1[0] = fmaf(bf_lo(old[i].z), fo, v1[0]); v1[1] = fmaf(bf_hi(old[i].z), fo, v1[1]); v1[2] = fmaf(bf_lo(old[i].w), fo, v1[2]); v1[3] = fmaf(bf_hi(old[i].w), fo, v1[3]); }
            if constexpr (OUT8) { u32x2 w; w.x = cvt4_fp8(v0[0] * O8_SCALE, v0[1] * O8_SCALE, v0[2] * O8_SCALE, v0[3] * O8_SCALE); w.y = cvt4_fp8(v1[0] * O8_SCALE, v1[1] * O8_SCALE, v1[2] * O8_SCALE, v1[3] * O8_SCALE);
                *(u32x2*)(O8 + (size_t)row * ldo + cc * 8) = w; }
            else { u32x4 w; w.x = cvt_pk_bf16(v0[0], v0[1]); w.y = cvt_pk_bf16(v0[2], v0[3]); w.z = cvt_pk_bf16(v1[0], v1[1]); w.w = cvt_pk_bf16(v1[2], v1[3]);
                *(u32x4*)(Og + (size_t)row * ldo + cc * 8) = w; } }
        asm volatile("" ::: "memory");
    }
    LDS_WAIT();
}
}

struct Frame {
    LAS unsigned char* lds; volatile LAS unsigned* misc; unsigned* ctl;
    int tid, lane, wave, G, vcu;
    const float* const* in; float* out; unsigned char* ws;
};
__device__ __forceinline__ void launder(Frame& F) { unsigned long long w_ = (unsigned long long)F.ws; asm volatile("" : "+s"(w_)); F.ws = (unsigned char*)(GAS unsigned char*)w_; F.out = (float*)(GAS float*)F.out; F.ctl = (unsigned*)(GAS unsigned*)F.ctl; asm volatile("" : "+v"(F.tid)); F.lane = F.tid & 63; F.wave = __builtin_amdgcn_readfirstlane(F.tid >> 6); }
enum { IN_X = 0, IN_ANORM, IN_WIN, IN_SINK, IN_PEK, IN_PEV, IN_WK1, IN_WK2, IN_WV1, IN_WV2, IN_WUPA, IN_WUPB, IN_WO, IN_FNORM, IN_DWG, IN_DWU, IN_DWD, IN_RW, IN_MWG, IN_MWU, IN_MWD, IN_FINAL };
#define INP(i) ((const float*)(const GAS float*)F.in[i])
#define WSP(T_, off) ((T_*)(F.ws + (off)))
#define BGP(T_, off) ((T_*)(F.ws + WS_BIG + (off)))

__device__ __forceinline__ int queue_pop(Frame& F, int q) {
    __syncthreads();
    if (F.tid == 0) F.misc[2] = __hip_atomic_fetch_add(F.ctl + CW_QUEUE + 64 * q, 1u, RLX_AGENT);
    __syncthreads();
    return (int)F.misc[2];
}

__device__ __forceinline__ int tr_drow(int mode, int n, int nn) {
    if (mode == 0) return n;
    if (mode == 1) { if (n < 4096) { const int d = n & 127; return (n & ~127) + 32 * ((d >> 4) & 3) + 8 * ((d >> 2) & 3) + 4 * (d >> 6) + (d & 3); }
                     return n < 4120 ? 8192 + (n - 4096) : 4096 + (n - 4120); }
    return 256 * (n >> 7) + 128 * nn + (n & 127);
}
__device__ __forceinline__ void tr_item(int mode, int nn, const float* W, int ld, int nsrc, const float* gain, int K, bf16_t* WT, int item, int nblk, int lane) {
    const int kb = item / nblk, nb = item - kb * nblk, kg = lane & 7, nq = lane >> 3, k0 = 64 * kb + 8 * kg, n = 32 * nb + 4 * nq;
    if (n >= nsrc) return;
    const float* p = W + (size_t)k0 * ld + n; f32x4 v[8];
#pragma unroll
    for (int j = 0; j < 8; ++j) v[j] = __builtin_nontemporal_load((const f32x4*)(p + (size_t)j * ld));
    if (gain) { const f32x4 g0 = *(const f32x4*)(gain + k0), g1 = *(const f32x4*)(gain + k0 + 4);
#pragma unroll
        for (int j = 0; j < 4; ++j) { v[j] = v[j] * g0[j]; v[4 + j] = v[4 + j] * g1[j]; } }
    const int c = tr_drow(mode, n, nn);
#pragma unroll
    for (int q = 0; q < 4; ++q) { u32x4 o; o.x = cvt_pk_bf16(v[0][q], v[1][q]); o.y = cvt_pk_bf16(v[2][q], v[3][q]); o.z = cvt_pk_bf16(v[4][q], v[5][q]); o.w = cvt_pk_bf16(v[6][q], v[7][q]);
        *(u32x4*)(WT + (size_t)(c + q) * K + k0) = o; }
}
__device__ __forceinline__ void tr_item8(int mode, int nn, const float* W, int ld, int nsrc, const float* gain, float scale, int K, unsigned char* WT, int item, int nblk, int lane) {
    const int kb = item / nblk, nb = item - kb * nblk, kg = lane & 7, nq = lane >> 3, k0 = 128 * kb + 16 * kg, n = 32 * nb + 4 * nq;
    if (n >= nsrc) return;
    const float* p = W + (size_t)k0 * ld + n; f32x4 v[16];
#pragma unroll
    for (int j = 0; j < 16; ++j) v[j] = __builtin_nontemporal_load((const f32x4*)(p + (size_t)j * ld));
#pragma unroll
    for (int j4 = 0; j4 < 4; ++j4) { f32x4 g = {scale, scale, scale, scale}; if (gain) g = *(const f32x4*)(gain + k0 + 4 * j4) * scale;
#pragma unroll
        for (int j = 0; j < 4; ++j) v[4 * j4 + j] = v[4 * j4 + j] * g[j]; }
    const int c = tr_drow(mode, n, nn);
#pragma unroll
    for (int q = 0; q < 4; ++q) { u32x4 o; o.x = cvt4_fp8(v[0][q], v[1][q], v[2][q], v[3][q]); o.y = cvt4_fp8(v[4][q], v[5][q], v[6][q], v[7][q]); o.z = cvt4_fp8(v[8][q], v[9][q], v[10][q], v[11][q]); o.w = cvt4_fp8(v[12][q], v[13][q], v[14][q], v[15][q]);
        __builtin_nontemporal_store(o, (u32x4*)(WT + (size_t)(c + q) * K + k0)); }
}
__device__ __forceinline__ void p_prologue(Frame F) {
    launder(F);
    const int gw = F.vcu * NWAVES + F.wave, NGW = F.G * NWAVES, lane = F.lane;
    constexpr int NB_IN = (IN_DIM + 31) / 32;
    { long long* cb = WSP(long long, WS_CBIAS);
      for (int u = gw; u < 1024; u += NGW) { const int q = u >> 8, l = q >> 1, kv = q & 1, nb = (u >> 6) & 3, kc = u & 63, n = nb * 64 + lane;
          const float* pe = INP(kv ? IN_PEV : IN_PEK) + (size_t)l * 4096 + kc * 64; const float* w1 = INP(kv ? IN_WV1 : IN_WK1) + (size_t)l * 4096 * 256 + (size_t)kc * 64 * 256 + n;
          float wv[64];
#pragma unroll
          for (int k = 0; k < 64; ++k) wv[k] = w1[(size_t)k * 256];
          float a0 = 0.f, a1 = 0.f, a2 = 0.f, a3 = 0.f;
#pragma unroll
          for (int k = 0; k < 64; k += 4) { a0 = fmaf(pe[k], wv[k], a0); a1 = fmaf(pe[k + 1], wv[k + 1], a1); a2 = fmaf(pe[k + 2], wv[k + 2], a2); a3 = fmaf(pe[k + 3], wv[k + 3], a3); }
          const float sum = (a0 + a1) + (a2 + a3);
          atomicAdd((unsigned long long*)(cb + q * 256 + n), (unsigned long long)(long long)rintf(sum * CB_SCALE)); } }
    constexpr int I_WIN = (D / 128) * NB_IN, I_W1 = (4096 / 64) * (256 / 32), I_W2 = (256 / 64) * (128 / 32), I_WUP = (1024 / 128) * (D / 32), I_WO = (D / 128) * (D / 32);
    {   constexpr int BI_G = (D / 128) * (FF / 256), BI_D = (FF / 128) * (D / 256), NBI = 16 * BI_G + 9 * BI_D;
        LAS unsigned char* tile = F.lds;
        for (int bi = F.vcu; bi < NBI; bi += F.G) {
            const float* W; const float* gain = nullptr; float scale; unsigned char* dst; int ld, Kd, mode = 0, nn = 0, kb, nb;
            if (bi < 16 * BI_G) { const int q = bi / BI_G, r = bi - q * BI_G, e = q >> 1; nn = q & 1; mode = 2; W = INP(nn ? IN_MWU : IN_MWG) + (size_t)e * D * FF; ld = FF; gain = INP(IN_FNORM) + D; scale = WGU8_SCALE;
                dst = WSP(unsigned char, WS_WGUM + (size_t)e * SZ_WGU8); Kd = D; kb = r / (FF / 256); nb = r - kb * (FF / 256); }
            else { const int r0 = bi - 16 * BI_G, e = r0 / BI_D, r = r0 - e * BI_D; ld = D; scale = WD8_SCALE;
                if (e < 8) { W = INP(IN_MWD) + (size_t)e * FF * D; dst = WSP(unsigned char, WS_WDM + (size_t)e * SZ_WD8); } else { W = INP(IN_DWD); dst = WSP(unsigned char, WS_WDD); }
                Kd = FF; kb = r / (D / 256); nb = r - kb * (D / 256); }
            const int k0 = 128 * kb + 16 * F.wave, n = 256 * nb + 4 * lane;
            const float* p = W + (size_t)k0 * ld + n; f32x4 v[16];
#pragma unroll
            for (int j = 0; j < 16; ++j) v[j] = __builtin_nontemporal_load((const f32x4*)(p + (size_t)j * ld));
#pragma unroll
            for (int j = 0; j < 16; ++j) { const float g = gain ? gain[k0 + j] * scale : scale; v[j] = v[j] * g; }
#pragma unroll
            for (int q = 0; q < 4; ++q) { u32x4 o; o.x = cvt4_fp8(v[0][q], v[1][q], v[2][q], v[3][q]); o.y = cvt4_fp8(v[4][q], v[5][q], v[6][q], v[7][q]); o.z = cvt4_fp8(v[8][q], v[9][q], v[10][q], v[11][q]); o.w = cvt4_fp8(v[12][q], v[13][q], v[14][q], v[15][q]);
                *(LAS u32x4*)(tile + (4 * lane + q) * 144 + 16 * F.wave) = o; }
            __syncthreads();
#pragma unroll
            for (int i = 0; i < 4; ++i) { const int nrow = 32 * F.wave + 8 * i + (lane >> 3), ch = lane & 7;
                const u32x4 o = *(const LAS u32x4*)(tile + nrow * 144 + 16 * ch);
                __builtin_nontemporal_store(o, (u32x4*)(dst + (size_t)tr_drow(mode, 256 * nb + nrow, nn) * Kd + 128 * kb + 16 * ch)); }
            __syncthreads();
        }
    }
    constexpr int I_G = (D / 64) * (FF / 32);
    constexpr int NITEMS = 2 * I_WIN + 4 * I_W1 + 4 * I_W2 + 4 * I_WUP + 2 * I_WO + 2 * I_G;
    for (int it = gw; it < NITEMS; it += NGW) {
        int r = it;
        if (r < 2 * I_G) { const int nn = r / I_G; r -= nn * I_G;
            tr_item(2, nn, INP(nn ? IN_DWU : IN_DWG), FF, FF, INP(IN_FNORM), D, WSP(bf16_t, WS_WGUD), r, FF / 32, lane); continue; } r -= 2 * I_G;
        if (r < 2 * I_WIN) { const int l = r / I_WIN; r -= l * I_WIN;
            tr_item8(1, 0, INP(IN_WIN) + (size_t)l * D * IN_DIM, IN_DIM, IN_DIM, INP(IN_ANORM) + l * D, WIN8_SCALE, D, WSP(unsigned char, WS_WIN + l * SZ_WIN), r, NB_IN, lane); continue; } r -= 2 * I_WIN;
        if (r < 4 * I_W1) { const int q = r / I_W1; r -= q * I_W1; const int l = q >> 1, kv = q & 1;
            tr_item(0, 0, INP(kv ? IN_WV1 : IN_WK1) + (size_t)l * 4096 * 256, 256, 256, nullptr, 4096, WSP(bf16_t, WS_W1 + q * SZ_W1), r, 256 / 32, lane); continue; } r -= 4 * I_W1;
        if (r < 4 * I_W2) { const int q = r / I_W2; r -= q * I_W2; const int l = q >> 1, kv = q & 1;
            tr_item(0, 0, INP(kv ? IN_WV2 : IN_WK2) + (size_t)l * 256 * 128, 128, 128, nullptr, 256, WSP(bf16_t, WS_W2 + q * SZ_W2), r, 128 / 32, lane); continue; } r -= 4 * I_W2;
        if (r < 4 * I_WUP) { const int q = r / I_WUP; r -= q * I_WUP; const int l = q >> 1, ab = q & 1;
            tr_item8(0, 0, INP(ab ? IN_WUPB : IN_WUPA) + (size_t)l * 1024 * D, D, D, nullptr, WUP8_SCALE, 1024, WSP(unsigned char, WS_WUP + q * SZ_WUP), r, D / 32, lane); continue; } r -= 4 * I_WUP;
        { const int l = r / I_WO; r -= l * I_WO;
            tr_item8(0, 0, INP(IN_WO) + (size_t)l * D * D, D, D, nullptr, WO8_SCALE, D, WSP(unsigned char, WS_WO + l * SZ_WO), r, D / 32, lane); }
    }
    { const int gt = gw * 64 + lane, NGT = NGW * 64; const u32x4 z = {0u, 0u, 0u, 0u};
      for (int i = gt; i < 2 * (NIN - IN_DIM) * (D / 16); i += NGT) { const int l = i / ((NIN - IN_DIM) * (D / 16)), j = i - l * ((NIN - IN_DIM) * (D / 16)); *((u32x4*)(WSP(unsigned char, WS_WIN + l * SZ_WIN) + (size_t)IN_DIM * D) + j) = z; }
      for (int i = gt; i < 4 * 128 * (256 / 8); i += NGT) { const int q = i / (128 * 32), j = i - q * (128 * 32); *((u32x4*)(WSP(bf16_t, WS_W2 + q * SZ_W2) + (size_t)128 * 256) + j) = z; } }
    { const float* x = INP(IN_X); unsigned char* x8 = WSP(unsigned char, WS_X8); u64* rsq = WSP(u64, WS_RSQ);
      for (int m = gw; m < M; m += NGW) { const f32x4* xr = (const f32x4*)(x + (size_t)m * D) + lane; f32x4 v[8]; float s = 0.f;
#pragma unroll
          for (int j = 0; j < 8; ++j) { v[j] = xr[64 * j]; s += (v[j][0] * v[j][0] + v[j][1] * v[j][1]) + (v[j][2] * v[j][2] + v[j][3] * v[j][3]); }
          s = wave_sum(s); if (lane == 0) rsq[m] = (u64)(s * RSQ_SCALE + 0.5f);
          unsigned* o4 = (unsigned*)(x8 + (size_t)m * D) + lane;
#pragma unroll
          for (int j = 0; j < 8; ++j) o4[64 * j] = cvt4_fp8(v[j][0], v[j][1], v[j][2], v[j][3]); } }
    { float* cosT = WSP(float, WS_ROPE); float* sinT = cosT + T * 64; const int gt = gw * 64 + lane, NGT = NGW * 64;
      for (int i = gt; i < T * 64; i += NGT) { const int t = i >> 6, d = i & 63; const float inv = (float)exp(-9.210340371976184 * (double)d / 64.0); const float ang = (float)t * inv;
          cosT[i] = (float)cos((double)ang); sinT[i] = (float)sin((double)ang); } }
}

__device__ __forceinline__ void p_attn_a(Frame F, int layer) {
    launder(F);
    bf16_t* QKV = BGP(bf16_t, BG_QKV); const bf16_t* NGb = BGP(bf16_t, BG_NG);
#ifndef NO_CMP
    if (blockIdx.x < 16) {
        const int kv = blockIdx.x >> 3, pm = blockIdx.x & 7, q = layer * 2 + kv;
        bf16_t* H = BGP(bf16_t, BG_HC) + (size_t)kv * 2048 * 256;
        { pg8::SchedOne S{BGP(bf16_t, kv ? BG_VCB : BG_KCB), WSP(bf16_t, WS_W1 + q * SZ_W1), 2048 * 2, 4096 * 2, pm, 0};
          pg8::EpiCmp1 E{H, WSP(long long, WS_CBIAS) + q * 256};
          pg8::gemm_phase<false>(F.lds, 4096 * 2, S, E); }
        VM_WAIT(); __syncthreads(); __builtin_amdgcn_fence(__ATOMIC_ACQUIRE, "agent"); VM_WAIT(); __syncthreads();
        { pg8::SchedOne S{H, WSP(bf16_t, WS_W2 + q * SZ_W2), 256 * 2, 256 * 2, pm, 0};
          pg8::EpiCmp2 E{BGP(bf16_t, kv ? BG_VCMP : BG_KCMP)};
          pg8::gemm_phase<false>(F.lds, 256 * 2, S, E); }
        __syncthreads();
    }
#endif
    const att::Ctx c = att::make_ctx(F.lds);
    const float* sinks = INP(IN_SINK) + layer * 8;
    const int nstat = (int)F.G - 16; bool first = blockIdx.x >= 16;
    for (;;) {
        int u = first ? (int)blockIdx.x - 16 : nstat + queue_pop(F, layer * 2 + 0); first = false; if (u >= 1024 + 64) break;
        if (u < 64) {
            pg8::SchedOne S{WSP(unsigned char, WS_X8), WSP(unsigned char, WS_WIN + layer * SZ_WIN), D, D, u, 32};
            pg8::EpiIn E{BGP(bf16_t, BG_QKV), BGP(bf16_t, BG_KCB), BGP(bf16_t, BG_VCB), BGP(bf16_t, BG_GM), BGP(bf16_t, BG_NG), WSP(u64, WS_RSQ) + (2 * layer) * M, WSP(float, WS_ROPE), WSP(float, WS_ROPE) + T * 64, 1.0f / WIN8_SCALE, F.lds + LDS_WSCR};
            pg8::gemm_phase<true>(F.lds, D, S, E); __syncthreads(); continue; }
        u -= 64;
        const bool swa = u >= 512; const int v = u & 511, qt = 63 - (v >> 3), bg = v & 7, b = bg >> 1, g = bg & 1;
        const int t0 = qt * 64, h = 4 * g + (c.wid >> 1), trow = t0 + 32 * (c.wid & 1);
        const size_t rowbase = (size_t)b * T;
        const int qcol = (swa ? 0 : 1536) + h * HD, kcol = (swa ? 1024 : 3584) + g * HD, vcol = (swa ? 1280 : 3840) + g * HD, W = swa ? 128 : 512;
        bf16x8 qr[8]; att::load_q(qr, QKV + (rowbase + trow + c.r32) * 4096 + qcol, c.hi);
        const int j_lo = (t0 - W + 1) > 0 ? (t0 - W + 1) / 64 : 0, NT = qt - j_lo + 1;
        f32x16 o[4] = {}; float m_reg = -1e30f, l_reg = 0.f;
        att::attn_loop<0>(c, QKV + rowbase * 4096 + kcol, 4096, QKV + rowbase * 4096 + vcol, 4096, j_lo, NT, qr, trow + c.r32, trow, W, 0u, 0u, -1, o, m_reg, l_reg);
        float f;
        if (swa) { const float lt = l_reg + __builtin_amdgcn_exp2f(sinks[h] * att::LOG2E - m_reg * att::C2); f = 1.0f / lt; }
        else f = 1.0f / l_reg;
        if (swa) att::store_o<false, true>(o, f, c, nullptr, 1024, 1.0f, false, BGP(unsigned char, BG_OA) + (rowbase + trow) * 1024 + h * HD);
        else att::store_o<false>(o, f, c, BGP(bf16_t, BG_OB) + (rowbase + trow) * 1024 + h * HD, 1024);
    }
}

__device__ __forceinline__ void p_attn_b(Frame F, int layer) {
    launder(F);
    const bf16_t* QKV = BGP(bf16_t, BG_QKV); const bf16_t* NGb = BGP(bf16_t, BG_NG);
    const att::Ctx c = att::make_ctx(F.lds);
    LAS unsigned* IMP = (LAS unsigned*)(F.lds + LDS_IMP);
    volatile LAS unsigned* SELM = (volatile LAS unsigned*)(F.lds + LDS_SELM);
    bool first = true;
    for (;;) {
        const int u = first ? (int)blockIdx.x : (int)F.G + queue_pop(F, layer * 2 + 1); first = false; if (u >= 512) break;
        const int qt = 63 - (u >> 3), bg = u & 7, b = bg >> 1, g = bg & 1;
        const int t0 = qt * 64, h = 4 * g + (c.wid >> 1), trow = t0 + 32 * (c.wid & 1), tl = 32 * (c.wid & 1) + c.r32;
        const size_t rowbase = (size_t)b * T; const int pos = trow + c.r32;
        for (int i = c.tid; i < 64 * 65; i += NTHREADS) IMP[i] = 0u;
        bf16x8 qr[8]; att::load_q(qr, QKV + (rowbase + pos) * 4096 + 1536 + h * HD, c.hi);
        const int maxc = (t0 + 63 - 31) >> 4, NTc = (maxc >> 6) + 1;
        const bf16_t* Kc = BGP(bf16_t, BG_KCMP) + (size_t)bg * 256 * HD; const bf16_t* Vc = BGP(bf16_t, BG_VCMP) + (size_t)bg * 256 * HD;
        { const att::Dma dc = att::make_dma(c, HD, HD); for (int j = 0; j < NTc; ++j) att::dma_tile(c, dc, Kc, HD, Vc, HD, j * 64, j); }
        VM_WAIT(); __syncthreads();
        const int cpos = (pos - 31) >> 4;
        float m_reg = -1e30f, l_reg = 0.f;
        {
            f32x16 p0, p1; float alpha;
#pragma unroll 1
            for (int J = 0; J < NTc; ++J) { att::qkt(p0, p1, c.K_lds + J * att::TILE_B, c.r32, c.hi, qr); att::mask_tile(p0, p1, cpos - J * 64 - 4 * c.hi, 0x40000000u); att::softmax_step(p0, p1, m_reg, l_reg, alpha); }
        }
        f32x16 o[4] = {};
        {
            const float inv_l = l_reg > 0.f ? 1.0f / l_reg : 0.f, mnL = -m_reg * att::C2; f32x16 p0, p1; bf16x8 pa0, pa1, pa2, pa3;
#pragma unroll 1
            for (int J = 0; J < NTc; ++J) { att::qkt(p0, p1, c.K_lds + J * att::TILE_B, c.r32, c.hi, qr); att::mask_tile(p0, p1, cpos - J * 64 - 4 * c.hi, 0x40000000u);
#pragma unroll
                for (int r = 0; r < 16; ++r) { p0[r] = __builtin_amdgcn_exp2f(fmaf(p0[r], att::C2, mnL)) * inv_l; p1[r] = __builtin_amdgcn_exp2f(fmaf(p1[r], att::C2, mnL)) * inv_l; }
                LAS unsigned* irow = IMP + tl * 65 + J * 16 + c.hi; constexpr float IS = 67108864.0f;
#pragma unroll
                for (int jj = 0; jj < 4; ++jj) {
                    atomicAdd((unsigned*)(irow + 2 * jj), (unsigned)((p0[4 * jj] + p0[4 * jj + 1] + p0[4 * jj + 2] + 0.5f * p0[4 * jj + 3]) * IS + 0.5f)); atomicAdd((unsigned*)(irow + 2 * jj + 1), (unsigned)(0.5f * p0[4 * jj + 3] * IS + 0.5f));
                    atomicAdd((unsigned*)(irow + 2 * jj + 8), (unsigned)((p1[4 * jj] + p1[4 * jj + 1] + p1[4 * jj + 2] + 0.5f * p1[4 * jj + 3]) * IS + 0.5f)); atomicAdd((unsigned*)(irow + 2 * jj + 9), (unsigned)(0.5f * p1[4 * jj + 3] * IS + 0.5f)); }
                att::pack_p(p0, p1, pa0, pa1, pa2, pa3); att::pv_tile(o, c.vb0 + J * att::TILE_B, pa0, pa1, pa2, pa3); }
        }
        bf16_t* Og = BGP(bf16_t, BG_OB) + (rowbase + trow) * 1024 + h * HD;
        __syncthreads();
        { const float g0 = bf2f(NGb[(rowbase + pos) * 32 + h * 3 + 0]), g2 = bf2f(NGb[(rowbase + pos) * 32 + h * 3 + 2]); att::store_o<true>(o, g0, c, Og, 1024, g2, true); }
        for (int i = 0; i < 8; ++i) { const int tk = c.wid * 8 + i, s = c.lane; volatile LAS unsigned* row = (volatile LAS unsigned*)IMP + tk * 65;
            const unsigned raw = row[s]; const bool forced = (s == 0) | (s == qt) | (s == qt - 1), valid = s <= qt;
            unsigned key = ((((raw >> 6) + 1u) << 6) | (unsigned)(63 - s)); key = forced ? (0xFFFFFFC0u | (unsigned)(63 - s)) : key; key = valid ? key : 0u;
            row[s] = key; LDS_WAIT();
            int rank = 0;
#pragma unroll 16
            for (int j = 0; j < 64; ++j) rank += (row[j] > key) ? 1 : 0;
            const unsigned long long bal = __ballot(rank < 16 && key != 0u);
            if (c.lane == 0) { SELM[2 * tk] = (unsigned)bal; SELM[2 * tk + 1] = (unsigned)(bal >> 32); } }
        __syncthreads();
        const unsigned sel_lo = SELM[2 * tl], sel_hi = SELM[2 * tl + 1];
#pragma unroll
        for (int d = 0; d < 4; ++d) o[d] = f32x16{};
        m_reg = -1e30f; l_reg = 0.f;
        att::attn_loop_simple<2>(c, QKV + rowbase * 4096 + 3072 + g * HD, 4096, QKV + rowbase * 4096 + 3328 + g * HD, 4096, 0, qt + 1, qr, pos, trow, 0, sel_lo, sel_hi, qt, o, m_reg, l_reg);
        { const float g1 = bf2f(NGb[(rowbase + pos) * 32 + h * 3 + 1]); VM_WAIT(); att::store_o<true, true>(o, g1 / l_reg, c, Og, 1024, 1.0f, false, BGP(unsigned char, BG_OA) + (size_t)M * 1024 + (rowbase + trow) * 1024 + h * HD); }
    }
}

__device__ __forceinline__ void p_router(Frame F) {
    launder(F);
    LAS float* wr = (LAS float*)F.lds;
    const float* rw = INP(IN_RW); const float* gain = INP(IN_FNORM) + D;
    for (int i = F.tid; i < D * 8; i += NTHREADS) wr[i] = rw[i] * gain[i >> 3];
    LAS int* te = (LAS int*)(F.lds + 65536); LAS float* tw = (LAS float*)(F.lds + 65536 + 1024);
    const bf16_t* XB = WSP(bf16_t, WS_XBF); const u64* rsq = WSP(u64, WS_RSQ) + 3 * M;
    int* ltok = WSP(int, WS_LTOK); float* lw = WSP(float, WS_LW); int* slot = WSP(int, WS_SLOT);
    for (int chunk = blockIdx.x; chunk < M / 64; chunk += F.G) {
        __syncthreads();
        for (int i = 0; i < 8; ++i) { const int tl = F.wave * 8 + i, tok = chunk * 64 + tl;
            const u32x2* xr = (const u32x2*)(XB + (size_t)tok * D) + F.lane; float a[8] = {0.f, 0.f, 0.f, 0.f, 0.f, 0.f, 0.f, 0.f};
#pragma unroll
            for (int j = 0; j < 8; ++j) { const u32x2 xw = xr[64 * j]; const f32x4 x = {bf_lo(xw.x), bf_hi(xw.x), bf_lo(xw.y), bf_hi(xw.y)}; const int k = 4 * (F.lane + 64 * j);
#pragma unroll
                for (int q = 0; q < 4; ++q) { const f32x4 w0 = *(const LAS f32x4*)(wr + (k + q) * 8), w1 = *(const LAS f32x4*)(wr + (k + q) * 8 + 4);
                    a[0] = fmaf(x[q], w0[0], a[0]); a[1] = fmaf(x[q], w0[1], a[1]); a[2] = fmaf(x[q], w0[2], a[2]); a[3] = fmaf(x[q], w0[3], a[3]);
                    a[4] = fmaf(x[q], w1[0], a[4]); a[5] = fmaf(x[q], w1[1], a[5]); a[6] = fmaf(x[q], w1[2], a[6]); a[7] = fmaf(x[q], w1[3], a[7]); } }
            const float rstd = rstd_of(rsq, tok);
#pragma unroll
            for (int e = 0; e < 8; ++e) a[e] = wave_sum(a[e]) * rstd;
            int e1 = 0; float l1 = a[0];
#pragma unroll
            for (int e = 1; e < 8; ++e) if (a[e] > l1) { l1 = a[e]; e1 = e; }
            int e2 = -1; float l2 = -3.0e38f;
#pragma unroll
            for (int e = 0; e < 8; ++e) if (e != e1 && a[e] > l2) { l2 = a[e]; e2 = e; }
            const float ex = __expf(l2 - l1), w1 = 1.0f / (1.0f + ex), w2 = ex * w1;
            if (F.lane == 0) { te[tl] = e1; te[64 + tl] = e2; tw[tl] = w1; tw[64 + tl] = w2; } }
        __syncthreads();
        if (F.wave == 0) { const int tl = F.lane, tok = chunk * 64 + tl, e1 = te[tl], e2 = te[64 + tl]; const float w1 = tw[tl], w2 = tw[64 + tl];
            const unsigned long long lt = (1ull << tl) - 1ull;
            int myn = 0;
#pragma unroll
            for (int e = 0; e < 8; ++e) { const int n = __popcll(__ballot(e1 == e)) + __popcll(__ballot(e2 == e)); if (tl == e) myn = n; }
            int mybase = 0; if (tl < 8 && myn > 0) mybase = (int)__hip_atomic_fetch_add(F.ctl + CW_ECNT + 64 * tl, (unsigned)myn, RLX_AGENT);
#pragma unroll
            for (int e = 0; e < 8; ++e) { const unsigned long long m1 = __ballot(e1 == e), m2 = __ballot(e2 == e); const int n1 = __popcll(m1);
                const int base = __shfl(mybase, e);
                if (e1 == e) { const int p = base + __popcll(m1 & lt); ltok[e * M + p] = tok; lw[e * M + p] = w1; slot[2 * tok] = (e << 20) | p; }
                if (e2 == e) { const int p = base + n1 + __popcll(m2 & lt); ltok[e * M + p] = tok; lw[e * M + p] = w2; slot[2 * tok + 1] = (e << 20) | p; } } }
    }
}
__device__ __forceinline__ void moe_counts(Frame& F) {
    __syncthreads();
    if (F.tid < 64) {
        int cnt = 0; if (F.tid < NE) cnt = (int)__hip_atomic_load(F.ctl + CW_ECNT + 64 * F.tid, RLX_AGENT);
        const int tiles = (cnt + 255) >> 8; int incl = tiles;
#pragma unroll
        for (int d = 1; d < 8; d <<= 1) { const int t = __shfl_up(incl, d); if (F.tid >= d) incl += t; }
        if (F.tid < NE) { F.misc[8 + F.tid] = (unsigned)cnt; F.misc[16 + F.tid] = (unsigned)(incl - tiles); }
        const int acc = __shfl(incl, NE - 1);
        if (F.tid == 0) { F.misc[24] = (unsigned)acc;
            int per_round = F.G / (D / 256); asm volatile("" : "+v"(per_round));
            const int tm = (acc / per_round) * per_round, tu = (acc - tm) * (D / 256);
            F.misc[25] = (unsigned)tm; F.misc[26] = (tu > 0 && tu * 4 <= F.G) ? 4u : ((tu > 0 && tu * 2 <= F.G) ? 2u : 1u); } }
    __syncthreads();
}
__device__ __forceinline__ void p_final(Frame F) {
    launder(F);
    moe_counts(F);
    const int gw = F.vcu * NWAVES + F.wave, NGW = F.G * NWAVES, lane = F.lane;
    const bf16_t* XB = WSP(bf16_t, WS_XBF); const bf16_t* YS = WSP(bf16_t, WS_YS); const int* slot = WSP(int, WS_SLOT); const float* gf = INP(IN_FINAL);
    const int Tm = (int)F.misc[25], S = (int)F.misc[26]; const bf16_t* YT = BGP(bf16_t, BG_YT);
    for (int m = gw; m < M; m += NGW) {
        const int s0 = slot[2 * m], s1 = slot[2 * m + 1];
        const size_t r0 = (size_t)F.misc[16 + (s0 >> 20)] * 256 + (s0 & 0xfffff), r1 = (size_t)F.misc[16 + (s1 >> 20)] * 256 + (s1 & 0xfffff);
        const u32x2* xr = (const u32x2*)(XB + (size_t)m * D) + lane;
        f32x4 v[8];
#pragma unroll
        for (int j = 0; j < 8; ++j) { const u32x2 a = xr[64 * j]; v[j] = f32x4{bf_lo(a.x), bf_hi(a.x), bf_lo(a.y), bf_hi(a.y)}; }
#pragma unroll
        for (int q = 0; q < 2; ++q) { const size_t r = q ? r1 : r0; const bool tail = (int)(r >> 8) >= Tm;
            const bf16_t* base = tail ? YT + (r - (size_t)Tm * 256) * D : YS + r * D; const int nrep = tail ? S : 1;
            for (int k = 0; k < nrep; ++k) { const u32x2* y = (const u32x2*)(base + (size_t)k * YT_ROWS * D) + lane;
#pragma unroll
                for (int j = 0; j < 8; ++j) { const u32x2 a = y[64 * j]; v[j][0] += bf_lo(a.x); v[j][1] += bf_hi(a.x); v[j][2] += bf_lo(a.y); v[j][3] += bf_hi(a.y); } } }
        float s = 0.f;
#pragma unroll
        for (int j = 0; j < 8; ++j) s += (v[j][0] * v[j][0] + v[j][1] * v[j][1]) + (v[j][2] * v[j][2] + v[j][3] * v[j][3]);
        const float rstd = rsqrtf(wave_sum(s) * (1.0f / D) + NORM_EPS);
        f32x4* o = (f32x4*)(F.out + (size_t)m * D) + lane; const f32x4* gp = (const f32x4*)gf + lane;
#pragma unroll
        for (int j = 0; j < 8; ++j) o[64 * j] = v[j] * rstd * gp[64 * j];
    }
}

#ifndef MK_SPLIT
#define MK_SPLIT 0
#endif
constexpr int NPHASE = 17;
struct Args { const float* in[22]; float* out; unsigned char* ws; int ph_lo, ph_hi, li, pad; };
__global__ void __launch_bounds__(NTHREADS, 2) mega_fwd(Args args) {
    extern __shared__ __attribute__((aligned(16))) unsigned char lds_raw[];
    Frame F0;
    F0.lds = (LAS unsigned char*)lds_raw; F0.misc = (volatile LAS unsigned*)(F0.lds + LDS_MISC);
    F0.tid = threadIdx.x; F0.lane = F0.tid & 63; F0.wave = __builtin_amdgcn_readfirstlane(F0.tid >> 6);
    F0.G = gridDim.x; { const int bx = blockIdx.x; F0.vcu = (F0.G % 8 == 0) ? (bx % 8) * (F0.G / 8) + bx / 8 : bx; }
    F0.in = args.in;
    F0.out = args.out; F0.ws = args.ws; F0.ctl = (unsigned*)(args.ws + WS_CTL);
    if (F0.tid < 64) F0.misc[F0.tid] = 0u;
    __syncthreads();
    XcdBarrier bar = xcd_barrier_post(F0.ctl + CW_BAR + args.li * XCD_BAR_WORDS, F0.misc);
    const int lo = args.ph_lo, hi = args.ph_hi;
#ifndef PHMASK
#define PHMASK 0x1ffff
#endif
#define IN(k) (((PHMASK >> ((k) > 7 && (k) < 13 ? (k) - 7 : (k))) & 1) && lo <= (k) && (k) < hi)
#define SEAM(k) do { if (IN(k) && IN((k) + 1)) { XcdBarrier b2 = bar; asm volatile("" : "+s"(b2.bar)); xcd_barrier(b2); } } while (0)

    if (IN(0)) p_prologue(F0);
    SEAM(0);
    for (int layer = 0; layer < 2; ++layer) {
        const int pb = 1 + 7 * layer;
        if (IN(pb)) { Frame F = F0; launder(F); u64* rsq = WSP(u64, WS_RSQ);
            pg8::SchedDense S{WSP(unsigned char, WS_X8), WSP(unsigned char, WS_WIN + layer * SZ_WIN), D, D, M / 256, 32, F.G, (int)blockIdx.x};
            pg8::EpiIn E{BGP(bf16_t, BG_QKV), BGP(bf16_t, BG_KCB), BGP(bf16_t, BG_VCB), BGP(bf16_t, BG_GM), BGP(bf16_t, BG_NG), rsq + (2 * layer) * M, WSP(float, WS_ROPE), WSP(float, WS_ROPE) + T * 64, 1.0f / WIN8_SCALE, F.lds + LDS_WSCR};
            pg8::gemm_phase<true>(F.lds, D, S, E);
        }
        SEAM(pb);
        if (IN(pb + 1)) p_attn_a(F0, layer);
        SEAM(pb + 1);
        if (IN(pb + 2)) p_attn_b(F0, layer);
        SEAM(pb + 2);
        if (IN(pb + 3)) { Frame F = F0; launder(F);
            pg8::SchedSeg2 S{BGP(unsigned char, BG_OA), WSP(unsigned char, WS_WUP + (2 * layer) * SZ_WUP), BGP(unsigned char, BG_OA) + (size_t)M * 1024, WSP(unsigned char, WS_WUP + (2 * layer + 1) * SZ_WUP), 1024, M / 256, D / 256, F.G, (int)blockIdx.x};
            pg8::EpiMerge E{BGP(bf16_t, BG_GM), BGP(unsigned char, BG_Z), Z8_SCALE / (O8_SCALE * WUP8_SCALE)};
            pg8::gemm_phase<true>(F.lds, 1024, S, E);
        }
        SEAM(pb + 3);
        if (IN(pb + 4)) { Frame F = F0; launder(F); u64* rsq = WSP(u64, WS_RSQ);
            pg8::SchedDense S{BGP(unsigned char, BG_Z), WSP(unsigned char, WS_WO + layer * SZ_WO), D, D, M / 256, D / 256, F.G, (int)blockIdx.x};
            pg8::EpiResid E{layer == 0 ? (const void*)INP(IN_X) : (const void*)WSP(bf16_t, WS_XBF), layer != 0, WSP(bf16_t, WS_XBF), rsq + (2 * layer + 1) * M, layer == 1 ? WSP(unsigned char, WS_X8) : nullptr, 1.0f / (Z8_SCALE * WO8_SCALE)};
            pg8::gemm_phase<true>(F.lds, D, S, E);
        }
        SEAM(pb + 4);
        if (layer == 0) {
            if (IN(pb + 5)) { Frame F = F0; launder(F); u64* rsq = WSP(u64, WS_RSQ);
                pg8::SchedDense S{WSP(bf16_t, WS_XBF), WSP(bf16_t, WS_WGUD), D * 2, D * 2, M / 256, 2 * FF / 256, F.G, (int)blockIdx.x};
                pg8::EpiGateUp<false, true, false> E{BGP(bf16_t, 0), rsq + 1 * M, nullptr, F.misc};
                pg8::gemm_phase<false>(F.lds, D * 2, S, E);
            }
            SEAM(pb + 5);
            if (IN(pb + 6)) { Frame F = F0; launder(F); u64* rsq = WSP(u64, WS_RSQ);
                pg8::SchedDense S{BGP(unsigned char, 0), WSP(unsigned char, WS_WDD), FF, FF, M / 256, D / 256, F.G, (int)blockIdx.x};
                pg8::EpiResid E{WSP(bf16_t, WS_XBF), 1, WSP(bf16_t, WS_XBF), rsq + 2 * M, WSP(unsigned char, WS_X8), 1.0f / WD8_SCALE};
                pg8::gemm_phase<true>(F.lds, FF, S, E);
            }
            SEAM(pb + 6);
        } else {
            if (IN(pb + 5)) p_router(F0);
            SEAM(pb + 5);
            if (IN(pb + 6)) { Frame F = F0; launder(F); u64* rsq = WSP(u64, WS_RSQ);
                moe_counts(F);
                pg8::SchedMoE<true> S{WSP(unsigned char, WS_X8), WSP(unsigned char, WS_WGUM), WSP(int, WS_LTOK), D, D, 2 * FF / 256, F.G, (int)blockIdx.x, SZ_WGU8, F.misc, 24};
                pg8::EpiGateUp<true> E{BGP(bf16_t, 0), rsq + 3 * M, WSP(int, WS_LTOK), F.misc};
                pg8::gemm_phase<true>(F.lds, D, S, E);
            }
            SEAM(pb + 6);
            if (IN(pb + 7)) { Frame F = F0; launder(F);
                moe_counts(F);
                pg8::SchedMoE<false> S{BGP(unsigned char, 0), WSP(unsigned char, WS_WDM), nullptr, FF, FF, D / 256, F.G, (int)blockIdx.x, SZ_WD8, F.misc, 25};
                pg8::EpiMoeDown E{WSP(bf16_t, WS_YS), WSP(float, WS_LW), F.misc};
                pg8::gemm_phase<true>(F.lds, FF, S, E);
                { const int kpart = FF / (int)F.misc[26];
                  pg8::SchedMoETail St{BGP(unsigned char, 0), WSP(unsigned char, WS_WDM), FF, FF, D / 256, (int)blockIdx.x, kpart, SZ_WD8, F.misc};
                  pg8::EpiMoeDownTail Et{BGP(bf16_t, BG_YT), WSP(float, WS_LW), F.misc};
                  pg8::gemm_phase<true>(F.lds, kpart, St, Et); }
            }
            SEAM(pb + 7);
        }
    }
    if (IN(16)) p_final(F0);
#undef IN
#undef SEAM
}

extern "C" void kernel_launch(void* const* d_in, const int* in_sizes, int n_in, void* d_out, int out_size, void* d_ws, size_t ws_size, hipStream_t stream) {
    static int grid = 0;
    if (grid == 0) {
        if (n_in != 22 || in_sizes[0] != M * D || out_size != M * D || ws_size < WS_END) { fprintf(stderr, "kernel_launch: unexpected shapes (n_in %d, in0 %d, out %d, ws %zu < %zu); nothing launched\n", n_in, n_in > 0 ? in_sizes[0] : -1, out_size, ws_size, (size_t)WS_END); grid = -1; return; }
        int dev = 0, cus = 0, per_cu = 0;
        if (hipGetDevice(&dev) != hipSuccess || hipDeviceGetAttribute(&cus, hipDeviceAttributeMultiprocessorCount, dev) != hipSuccess) { grid = -1; return; }
        if (hipFuncSetAttribute((const void*)mega_fwd, hipFuncAttributeMaxDynamicSharedMemorySize, LDS_BYTES) != hipSuccess) { fprintf(stderr, "kernel_launch: hipFuncSetAttribute failed\n"); grid = -1; return; }
        if (hipOccupancyMaxActiveBlocksPerMultiprocessor(&per_cu, (const void*)mega_fwd, NTHREADS, LDS_BYTES) != hipSuccess || per_cu < 1) fprintf(stderr, "kernel_launch: occupancy query reports %d\n", per_cu);
        (void)hipGetLastError();
        grid = cus;
    }
    if (grid < 0) return;
    (void)hipMemsetAsync((char*)d_ws + WS_CTL, 0, CTL_ZERO_BYTES, stream);
    Args a{};
    for (int i = 0; i < 22; ++i) a.in[i] = (const float*)d_in[i];
    a.out = (float*)d_out; a.ws = (unsigned char*)d_ws; a.pad = 0;
#if MK_SPLIT
    for (int p = 0; p < NPHASE; ++p) { a.ph_lo = p; a.ph_hi = p + 1; a.li = p; hipLaunchKernelGGL(mega_fwd, dim3(grid), dim3(NTHREADS), LDS_BYTES, stream, a); }
#else
    a.ph_lo = 0; a.ph_hi = NPHASE; a.li = 0;
    hipLaunchKernelGGL(mega_fwd, dim3(grid), dim3(NTHREADS), LDS_BYTES, stream, a);
#endif
}
```

```cpp
#include <hip/hip_runtime.h>
#include <cstdio>
#include <cstdint>

#define LAS __attribute__((address_space(3)))
#define GAS __attribute__((address_space(1)))
typedef unsigned short bf16_t;
typedef short bf16x8 __attribute__((ext_vector_type(8)));
typedef short s16x4 __attribute__((ext_vector_type(4)));
typedef float f32x4 __attribute__((ext_vector_type(4)));
typedef float f32x2 __attribute__((ext_vector_type(2)));
typedef float f32x16 __attribute__((ext_vector_type(16)));
typedef unsigned u32x4 __attribute__((ext_vector_type(4)));
typedef unsigned u32x2 __attribute__((ext_vector_type(2)));

constexpr int NB = 4, T = 4096, D = 2048, M = NB * T, HD = 128, FF = 7168, NE = 8;
constexpr int IN_DIM = 8216, NIN = 8448;
constexpr int NCMP = 255, CMPH = 256;
constexpr float NORM_EPS = 1e-6f;
constexpr int MAXSLOT = 34816;
constexpr int YT_ROWS = 31 * 256;

constexpr size_t MiB = 1u << 20;
constexpr size_t WS_CTL = 0, CTL_ZERO_BYTES = 2 * MiB;
constexpr int CW_TMO = 0, CW_QUEUE = 1024, CW_ECNT = 2048, CW_BAR = 4096;
constexpr size_t WS_RSQ = 1 * MiB;
constexpr size_t WS_ROPE = 2 * MiB;
constexpr size_t WS_MISC = 4 * MiB;
constexpr size_t WS_CBIAS = 512 * 1024;
constexpr float CB_SCALE = 1099511627776.0f;
constexpr size_t WS_LTOK = WS_MISC + 64 * 1024;
constexpr size_t WS_LW = WS_LTOK + (size_t)NE * M * 4;
constexpr size_t WS_SLOT = WS_LW + (size_t)NE * M * 4;
constexpr size_t WS_W = 6 * MiB;
constexpr size_t SZ_WIN = (size_t)NIN * D * 2, SZ_W1 = (size_t)CMPH * 4096 * 2, SZ_W2 = (size_t)256 * 256 * 2, SZ_WUP = (size_t)D * 1024 * 2, SZ_WO = (size_t)D * D * 2;
constexpr size_t SZ_WGU = (size_t)2 * FF * D * 2, SZ_WD = (size_t)D * FF * 2;
constexpr size_t SZ_WGU8 = (size_t)2 * FF * D, SZ_WD8 = (size_t)D * FF;
constexpr float WGU8_SCALE = 32.0f, WD8_SCALE = 64.0f, WIN8_SCALE = 32.0f, WUP8_SCALE = 32.0f, WO8_SCALE = 32.0f, O8_SCALE = 16.0f, Z8_SCALE = 16.0f;
constexpr size_t WS_WIN = WS_W;
constexpr size_t WS_W1 = WS_WIN + 2 * SZ_WIN;
constexpr size_t WS_W2 = WS_W1 + 4 * SZ_W1;
constexpr size_t WS_WUP = WS_W2 + 4 * SZ_W2;
constexpr size_t WS_WO = WS_WUP + 4 * SZ_WUP;
constexpr size_t WS_WGUD = WS_WO + 2 * SZ_WO;
constexpr size_t WS_WDD = WS_WGUD + SZ_WGU;
constexpr size_t WS_WGUM = WS_WDD + SZ_WD;
constexpr size_t WS_WDM = WS_WGUM + 8 * SZ_WGU8;
constexpr size_t WS_X8 = WS_WDM + 8 * SZ_WD8;
constexpr size_t WS_XR = WS_X8 + (size_t)M * D;
constexpr size_t WS_XBF = WS_XR + (size_t)M * D * 4;
constexpr size_t WS_YS = WS_XBF + (size_t)M * D * 2;
constexpr size_t WS_BIG = WS_YS + (size_t)MAXSLOT * D * 2;
constexpr size_t SZ_BIG = (size_t)MAXSLOT * FF * 2;
constexpr size_t WS_END = WS_BIG + SZ_BIG;
constexpr size_t BG_QKV = 0;
constexpr size_t BG_GM = BG_QKV + (size_t)M * 4096 * 2;
constexpr size_t BG_NG = BG_GM + (size_t)M * 4096 * 2;
constexpr size_t BG_KCB = BG_NG + (size_t)M * 32 * 2;
constexpr size_t BG_VCB = BG_KCB + (size_t)M * 256 * 2 + 65536;
constexpr size_t BG_HC = BG_VCB + (size_t)M * 256 * 2 + 65536;
constexpr size_t BG_KCMP = BG_HC + (size_t)2 * 2048 * 256 * 2;
constexpr size_t BG_VCMP = BG_KCMP + (size_t)8 * 256 * 128 * 2;
constexpr size_t BG_OA = BG_VCMP + (size_t)8 * 256 * 128 * 2;
constexpr size_t BG_OB = BG_OA + (size_t)M * 1024 * 2;
constexpr size_t BG_Z = BG_OB + (size_t)M * 1024 * 2;
constexpr size_t BG_END = BG_Z + (size_t)M * D * 2;
static_assert(BG_END <= SZ_BIG, "attention-phase tensors fit the aliased region");
constexpr size_t BG_YT = 256 * MiB;
static_assert((size_t)MAXSLOT * FF <= BG_YT && BG_YT + (size_t)4 * YT_ROWS * D * 2 <= SZ_BIG, "tail partials fit");
static_assert(WS_SLOT + (size_t)M * 8 <= WS_W, "misc region");

constexpr int LDS_K = 0, LDS_V = 65536, LDS_WSCR = 131072  , LDS_IMP = LDS_WSCR + 2048  , LDS_SELM = LDS_IMP + 64 * 65 * 4  ;
constexpr int LDS_MISC = LDS_SELM + 512;
constexpr int LDS_BYTES = LDS_MISC + 256;
static_assert(LDS_BYTES <= 163840, "LDS");
static_assert(LDS_WSCR + 32 * 528 <= LDS_MISC, "epilogue slab fits beside the GEMM buffers");
constexpr int NWAVES = 8, NTHREADS = 512;

#define RLX_AGENT __ATOMIC_RELAXED, __HIP_MEMORY_SCOPE_AGENT
#define LDS_WAIT() asm volatile("s_waitcnt lgkmcnt(0)" ::: "memory")
#define VM_WAIT() asm volatile("s_waitcnt vmcnt(0)" ::: "memory")

typedef __bf16 bf16x2_t __attribute__((ext_vector_type(2)));
__device__ __forceinline__ unsigned cvt_pk_bf16(float lo, float hi) { f32x2 v = {lo, hi}; bf16x2_t b = __builtin_convertvector(v, bf16x2_t); return __builtin_bit_cast(unsigned, b); }
__device__ __forceinline__ float bf_lo(unsigned w) { return __uint_as_float(w << 16); }
__device__ __forceinline__ float bf_hi(unsigned w) { return __uint_as_float(w & 0xffff0000u); }
__device__ __forceinline__ float bf2f(bf16_t b) { return __uint_as_float(((unsigned)b) << 16); }
__device__ __forceinline__ float fast_sigmoid(float x) { return __builtin_amdgcn_rcpf(1.0f + __builtin_amdgcn_exp2f(-1.4426950408889634f * x)); }
__device__ __forceinline__ f32x4 sigmoid4_scaled(const f32x4& x, float c1) { const f32x4 t = x * c1; f32x4 e, sg;
#pragma unroll
    for (int j = 0; j < 4; ++j) e[j] = __builtin_amdgcn_exp2f(t[j]);
    const f32x4 d = e + 1.0f;
#pragma unroll
    for (int j = 0; j < 4; ++j) sg[j] = __builtin_amdgcn_rcpf(d[j]);
    return sg; }
__device__ __forceinline__ int opaque_tid() { int t; asm volatile("v_mov_b32 %0, %1" : "=v"(t) : "v"((int)threadIdx.x)); return t; }
typedef unsigned long long u64;
typedef int v8i __attribute__((ext_vector_type(8)));
typedef int v4i __attribute__((ext_vector_type(4)));
__device__ __forceinline__ unsigned cvt4_fp8(float a, float b, float c, float d) { unsigned w = 0u; w = __builtin_amdgcn_cvt_pk_fp8_f32(a, b, w, false); w = __builtin_amdgcn_cvt_pk_fp8_f32(c, d, w, true); return w; }
constexpr float RSQ_SCALE = 1048576.0f;
__device__ __forceinline__ float rstd_of(const u64* rsq, int row) { return rsqrtf((float)rsq[row] * (1.0f / (RSQ_SCALE * D)) + NORM_EPS); }
__device__ __forceinline__ float wave_sum(float v) {
#pragma unroll
    for (int o = 1; o < 64; o <<= 1) v += __shfl_xor(v, o);
    return v;
}

#define XB_TMO      128
#define XB_XCNT(j)  (256  + 64 * (j))
#define XB_XSUB(j)  (1280 + 64 * (j))
#define XB_XGEN(j)  (2304 + 64 * (j))
#define XB_TOP      3328
#define XB_TOPGEN   3392
#define XCD_BAR_WORDS 3456
#define XB_SPIN_CAP (1u << 18)
__device__ __forceinline__ unsigned xb_ld(unsigned* p)              { return __hip_atomic_load(p, __ATOMIC_RELAXED, __HIP_MEMORY_SCOPE_AGENT); }
__device__ __forceinline__ unsigned xb_add(unsigned* p, unsigned v) { return __hip_atomic_fetch_add(p, v, __ATOMIC_RELAXED, __HIP_MEMORY_SCOPE_AGENT); }
__device__ __forceinline__ unsigned xb_xcc_id() { return (unsigned)__builtin_amdgcn_s_getreg((3 << 11) | 20) & 0xFu; }
#define XB_SPIN(cond, bar) do { unsigned _sp = 0; while (cond) { __builtin_amdgcn_s_sleep(1); \
    if ((++_sp & 255u) == 0u) { if (xb_ld(&(bar)[XB_TMO])) break; if (_sp > XB_SPIN_CAP) { atomicAdd(&(bar)[XB_TMO], 1u); break; } } } } while (0)
struct XcdBarrier { unsigned* bar; unsigned x; volatile LAS unsigned* st; };
__device__ __forceinline__ XcdBarrier xcd_barrier_post(unsigned* bar, volatile LAS unsigned* st) {
    XcdBarrier b; b.bar = bar; b.x = xb_xcc_id(); b.st = st;
    if (threadIdx.x == 0) (void)xb_add(&bar[XB_XCNT(b.x)], 1u);
    return b;
}
__device__ __forceinline__ void xcd_barrier_complete(unsigned* bar, unsigned x, unsigned& nloc, unsigned& nx) {
    const unsigned G = gridDim.x * gridDim.y * gridDim.z;
    unsigned sum, cnt, mine, sp = 0u;
    for (;;) {
        sum = 0u; cnt = 0u; mine = 0u;
#pragma unroll
        for (unsigned j = 0; j < 16; ++j) { const unsigned c = xb_ld(&bar[XB_XCNT(j)]); sum += c; cnt += (c > 0u) ? 1u : 0u; mine = (j == x) ? c : mine; }
        if (sum == G) break;
        __builtin_amdgcn_s_sleep(1);
        if ((++sp & 255u) == 0u) { if (xb_ld(&bar[XB_TMO])) break; if (sp > XB_SPIN_CAP) { atomicAdd(&bar[XB_TMO], 1u); break; } }
    }
    nloc = mine > 0u ? mine : 1u; nx = cnt > 0u ? cnt : 1u;
}
__device__ __forceinline__ void xcd_barrier(const XcdBarrier& b) {
    asm volatile("s_waitcnt vmcnt(0)" ::: "memory");
    __syncthreads();
    if (threadIdx.x == 0) {
        unsigned* bar = b.bar;
        __builtin_amdgcn_s_waitcnt(0);
        unsigned nloc = b.st[0], nx = b.st[1];
        if (nloc == 0u) { xcd_barrier_complete(bar, b.x, nloc, nx); b.st[0] = nloc; b.st[1] = nx; }
        const unsigned old = xb_add(&bar[XB_XSUB(b.x)], 1u);
        const unsigned gen = old / nloc;
        if (old + 1u == (gen + 1u) * nloc) {
            __builtin_amdgcn_fence(__ATOMIC_RELEASE, "agent");
            asm volatile("s_waitcnt vmcnt(0)" ::: "memory");
            const unsigned og = xb_add(&bar[XB_TOP], 1u);
            const unsigned tg = og / nx;
            if (og + 1u == (tg + 1u) * nx) xb_add(&bar[XB_TOPGEN], 1u);
            else XB_SPIN(xb_ld(&bar[XB_TOPGEN]) == tg, bar);
            __builtin_amdgcn_fence(__ATOMIC_ACQUIRE, "agent");
            xb_add(&bar[XB_XGEN(b.x)], 1u);
            asm volatile("s_waitcnt vmcnt(0)" ::: "memory");
        } else {
            XB_SPIN(xb_ld(&bar[XB_XGEN(b.x)]) == gen, bar);
            __builtin_amdgcn_fence(__ATOMIC_ACQUIRE, "agent");
            asm volatile("s_waitcnt vmcnt(0)" ::: "memory");
        }
    }
    __syncthreads();
}

namespace pg8 {
constexpr int BM = 256, BK = 64, HALF = 128, HTB = HALF * BK * 2, STAGE_BYTES = 8 * HTB, NXCD = 8, WGM = 4;
__host__ __device__ __forceinline__ int lds_byte(int r, int c) { const int st = (r >> 4) * 2 + (c >> 5), rr = r & 15, cc = c & 31, ob = rr * 64 + cc * 2; return st * 1024 + (ob ^ (((ob >> 9) & 1) << 5)); }
__host__ __device__ __forceinline__ void stage_rc(int b, int& R, int& C) { const int st = b / 1024, sb = b % 1024, swz = sb ^ (((sb >> 9) & 1) << 5); R = (st >> 1) * 16 + swz / 64; C = (st & 1) * 32 + (swz % 64) / 2; }
__host__ __device__ __forceinline__ int perm32(int rho) { const int n = rho >> 4, i = rho & 15; return 8 * (i >> 2) + 4 * n + (i & 3); }

struct Unit { int pm, pn, aux; };
typedef f32x4 Acc[2][2][4][2];

__device__ __forceinline__ bool static_tile(int L, int nM, int nN, int& pm, int& pn) {
    const int nwg = nM * nN; if (L >= nwg) return false;
    int wgid = L; { const int q = nwg / NXCD, r = nwg % NXCD, xcd = wgid % NXCD, off = wgid / NXCD; wgid = (xcd < r ? xcd * (q + 1) : r * (q + 1) + (xcd - r) * q) + off; }
    const int nig = WGM * nN, gid = wgid / nig, fm = gid * WGM, gsz = (nM - fm) < WGM ? (nM - fm) : WGM;
    pm = fm + ((wgid % nig) % gsz); pn = (wgid % nig) / gsz; return true;
}

__device__ __forceinline__ void glds_s(const void* sbase, unsigned voff, unsigned lds_dst) { unsigned keep;
    asm volatile("s_mov_b32 %0, m0\n\ts_mov_b32 m0, %3\n\ts_nop 0\n\tglobal_load_lds_dwordx4 %1, %2\n\ts_mov_b32 m0, %0" : "=&s"(keep) : "v"(voff), "s"(sbase), "s"(lds_dst) : "memory"); }
__device__ __forceinline__ const char* uni_ptr(const char* p) { const unsigned long long v = (unsigned long long)p; const unsigned lo = __builtin_amdgcn_readfirstlane((unsigned)v), hi = __builtin_amdgcn_readfirstlane((unsigned)(v >> 32));
    return (const char*)(GAS const char*)(((unsigned long long)hi << 32) | lo); }
template <bool FP8, class Epi, class Sched>
__device__ __forceinline__ void gemm_phase(LAS unsigned char* lds, const int Kb, const Sched& S, const Epi& E) {
    const int tid = opaque_tid(), wid = __builtin_amdgcn_readfirstlane(tid >> 6), lane = tid & 63, wr = wid >> 2, wc = wid & 3, fr = lane & 15, fq = lane >> 4;
    const int nt = Kb / 128;
    int Rr[2], Cc[2]; unsigned voffB[2];
#pragma unroll
    for (int i = 0; i < 2; ++i) { stage_rc(tid * 16 + i * 8192, Rr[i], Cc[i]); const int Rb = Epi::PERM ? ((Rr[i] & ~31) + perm32(Rr[i] & 31)) : Rr[i];
        voffB[i] = (unsigned)(Rb * S.ldb() + Cc[i] * 2); }
    const size_t kstep = (size_t)(BK * 2);
    const size_t hstepB = (size_t)HALF * S.ldb();
    const unsigned ldsw = (unsigned)wid * 1024u;
    const unsigned ldsb = (unsigned)__builtin_amdgcn_readfirstlane((int)((unsigned)(uintptr_t)lds + ldsw));
    const int aoff = lds_byte(wr * 64 + fr, fq * 8), boff = lds_byte(wc * 32 + fr, fq * 8);
#define PG8_SA(b, h) (((b) * 2 + (h)) * HTB)
#define PG8_SB(b, h) ((4 + (b) * 2 + (h)) * HTB)
#define PG8_STAGE(bufoff, gbase, voff) do { const void* sb_ = (const void*)(gbase); _Pragma("unroll") for (int _i = 0; _i < 2; ++_i) \
        glds_s(sb_, (voff)[_i], ldsb + (unsigned)((bufoff) + _i * 8192)); } while (0)
#define PG8_LD8(p_) __builtin_shufflevector(*(const LAS v4i*)(p_), *(const LAS v4i*)((p_) + 1024), 0, 1, 2, 3, 4, 5, 6, 7)
#define PG8_LDA(dst, b, h) do { _Pragma("unroll") for (int m = 0; m < 4; ++m) dst[m] = PG8_LD8(lds + PG8_SA(b, h) + aoff + m * 2048); } while (0)
#define PG8_LDB(dst, b, h) do { _Pragma("unroll") for (int n = 0; n < 2; ++n) dst[n] = PG8_LD8(lds + PG8_SB(b, h) + boff + n * 2048); } while (0)
#define PG8_H(v_, k_) __builtin_bit_cast(bf16x8, __builtin_shufflevector(v_, v_, 4 * (k_), 4 * (k_) + 1, 4 * (k_) + 2, 4 * (k_) + 3))
#define PG8_MMA(ai, bj, At, Bt) do { __builtin_amdgcn_s_setprio(1); _Pragma("unroll") for (int m = 0; m < 4; ++m) _Pragma("unroll") for (int n = 0; n < 2; ++n) { \
        if constexpr (FP8) asm volatile("v_mfma_f32_16x16x128_f8f6f4 %0, %1, %2, %0" : "+v"(acc[ai][bj][m][n]) : "v"(Bt[n]), "v"(At[m]));   \
        else { acc[ai][bj][m][n] = __builtin_amdgcn_mfma_f32_16x16x32_bf16(PG8_H(Bt[n], 0), PG8_H(At[m], 0), acc[ai][bj][m][n], 0, 0, 0); \
               acc[ai][bj][m][n] = __builtin_amdgcn_mfma_f32_16x16x32_bf16(PG8_H(Bt[n], 1), PG8_H(At[m], 1), acc[ai][bj][m][n], 0, 0, 0); } } \
        __builtin_amdgcn_s_setprio(0); } while (0)
#define PG8_WAIT_V(n) asm volatile("s_waitcnt vmcnt(" #n ")" ::: "memory")
#define PG8_WAIT_L(n) asm volatile("s_waitcnt lgkmcnt(" #n ")" ::: "memory")
#define PG8_BAR __builtin_amdgcn_s_barrier()
#define PG8_SCHED __builtin_amdgcn_sched_barrier(0)
    Unit cur, nxt; int ui = 0;
    if (!S.next(0, cur)) return;
    Acc acc;
#pragma unroll
    for (int a = 0; a < 2; ++a)
#pragma unroll
        for (int b = 0; b < 2; ++b)
#pragma unroll
            for (int m = 0; m < 4; ++m)
#pragma unroll
                for (int n = 0; n < 2; ++n) acc[a][b][m][n] = (f32x4){0.f, 0.f, 0.f, 0.f};
    v8i At[4], B0[2], B1[2]; const int one8 = 0x7F7F7F7F;
    unsigned vA[2][2], vAn[2][2];
    S.a_off(cur, Rr, Cc, vA);
    const char* cA = uni_ptr(S.a_base(cur)); const char* cB = uni_ptr(S.b_base(cur));
    PG8_STAGE(PG8_SB(0, 0), cB, voffB); PG8_STAGE(PG8_SB(0, 1), cB + hstepB, voffB); PG8_STAGE(PG8_SA(0, 0), cA, vA[0]); PG8_STAGE(PG8_SA(0, 1), cA, vA[1]);
    if (wr == 1) PG8_BAR;
    PG8_WAIT_V(2); PG8_BAR;
    PG8_STAGE(PG8_SB(1, 0), cB + kstep, voffB); PG8_STAGE(PG8_SA(1, 0), cA + kstep, vA[0]); PG8_STAGE(PG8_SB(1, 1), cB + hstepB + kstep, voffB);
    PG8_WAIT_V(6); PG8_BAR;
    for (;;) {
        const bool has_next = S.next(ui + 1, nxt);
        const char* nA = cA; const char* nB = cB;
#pragma unroll
        for (int h = 0; h < 2; ++h)
#pragma unroll
            for (int i = 0; i < 2; ++i) vAn[h][i] = vA[h][i];
        if (has_next) { nA = uni_ptr(S.a_base(nxt)); nB = uni_ptr(S.b_base(nxt)); if (Sched::VARIES) S.a_off(nxt, Rr, Cc, vAn); }
        for (int t = 0; t < nt; t += 2) {
            const bool last = (t == nt - 2);
            const char* a1 = cA + (size_t)(t + 1) * kstep;
            const char* a2 = last ? nA : cA + (size_t)(t + 2) * kstep; const char* b2 = last ? nB : cB + (size_t)(t + 2) * kstep;
            const char* a3 = a2 + kstep; const char* b3 = b2 + kstep;
            unsigned v2[2][2];
#pragma unroll
            for (int h = 0; h < 2; ++h)
#pragma unroll
                for (int i = 0; i < 2; ++i) v2[h][i] = (Sched::VARIES && last) ? vAn[h][i] : vA[h][i];
            PG8_LDB(B0, 0, 0); PG8_LDB(B1, 0, 1); PG8_SCHED; PG8_LDA(At, 0, 0); PG8_STAGE(PG8_SA(1, 1), a1, vA[1]);
            if (!(FP8 && t == 0 && ui > 0)) PG8_WAIT_V(8);
            PG8_WAIT_L(0); PG8_BAR; PG8_MMA(0, 0, At, B0); PG8_MMA(0, 1, At, B1); PG8_BAR; PG8_SCHED;
            PG8_LDA(At, 0, 1); PG8_STAGE(PG8_SB(0, 0), b2, voffB); PG8_STAGE(PG8_SB(0, 1), b2 + hstepB, voffB); PG8_STAGE(PG8_SA(0, 0), a2, v2[0]);
            PG8_WAIT_V(8); PG8_WAIT_L(0); PG8_BAR; PG8_MMA(1, 0, At, B0); PG8_MMA(1, 1, At, B1); PG8_BAR; PG8_SCHED;
            PG8_LDB(B0, 1, 0); PG8_LDB(B1, 1, 1); PG8_SCHED; PG8_LDA(At, 1, 0); PG8_STAGE(PG8_SA(0, 1), a2, v2[1]);
            PG8_WAIT_V(8); PG8_WAIT_L(0); PG8_BAR; PG8_MMA(0, 0, At, B0); PG8_MMA(0, 1, At, B1); PG8_BAR; PG8_SCHED;
            PG8_LDA(At, 1, 1); PG8_STAGE(PG8_SB(1, 0), b3, voffB); PG8_STAGE(PG8_SB(1, 1), b3 + hstepB, voffB); PG8_STAGE(PG8_SA(1, 0), a3, v2[0]);
            PG8_WAIT_V(8); PG8_WAIT_L(0); PG8_BAR; PG8_MMA(1, 0, At, B0); PG8_MMA(1, 1, At, B1); PG8_BAR; PG8_SCHED;
        }
        PG8_WAIT_V(6);
        if (wr == 0) PG8_BAR;
        if constexpr (FP8) asm volatile("s_nop 15\n\ts_nop 15" ::: "memory");
        E(acc, cur, wr, wc, fr, fq);
        if (!has_next) break;
        if (!E.keep(cur)) {
#pragma unroll
            for (int a = 0; a < 2; ++a)
#pragma unroll
                for (int b = 0; b < 2; ++b)
#pragma unroll
                    for (int m = 0; m < 4; ++m)
#pragma unroll
                        for (int n = 0; n < 2; ++n) acc[a][b][m][n] = (f32x4){0.f, 0.f, 0.f, 0.f};
        }
        cur = nxt; cA = nA; cB = nB; ++ui;
#pragma unroll
        for (int h = 0; h < 2; ++h)
#pragma unroll
            for (int i = 0; i < 2; ++i) vA[h][i] = vAn[h][i];
        if (wr == 1) PG8_BAR;
    }
    PG8_WAIT_V(0);
    PG8_BAR;
#undef PG8_SA
#undef PG8_SB
#undef PG8_STAGE
#undef PG8_LDA
#undef PG8_LDB
#undef PG8_MMA
#undef PG8_WAIT_V
#undef PG8_WAIT_L
#undef PG8_BAR
#undef PG8_SCHED
}

struct SchedDense {
    static constexpr bool VARIES = false;
    const void* A; const void* Bt; int lda, ldb_, nM, nN, G, c;
    __device__ __forceinline__ int ldb() const { return ldb_; }
    __device__ __forceinline__ bool next(int i, Unit& u) const { u.aux = 0; return static_tile(i * G + c, nM, nN, u.pm, u.pn); }
    __device__ __forceinline__ const char* a_base(const Unit& u) const { return (const char*)A + (size_t)u.pm * BM * lda; }
    __device__ __forceinline__ const char* b_base(const Unit& u) const { return (const char*)Bt + (size_t)u.pn * BM * ldb_; }
    __device__ __forceinline__ void a_off(const Unit&, const int (&R)[2], const int (&C)[2], unsigned (&vo)[2][2]) const {
#pragma unroll
        for (int h = 0; h < 2; ++h)
#pragma unroll
            for (int i = 0; i < 2; ++i) vo[h][i] = (unsigned)((h * HALF + R[i]) * lda + C[i] * 2); }
};
struct SchedOne {
    static constexpr bool VARIES = false;
    const void* A; const void* Bt; int lda, ldb_, pm, pn;
    __device__ __forceinline__ int ldb() const { return ldb_; }
    __device__ __forceinline__ bool next(int i, Unit& u) const { u.aux = 0; u.pm = pm; u.pn = pn; return i == 0; }
    __device__ __forceinline__ const char* a_base(const Unit& u) const { return (const char*)A + (size_t)u.pm * BM * lda; }
    __device__ __forceinline__ const char* b_base(const Unit& u) const { return (const char*)Bt + (size_t)u.pn * BM * ldb_; }
    __device__ __forceinline__ void a_off(const Unit&, const int (&R)[2], const int (&C)[2], unsigned (&vo)[2][2]) const {
#pragma unroll
        for (int h = 0; h < 2; ++h)
#pragma unroll
            for (int i = 0; i < 2; ++i) vo[h][i] = (unsigned)((h * HALF + R[i]) * lda + C[i] * 2); }
};
struct SchedSeg2 {
    static constexpr bool VARIES = false;
    const void* A0; const void* B0; const void* A1; const void* B1; int ld, nM, nN, G, c;
    __device__ __forceinline__ int ldb() const { return ld; }
    __device__ __forceinline__ bool next(int i, Unit& u) const { u.aux = i & 1; return static_tile((i >> 1) * G + c, nM, nN, u.pm, u.pn); }
    __device__ __forceinline__ const char* a_base(const Unit& u) const { return (const char*)(u.aux ? A1 : A0) + (size_t)u.pm * BM * ld; }
    __device__ __forceinline__ const char* b_base(const Unit& u) const { return (const char*)(u.aux ? B1 : B0) + (size_t)u.pn * BM * ld; }
    __device__ __forceinline__ void a_off(const Unit&, const int (&R)[2], const int (&C)[2], unsigned (&vo)[2][2]) const {
#pragma unroll
        for (int h = 0; h < 2; ++h)
#pragma unroll
            for (int i = 0; i < 2; ++i) vo[h][i] = (unsigned)((h * HALF + R[i]) * ld + C[i] * 2); }
};
template <bool GATHER> struct SchedMoE {
    static constexpr bool VARIES = GATHER;
    const void* A; const void* Bt; const int* ltok; int lda, ldb_, nN, G, c; size_t bstride; const volatile LAS unsigned* misc; int nm_word;
    __device__ __forceinline__ int ldb() const { return ldb_; }
    __device__ __forceinline__ bool next(int i, Unit& u) const {
        const int nM = (int)misc[nm_word]; if (!static_tile(i * G + c, nM, nN, u.pm, u.pn)) return false;
        int e = 0;
#pragma unroll
        for (int j = 1; j < NE; ++j) e += ((int)misc[16 + j] <= u.pm) ? 1 : 0;
        u.aux = e; return true; }
    __device__ __forceinline__ const char* a_base(const Unit& u) const { return GATHER ? (const char*)A : (const char*)A + (size_t)u.pm * BM * lda; }
    __device__ __forceinline__ const char* b_base(const Unit& u) const { return (const char*)Bt + (size_t)u.aux * bstride + (size_t)u.pn * BM * ldb_; }
    __device__ __forceinline__ void a_off(const Unit& u, const int (&R)[2], const int (&C)[2], unsigned (&vo)[2][2]) const {
        if (GATHER) {
            const int cnt = (int)misc[8 + u.aux], r0 = (u.pm - (int)misc[16 + u.aux]) * BM;
#pragma unroll
            for (int h = 0; h < 2; ++h)
#pragma unroll
                for (int i = 0; i < 2; ++i) { const int r = r0 + h * HALF + R[i]; const int tok = r < cnt ? ltok[u.aux * M + r] : 0; vo[h][i] = (unsigned)(tok * lda + C[i] * 2); }
        } else {
#pragma unroll
            for (int h = 0; h < 2; ++h)
#pragma unroll
                for (int i = 0; i < 2; ++i) vo[h][i] = (unsigned)((h * HALF + R[i]) * lda + C[i] * 2);
        } }
};

struct SchedMoETail {
    static constexpr bool VARIES = false;
    const void* A; const void* Bt; int lda, ldb_, nN, c, kpart; size_t bstride; const volatile LAS unsigned* misc;
    __device__ __forceinline__ int ldb() const { return ldb_; }
    __device__ __forceinline__ bool next(int i, Unit& u) const {
        const int S = (int)misc[26], Tm = (int)misc[25], nt = ((int)misc[24] - Tm) * nN;
        if (i != 0 || c >= nt * S) return false;
        const int j = c / S, part = c - j * S; u.pm = Tm + j / nN; u.pn = j % nN;
        int e = 0;
#pragma unroll
        for (int q = 1; q < NE; ++q) e += ((int)misc[16 + q] <= u.pm) ? 1 : 0;
        u.aux = e | (part << 8); return true; }
    __device__ __forceinline__ const char* a_base(const Unit& u) const { return (const char*)A + (size_t)u.pm * BM * lda + (size_t)(u.aux >> 8) * kpart; }
    __device__ __forceinline__ const char* b_base(const Unit& u) const { return (const char*)Bt + (size_t)(u.aux & 255) * bstride + (size_t)u.pn * BM * ldb_ + (size_t)(u.aux >> 8) * kpart; }
    __device__ __forceinline__ void a_off(const Unit&, const int (&R)[2], const int (&C)[2], unsigned (&vo)[2][2]) const {
#pragma unroll
        for (int h = 0; h < 2; ++h)
#pragma unroll
            for (int i = 0; i < 2; ++i) vo[h][i] = (unsigned)((h * HALF + R[i]) * lda + C[i] * 2); }
};

struct EpiIn {
    static constexpr bool PERM = true;
    bf16_t* QKV; bf16_t* KCb; bf16_t* VCb; bf16_t* GMb; bf16_t* NGb; const u64* rsq; const float* cosT; const float* sinT; float wscale;
    LAS unsigned char* slab;
    __device__ __forceinline__ bool keep(const Unit&) const { return false; }
    __device__ __forceinline__ void operator()(const Acc& acc, const Unit& u, int wr, int wc, int fr, int fq) const {
        const int pn = u.pn, row0 = u.pm * BM + wr * 64 + fr;
        u64 rq[2][4];
#pragma unroll
        for (int ai = 0; ai < 2; ++ai)
#pragma unroll
            for (int m = 0; m < 4; ++m) rq[ai][m] = rsq[row0 + ai * HALF + m * 16];
        const float sc = (1.0f / (RSQ_SCALE * D));
        if (pn < 32) {
            const int wid = wr * 4 + wc, lane = fq * 16 + fr;
            LAS unsigned char* wrow = slab + (wr * 16 + fr) * 528;
            const int sr = wid * 4 + (lane >> 5), cb = (lane & 31) * 16;
            const LAS unsigned char* rp = slab + sr * 528 + cb;
            const int trow = (sr >> 4) * 64 + (sr & 15);
            const bool rope = pn < 16 && ((0x57DF >> pn) & 1); const int d0 = 16 * wc + 4 * fq;
            f32x4 csa[8], sna[8];
#pragma unroll
            for (int g = 0; g < 8; ++g) { csa[g] = f32x4{1.f, 1.f, 1.f, 1.f}; sna[g] = f32x4{0.f, 0.f, 0.f, 0.f}; }
            if (rope) {
#pragma unroll
                for (int g = 0; g < 8; ++g) { const int t = (row0 + (g >> 2) * HALF + (g & 3) * 16) & (T - 1); csa[g] = *(const f32x4*)(cosT + t * 64 + d0); sna[g] = *(const f32x4*)(sinT + t * 64 + d0); } }
#pragma unroll
            for (int g = 0; g < 8; ++g) { const int ai = g >> 2, m = g & 3; const f32x4 cs = csa[g], sn = sna[g];
                const float rstd = rsqrtf((float)rq[ai][m] * sc + NORM_EPS) * wscale;
#pragma unroll
                for (int bj = 0; bj < 2; ++bj) { const f32x4 v0 = acc[ai][bj][m][0] * rstd, v1 = acc[ai][bj][m][1] * rstd;
                    if (pn < 16) { const f32x4 o1 = v0 * cs - v1 * sn, o2 = v1 * cs + v0 * sn;
                        u32x2 w1, w2; w1.x = cvt_pk_bf16(o1[0], o1[1]); w1.y = cvt_pk_bf16(o1[2], o1[3]); w2.x = cvt_pk_bf16(o2[0], o2[1]); w2.y = cvt_pk_bf16(o2[2], o2[3]);
                        *(LAS u32x2*)(wrow + (bj * HD + d0) * 2) = w1; *(LAS u32x2*)(wrow + (bj * HD + 64 + d0) * 2) = w2; }
                    else { const float c1 = -1.4426950408889634f * rstd; const f32x4 s0 = sigmoid4_scaled(acc[ai][bj][m][0], c1), s1 = sigmoid4_scaled(acc[ai][bj][m][1], c1); u32x4 w;
                        w.x = cvt_pk_bf16(s0[0], s0[1]); w.y = cvt_pk_bf16(s0[2], s0[3]); w.z = cvt_pk_bf16(s1[0], s1[1]); w.w = cvt_pk_bf16(s1[2], s1[3]);
                        *(LAS u32x4*)(wrow + (bj * HD + wc * 32 + 8 * fq) * 2) = w; } }
                asm volatile("s_waitcnt lgkmcnt(0)" ::: "memory"); __builtin_amdgcn_s_barrier(); asm volatile("" ::: "memory");
                const u32x4 ra = *(const LAS u32x4*)rp, rb = *(const LAS u32x4*)(rp + 2 * 528);
                asm volatile("s_waitcnt lgkmcnt(0)" ::: "memory"); __builtin_amdgcn_s_barrier(); asm volatile("" ::: "memory");
                const int grow = u.pm * BM + ai * HALF + m * 16 + trow;
                unsigned char* dst; size_t rstride;
                if (pn == 10 || pn == 11) { bf16_t* cbuf = pn == 10 ? KCb : VCb; dst = (unsigned char*)(cbuf + ((size_t)((grow >> 12) * 2 + (cb >> 8)) * T + (grow & (T - 1))) * HD) + (cb & 255); rstride = (size_t)HD * 2; }
                else if (pn < 16) { dst = (unsigned char*)(QKV + (size_t)grow * 4096 + pn * 256) + cb; rstride = (size_t)4096 * 2; }
                else { dst = (unsigned char*)(GMb + (size_t)grow * 4096 + (pn - 16) * 256) + cb; rstride = (size_t)4096 * 2; }
                *(u32x4*)dst = ra; *(u32x4*)(dst + 2 * rstride) = rb; }
        } else {
            if (wc == 0) {
#pragma unroll
                for (int ai = 0; ai < 2; ++ai)
#pragma unroll
                    for (int m = 0; m < 4; ++m) { const int row = row0 + ai * HALF + m * 16; const float rstd = rsqrtf((float)rq[ai][m] * sc + NORM_EPS) * wscale;
                        const f32x4 v0 = acc[ai][0][m][0] * rstd, v1 = acc[ai][0][m][1] * rstd; u32x4 w;
                        w.x = cvt_pk_bf16(fast_sigmoid(v0[0]), fast_sigmoid(v0[1])); w.y = cvt_pk_bf16(fast_sigmoid(v0[2]), fast_sigmoid(v0[3]));
                        w.z = cvt_pk_bf16(fast_sigmoid(v1[0]), fast_sigmoid(v1[1])); w.w = cvt_pk_bf16(fast_sigmoid(v1[2]), fast_sigmoid(v1[3]));
                        *(u32x4*)(NGb + (size_t)row * 32 + 8 * fq) = w; }
            }
        }
    }
};
struct EpiCmp1 {
    static constexpr bool PERM = true;
    bf16_t* H; const long long* bias;
    __device__ __forceinline__ bool keep(const Unit&) const { return false; }
    __device__ __forceinline__ void operator()(const Acc& acc, const Unit& u, int wr, int wc, int fr, int fq) const {
        const int row0 = u.pm * BM + wr * 64 + fr, col0 = wc * 32 + 8 * fq;
        f32x4 bv[2][2];
#pragma unroll
        for (int bj = 0; bj < 2; ++bj)
#pragma unroll
            for (int n = 0; n < 2; ++n) { const long long* bp = bias + col0 + bj * HALF + 4 * n; bv[bj][n] = f32x4{(float)bp[0], (float)bp[1], (float)bp[2], (float)bp[3]} * (1.0f / CB_SCALE); }
#pragma unroll
        for (int ai = 0; ai < 2; ++ai)
#pragma unroll
            for (int m = 0; m < 4; ++m) { bf16_t* rowp = H + (size_t)(row0 + ai * HALF + m * 16) * 256 + col0;
#pragma unroll
                for (int bj = 0; bj < 2; ++bj) { f32x4 v0 = acc[ai][bj][m][0] + bv[bj][0], v1 = acc[ai][bj][m][1] + bv[bj][1];
#pragma unroll
                    for (int j = 0; j < 4; ++j) { v0[j] = v0[j] * fast_sigmoid(v0[j]); v1[j] = v1[j] * fast_sigmoid(v1[j]); }
                    u32x4 w; w.x = cvt_pk_bf16(v0[0], v0[1]); w.y = cvt_pk_bf16(v0[2], v0[3]); w.z = cvt_pk_bf16(v1[0], v1[1]); w.w = cvt_pk_bf16(v1[2], v1[3]);
                    *(u32x4*)(rowp + bj * HALF) = w; } }
    }
};
struct EpiCmp2 {
    static constexpr bool PERM = true;
    bf16_t* O;
    __device__ __forceinline__ bool keep(const Unit&) const { return false; }
    __device__ __forceinline__ void operator()(const Acc& acc, const Unit& u, int wr, int wc, int fr, int fq) const {
        const int row0 = u.pm * BM + wr * 64 + fr, col0 = wc * 32 + 8 * fq;
#pragma unroll
        for (int ai = 0; ai < 2; ++ai)
#pragma unroll
            for (int m = 0; m < 4; ++m) { const int row = row0 + ai * HALF + m * 16; const float z = ((row & 255) == 255) ? 0.f : 1.f;
                const f32x4 v0 = acc[ai][0][m][0] * z, v1 = acc[ai][0][m][1] * z;
                u32x4 w; w.x = cvt_pk_bf16(v0[0], v0[1]); w.y = cvt_pk_bf16(v0[2], v0[3]); w.z = cvt_pk_bf16(v1[0], v1[1]); w.w = cvt_pk_bf16(v1[2], v1[3]);
                *(u32x4*)(O + (size_t)row * HD + col0) = w; }
    }
};
struct EpiMerge {
    static constexpr bool PERM = true;
    const bf16_t* GMb; unsigned char* Z; float zscale;
    __device__ __forceinline__ bool keep(const Unit& u) const { return u.aux == 0; }
    __device__ __forceinline__ void operator()(Acc& acc, const Unit& u, int wr, int wc, int fr, int fq) const {
        const int row0 = u.pm * BM + wr * 64 + fr, col0 = u.pn * BM + wc * 32 + 8 * fq;
        if (u.aux == 0) {
#pragma unroll
            for (int ai = 0; ai < 2; ++ai)
#pragma unroll
                for (int m = 0; m < 4; ++m) { const int row = row0 + ai * HALF + m * 16;
#pragma unroll
                    for (int bj = 0; bj < 2; ++bj) { const int col = col0 + bj * HALF;
                        const u32x4 g1 = *(const u32x4*)(GMb + (size_t)row * 4096 + 2048 + col), g0 = *(const u32x4*)(GMb + (size_t)row * 4096 + col);
                        const f32x4 g1a = {bf_lo(g1.x), bf_hi(g1.x), bf_lo(g1.y), bf_hi(g1.y)}, g1b = {bf_lo(g1.z), bf_hi(g1.z), bf_lo(g1.w), bf_hi(g1.w)};
                        const f32x4 g0a = {bf_lo(g0.x), bf_hi(g0.x), bf_lo(g0.y), bf_hi(g0.y)}, g0b = {bf_lo(g0.z), bf_hi(g0.z), bf_lo(g0.w), bf_hi(g0.w)};
#pragma unroll
                        for (int j = 0; j < 4; ++j) { acc[ai][bj][m][0][j] *= g0a[j] * __builtin_amdgcn_rcpf(fmaxf(g1a[j], 1e-30f)); acc[ai][bj][m][1][j] *= g0b[j] * __builtin_amdgcn_rcpf(fmaxf(g1b[j], 1e-30f)); } } }
        } else {
            u32x4 gc[2], gn[2];
#pragma unroll
            for (int bj = 0; bj < 2; ++bj) gc[bj] = *(const u32x4*)(GMb + (size_t)row0 * 4096 + 2048 + col0 + bj * HALF);
#pragma unroll
            for (int g = 0; g < 8; ++g) { const int ai = g >> 2, m = g & 3, row = row0 + ai * HALF + m * 16;
                if (g < 7) { const int rn = row0 + ((g + 1) >> 2) * HALF + ((g + 1) & 3) * 16;
#pragma unroll
                    for (int bj = 0; bj < 2; ++bj) gn[bj] = *(const u32x4*)(GMb + (size_t)rn * 4096 + 2048 + col0 + bj * HALF); }
#pragma unroll
                for (int bj = 0; bj < 2; ++bj) { const u32x4 g1 = gc[bj];
                    const f32x4 g1a = {bf_lo(g1.x), bf_hi(g1.x), bf_lo(g1.y), bf_hi(g1.y)}, g1b = {bf_lo(g1.z), bf_hi(g1.z), bf_lo(g1.w), bf_hi(g1.w)};
                    const f32x4 v0 = acc[ai][bj][m][0] * g1a * zscale, v1 = acc[ai][bj][m][1] * g1b * zscale;
                    u32x2 w; w.x = cvt4_fp8(v0[0], v0[1], v0[2], v0[3]); w.y = cvt4_fp8(v1[0], v1[1], v1[2], v1[3]);
                    *(u32x2*)(Z + (size_t)row * D + col0 + bj * HALF) = w; }
                gc[0] = gn[0]; gc[1] = gn[1]; }
        }
    }
};
struct EpiResid {
    static constexpr bool PERM = true;
    const void* xin; int xin16; bf16_t* XB; u64* rsq_out; unsigned char* X8; float ascale;
    __device__ __forceinline__ bool keep(const Unit&) const { return false; }
    __device__ __forceinline__ void ldx(size_t off, f32x4& a, f32x4& b) const {
        if (xin16) { const u32x4 w = *(const u32x4*)((const bf16_t*)xin + off); a = f32x4{bf_lo(w.x), bf_hi(w.x), bf_lo(w.y), bf_hi(w.y)}; b = f32x4{bf_lo(w.z), bf_hi(w.z), bf_lo(w.w), bf_hi(w.w)}; }
        else { a = *(const f32x4*)((const float*)xin + off); b = *(const f32x4*)((const float*)xin + off + 4); } }
    __device__ __forceinline__ void operator()(const Acc& acc, const Unit& u, int wr, int wc, int fr, int fq) const {
        const int row0 = u.pm * BM + wr * 64 + fr, col0 = u.pn * BM + wc * 32 + 8 * fq;
        f32x4 xc[2][2], xn[2][2];
#pragma unroll
        for (int bj = 0; bj < 2; ++bj) ldx((size_t)row0 * D + col0 + bj * HALF, xc[bj][0], xc[bj][1]);
#pragma unroll
        for (int g = 0; g < 8; ++g) { const int ai = g >> 2, m = g & 3, row = row0 + ai * HALF + m * 16; const size_t off = (size_t)row * D + col0; float ss = 0.f;
            if (g < 7) { const size_t offn = (size_t)(row0 + ((g + 1) >> 2) * HALF + ((g + 1) & 3) * 16) * D + col0;
#pragma unroll
                for (int bj = 0; bj < 2; ++bj) ldx(offn + bj * HALF, xn[bj][0], xn[bj][1]); }
#pragma unroll
            for (int bj = 0; bj < 2; ++bj) { const size_t o = off + bj * HALF; const f32x4 x0 = xc[bj][0] + acc[ai][bj][m][0] * ascale, x1 = xc[bj][1] + acc[ai][bj][m][1] * ascale;
                { u32x4 w; w.x = cvt_pk_bf16(x0[0], x0[1]); w.y = cvt_pk_bf16(x0[2], x0[3]); w.z = cvt_pk_bf16(x1[0], x1[1]); w.w = cvt_pk_bf16(x1[2], x1[3]); *(u32x4*)(XB + o) = w; }
                if (X8) { u32x2 w; w.x = cvt4_fp8(x0[0], x0[1], x0[2], x0[3]); w.y = cvt4_fp8(x1[0], x1[1], x1[2], x1[3]); *(u32x2*)(X8 + o) = w; }
                ss += (x0[0] * x0[0] + x0[1] * x0[1]) + (x0[2] * x0[2] + x0[3] * x0[3]) + (x1[0] * x1[0] + x1[1] * x1[1]) + (x1[2] * x1[2] + x1[3] * x1[3]); }
            ss += __shfl_xor(ss, 16); ss += __shfl_xor(ss, 32);
            if (fq == 0) atomicAdd(rsq_out + row, (u64)(ss * RSQ_SCALE + 0.5f));
#pragma unroll
            for (int bj = 0; bj < 2; ++bj)
#pragma unroll
                for (int n = 0; n < 2; ++n) xc[bj][n] = xn[bj][n]; }
    }
};
template <bool MOE, bool OUT8 = MOE, bool W8 = MOE> struct EpiGateUp {
    static constexpr bool PERM = true;
    bf16_t* ACT; const u64* rsq; const int* ltok; const volatile LAS unsigned* misc;
    __device__ __forceinline__ bool keep(const Unit&) const { return false; }
    __device__ __forceinline__ void operator()(const Acc& acc, const Unit& u, int wr, int wc, int fr, int fq) const {
        const int row0 = u.pm * BM + wr * 64 + fr, col0 = u.pn * 128 + wc * 32 + 8 * fq;
        int cnt = 0, r0 = 0; if (MOE) { cnt = (int)misc[8 + u.aux]; r0 = (u.pm - (int)misc[16 + u.aux]) * BM + wr * 64 + fr; }
        int srow[2][4]; u64 rq[2][4];
#pragma unroll
        for (int ai = 0; ai < 2; ++ai)
#pragma unroll
            for (int m = 0; m < 4; ++m) { srow[ai][m] = row0 + ai * HALF + m * 16; if (MOE) { const int r = r0 + ai * HALF + m * 16; srow[ai][m] = r < cnt ? ltok[u.aux * M + r] : 0; } }
#pragma unroll
        for (int ai = 0; ai < 2; ++ai)
#pragma unroll
            for (int m = 0; m < 4; ++m) rq[ai][m] = rsq[srow[ai][m]];
#pragma unroll
        for (int ai = 0; ai < 2; ++ai)
#pragma unroll
            for (int m = 0; m < 4; ++m) { const int row = row0 + ai * HALF + m * 16;
                const float rstd = rsqrtf((float)rq[ai][m] * (1.0f / (RSQ_SCALE * D)) + NORM_EPS) * (W8 ? 1.0f / WGU8_SCALE : 1.0f);
                const float c1 = -1.4426950408889634f * rstd, r2 = rstd * rstd;
                f32x4 a[2];
#pragma unroll
                for (int n = 0; n < 2; ++n) { const f32x4 g = acc[ai][0][m][n], up = acc[ai][1][m][n]; const f32x4 t = g * c1, gu = g * up; f32x4 e, sg;
#pragma unroll
                    for (int j = 0; j < 4; ++j) e[j] = __builtin_amdgcn_exp2f(t[j]);
                    const f32x4 d = e + 1.0f;
#pragma unroll
                    for (int j = 0; j < 4; ++j) sg[j] = __builtin_amdgcn_rcpf(d[j]);
                    a[n] = gu * (sg * r2); }
                if (OUT8) { u32x2 w; w.x = cvt4_fp8(a[0][0], a[0][1], a[0][2], a[0][3]); w.y = cvt4_fp8(a[1][0], a[1][1], a[1][2], a[1][3]); *(u32x2*)((unsigned char*)ACT + (size_t)row * FF + col0) = w; }
                else { u32x4 w; w.x = cvt_pk_bf16(a[0][0], a[0][1]); w.y = cvt_pk_bf16(a[0][2], a[0][3]); w.z = cvt_pk_bf16(a[1][0], a[1][1]); w.w = cvt_pk_bf16(a[1][2], a[1][3]); *(u32x4*)(ACT + (size_t)row * FF + col0) = w; } }
    }
};
struct EpiMoeDown {
    static constexpr bool PERM = true;
    bf16_t* YS; const float* lw; const volatile LAS unsigned* misc;
    __device__ __forceinline__ bool keep(const Unit&) const { return false; }
    __device__ __forceinline__ void operator()(const Acc& acc, const Unit& u, int wr, int wc, int fr, int fq) const {
        const int row0 = u.pm * BM + wr * 64 + fr, col0 = u.pn * BM + wc * 32 + 8 * fq;
        const int cnt = (int)misc[8 + u.aux], r0 = (u.pm - (int)misc[16 + u.aux]) * BM + wr * 64 + fr;
        float wg[2][4];
#pragma unroll
        for (int ai = 0; ai < 2; ++ai)
#pragma unroll
            for (int m = 0; m < 4; ++m) { const int r = r0 + ai * HALF + m * 16; wg[ai][m] = r < cnt ? lw[u.aux * M + r] * (1.0f / WD8_SCALE) : 0.f; }
#pragma unroll
        for (int ai = 0; ai < 2; ++ai)
#pragma unroll
            for (int m = 0; m < 4; ++m) { const int row = row0 + ai * HALF + m * 16; const float wgt = wg[ai][m];
#pragma unroll
                for (int bj = 0; bj < 2; ++bj) { const f32x4 v0 = acc[ai][bj][m][0] * wgt, v1 = acc[ai][bj][m][1] * wgt;
                    u32x4 w; w.x = cvt_pk_bf16(v0[0], v0[1]); w.y = cvt_pk_bf16(v0[2], v0[3]); w.z = cvt_pk_bf16(v1[0], v1[1]); w.w = cvt_pk_bf16(v1[2], v1[3]);
                    *(u32x4*)(YS + (size_t)row * D + col0 + bj * HALF) = w; } }
    }
};
struct EpiMoeDownTail {
    static constexpr bool PERM = true;
    bf16_t* YT; const float* lw; const volatile LAS unsigned* misc;
    __device__ __forceinline__ bool keep(const Unit&) const { return false; }
    __device__ __forceinline__ void operator()(const Acc& acc, const Unit& u, int wr, int wc, int fr, int fq) const {
        const int e = u.aux & 255, part = u.aux >> 8, Tm = (int)misc[25];
        const int row0 = (u.pm - Tm) * BM + wr * 64 + fr, col0 = u.pn * BM + wc * 32 + 8 * fq;
        const int cnt = (int)misc[8 + e], r0 = (u.pm - (int)misc[16 + e]) * BM + wr * 64 + fr;
        float wg[2][4];
#pragma unroll
        for (int ai = 0; ai < 2; ++ai)
#pragma unroll
            for (int m = 0; m < 4; ++m) { const int r = r0 + ai * HALF + m * 16; wg[ai][m] = r < cnt ? lw[e * M + r] * (1.0f / WD8_SCALE) : 0.f; }
        bf16_t* Y = YT + (size_t)part * YT_ROWS * D;
#pragma unroll
        for (int ai = 0; ai < 2; ++ai)
#pragma unroll
            for (int m = 0; m < 4; ++m) { const int row = row0 + ai * HALF + m * 16; const float wgt = wg[ai][m];
#pragma unroll
                for (int bj = 0; bj < 2; ++bj) { const f32x4 v0 = acc[ai][bj][m][0] * wgt, v1 = acc[ai][bj][m][1] * wgt;
                    u32x4 w; w.x = cvt_pk_bf16(v0[0], v0[1]); w.y = cvt_pk_bf16(v0[2], v0[3]); w.z = cvt_pk_bf16(v1[0], v1[1]); w.w = cvt_pk_bf16(v1[2], v1[3]);
                    *(u32x4*)(Y + (size_t)row * D + col0 + bj * HALF) = w; } }
    }
};
}

namespace att {
constexpr float SCALE = 0.08838834764831845f, LOG2E = 1.4426950408889634f, C2 = LOG2E * SCALE, THR = 8.f;
constexpr int TILE_B = 16384;
#define KSWZ(row, colB) ((row) * 256 + ((colB) ^ (((row) & 7) << 4)))
#define SBAR() __builtin_amdgcn_sched_barrier(0)
__device__ __forceinline__ int v_st(int k, int c) { const int kk = (k & ~0xC) | ((k & 4) << 1) | ((k & 8) >> 1); return ((kk >> 3) * 4 + (c >> 5)) * 512 + ((kk & 7) * 32 + (c & 31)) * 2; }
__device__ __forceinline__ int v_rd_base(int lane) { return ((lane & 3) << 3) | (((lane >> 2) & 3) << 6) | (((lane >> 4) & 1) << 5) | (((lane >> 5) & 1) << 8); }
constexpr int v_rd_off(int d0, int ks, int half) { return d0 * 512 + ks * 4096 + half * 2048; }
__device__ __forceinline__ int crow(int r, int hi) { return (r & 3) + 8 * (r >> 2) + 4 * hi; }

__device__ __forceinline__ void mask_tile(f32x16& p0, f32x16& p1, int dq, unsigned W) {
    const float NEG = -__builtin_inff();
#pragma unroll
    for (int r = 0; r < 16; ++r) { const int c = (r & 3) + 8 * (r >> 2);
        if ((unsigned)(dq - c) >= W) p0[r] = NEG;
        if ((unsigned)(dq - c - 32) >= W) p1[r] = NEG; }
}
__device__ __forceinline__ void mask_all(f32x16& p0, f32x16& p1, bool keep) {
    const float NEG = -__builtin_inff();
#pragma unroll
    for (int r = 0; r < 16; ++r) { p0[r] = keep ? p0[r] : NEG; p1[r] = keep ? p1[r] : NEG; }
}
__device__ __forceinline__ float rowmax32(const f32x16& p0, const f32x16& p1) {
    float pmax = p0[0];
#pragma unroll
    for (int r = 1; r < 16; ++r) pmax = fmaxf(pmax, p0[r]);
#pragma unroll
    for (int r = 0; r < 16; ++r) pmax = fmaxf(pmax, p1[r]);
    auto rr = __builtin_amdgcn_permlane32_swap(__float_as_uint(pmax), __float_as_uint(pmax), false, false);
    return fmaxf(__uint_as_float(rr[0]), __uint_as_float(rr[1]));
}
__device__ __forceinline__ float rowsum32(const f32x16& p0, const f32x16& p1) {
    float ps = 0.f;
#pragma unroll
    for (int r = 0; r < 16; ++r) ps += p0[r];
#pragma unroll
    for (int r = 0; r < 16; ++r) ps += p1[r];
    auto rr = __builtin_amdgcn_permlane32_swap(__float_as_uint(ps), __float_as_uint(ps), false, false);
    return __uint_as_float(rr[0]) + __uint_as_float(rr[1]);
}
__device__ __forceinline__ void pack_p(const f32x16& p0, const f32x16& p1, bf16x8& pa0, bf16x8& pa1, bf16x8& pa2, bf16x8& pa3) {
#define PK4(P, B_, OUT) do { unsigned a0 = cvt_pk_bf16(P[B_+0], P[B_+1]), a1 = cvt_pk_bf16(P[B_+2], P[B_+3]);                          \
        unsigned b0 = cvt_pk_bf16(P[B_+4], P[B_+5]), b1 = cvt_pk_bf16(P[B_+6], P[B_+7]);                                             \
        auto r0 = __builtin_amdgcn_permlane32_swap(a0, b0, false, false); auto r1 = __builtin_amdgcn_permlane32_swap(a1, b1, false, false); \
        u32x4 w = {r0[0], r1[0], r0[1], r1[1]}; OUT = *reinterpret_cast<bf16x8*>(&w); } while (0)
    PK4(p0, 0, pa0); PK4(p0, 8, pa1); PK4(p1, 0, pa2); PK4(p1, 8, pa3);
#undef PK4
}
__device__ __forceinline__ void softmax_step(f32x16& p0, f32x16& p1, float& m_reg, float& l_reg, float& alpha) {
    const float pmax = rowmax32(p0, p1); float mn;
    if (__builtin_expect(__all((pmax - m_reg) * SCALE <= THR), 1)) { mn = m_reg; alpha = 1.f; }
    else { mn = fmaxf(m_reg, pmax); alpha = __builtin_amdgcn_exp2f((m_reg - mn) * C2); m_reg = mn; }
    const float mnL = -mn * C2;
#pragma unroll
    for (int r = 0; r < 16; ++r) { p0[r] = __builtin_amdgcn_exp2f(fmaf(p0[r], C2, mnL)); p1[r] = __builtin_amdgcn_exp2f(fmaf(p1[r], C2, mnL)); }
    l_reg = l_reg * alpha + rowsum32(p0, p1);
}
__device__ __forceinline__ void softmax_step_keep(f32x16& p0, f32x16& p1, float& m_reg, float& l_reg, float& alpha, bool keep) {
    const float NEG = -__builtin_inff();
    const float pm = rowmax32(p0, p1), pmax = keep ? pm : NEG; float mn;
    if (__builtin_expect(__all((pmax - m_reg) * SCALE <= THR), 1)) { mn = m_reg; alpha = 1.f; }
    else { mn = fmaxf(m_reg, pmax); alpha = __builtin_amdgcn_exp2f((m_reg - mn) * C2); m_reg = mn; }
    const float c2 = keep ? C2 : 0.f, mnL = keep ? -mn * C2 : NEG;
#pragma unroll
    for (int r = 0; r < 16; ++r) { p0[r] = __builtin_amdgcn_exp2f(fmaf(p0[r], c2, mnL)); p1[r] = __builtin_amdgcn_exp2f(fmaf(p1[r], c2, mnL)); }
    l_reg = l_reg * alpha + rowsum32(p0, p1);
}
__device__ __forceinline__ void qkt(f32x16& p0, f32x16& p1, const LAS char* K_lds, int r32, int hi, const bf16x8* qr) {
    p0 = f32x16{}; p1 = f32x16{};
    const LAS char* kb[4];
#pragma unroll
    for (int dd = 0; dd < 4; ++dd) kb[dd] = K_lds + KSWZ(r32, (dd * 16 + hi * 8) * 2);
#pragma unroll
    for (int d0 = 0; d0 < 8; ++d0) { const LAS char* a = kb[d0 & 3] + (d0 >> 2) * 128;
        const bf16x8 b0 = *reinterpret_cast<const LAS bf16x8*>(a);
        const bf16x8 b1 = *reinterpret_cast<const LAS bf16x8*>(a + 32 * 256);
        p0 = __builtin_amdgcn_mfma_f32_32x32x16_bf16(b0, qr[d0], p0, 0, 0, 0);
        p1 = __builtin_amdgcn_mfma_f32_32x32x16_bf16(b1, qr[d0], p1, 0, 0, 0); }
}
__device__ __forceinline__ void pv_tile(f32x16* o, int vb0, bf16x8 pa0, bf16x8 pa1, bf16x8 pa2, bf16x8 pa3) {
#define TRRD(dst, off) asm volatile("ds_read_b64_tr_b16 %0, %1 offset:%2" : "=&v"(dst) : "v"(vb0), "i"(off) : "memory")
#define PV_D0(d0) do { s16x4 l0, l1, l2, l3, h0, h1, h2, h3; constexpr int b_ = v_rd_off(d0, 0, 0); \
        TRRD(l0, b_); TRRD(h0, b_ + 2048); TRRD(l1, b_ + 4096); TRRD(h1, b_ + 6144); TRRD(l2, b_ + 8192); TRRD(h2, b_ + 10240); TRRD(l3, b_ + 12288); TRRD(h3, b_ + 14336); \
        asm volatile("s_waitcnt lgkmcnt(0)" ::: "memory"); SBAR();   \
        o[d0] = __builtin_amdgcn_mfma_f32_32x32x16_bf16(pa0, (bf16x8){l0[0], l0[1], l0[2], l0[3], h0[0], h0[1], h0[2], h0[3]}, o[d0], 0, 0, 0);   \
        o[d0] = __builtin_amdgcn_mfma_f32_32x32x16_bf16(pa1, (bf16x8){l1[0], l1[1], l1[2], l1[3], h1[0], h1[1], h1[2], h1[3]}, o[d0], 0, 0, 0);   \
        o[d0] = __builtin_amdgcn_mfma_f32_32x32x16_bf16(pa2, (bf16x8){l2[0], l2[1], l2[2], l2[3], h2[0], h2[1], h2[2], h2[3]}, o[d0], 0, 0, 0);   \
        o[d0] = __builtin_amdgcn_mfma_f32_32x32x16_bf16(pa3, (bf16x8){l3[0], l3[1], l3[2], l3[3], h3[0], h3[1], h3[2], h3[3]}, o[d0], 0, 0, 0); } while (0)
    PV_D0(0); PV_D0(1); PV_D0(2); PV_D0(3);
#undef PV_D0
#undef TRRD
}

struct Ctx {
    int tid, wid, lane, r32, hi, sr, sc, kws, vst0, vst1, vb0;
    LAS char* K_lds; LAS char* V_lds; LAS float* wscr;
};
__device__ __forceinline__ Ctx make_ctx(LAS unsigned char* lds) {
    Ctx c; c.tid = opaque_tid(); c.wid = __builtin_amdgcn_readfirstlane(c.tid >> 6); c.lane = c.tid & 63; c.r32 = c.lane & 31; c.hi = c.lane >> 5;
    c.sr = c.tid >> 4; c.sc = (c.tid & 15) * 8; c.kws = KSWZ(c.sr, c.sc * 2); c.vst0 = v_st(c.sr, c.sc); c.vst1 = v_st(32 + c.sr, c.sc);
    c.K_lds = (LAS char*)(lds + LDS_K); c.V_lds = (LAS char*)(lds + LDS_V); c.wscr = (LAS float*)(lds + LDS_WSCR) + c.wid * 64;
    c.vb0 = (int)(unsigned)(uintptr_t)c.V_lds + v_rd_base(c.lane);
    return c;
}
__device__ __forceinline__ void glds16(const void* sbase, unsigned voff, unsigned lds_dst) { unsigned keep;
    asm volatile("s_mov_b32 %0, m0\n\ts_mov_b32 m0, %3\n\ts_nop 0\n\tglobal_load_lds_dwordx4 %1, %2\n\ts_mov_b32 m0, %0" : "=&s"(keep) : "v"(voff), "s"(sbase), "s"(lds_dst) : "memory"); }
__device__ __forceinline__ const void* uniform_ptr(const void* p) { const unsigned long long v = (unsigned long long)p; const unsigned lo = __builtin_amdgcn_readfirstlane((unsigned)v), hi = __builtin_amdgcn_readfirstlane((unsigned)(v >> 32));
    return (const void*)(GAS const void*)(((unsigned long long)hi << 32) | lo); }
struct Dma { unsigned ko[2], vo[2]; };
__device__ __forceinline__ Dma make_dma(const Ctx& c, int ldk, int ldv) {
    Dma d;
#pragma unroll
    for (int i = 0; i < 2; ++i) { const int p = c.wid * 2 + i, row = 4 * p + (c.lane >> 4); d.ko[i] = (unsigned)(row * ldk + (((c.lane & 15) ^ (row & 7)) * 8)) * 2u;
        const int st = 2 * p + (c.lane >> 5), kk = (st >> 2) * 8 + ((c.lane & 31) >> 2), k = (kk & ~0xC) | ((kk & 4) << 1) | ((kk & 8) >> 1); d.vo[i] = (unsigned)(k * ldv + (st & 3) * 32 + (c.lane & 3) * 8) * 2u; }
    return d;
}
__device__ __forceinline__ void dma_tile(const Ctx& c, const Dma& d, const bf16_t* Kg, int ldk, const bf16_t* Vg, int ldv, int key0, int slot) {
    const void* kb = uniform_ptr(Kg + (size_t)key0 * ldk); const void* vb = uniform_ptr(Vg + (size_t)key0 * ldv);
#pragma unroll
    for (int i = 0; i < 2; ++i) {
        glds16(kb, d.ko[i], (unsigned)__builtin_amdgcn_readfirstlane((int)(unsigned)(uintptr_t)(c.K_lds + slot * TILE_B + (c.wid * 2 + i) * 1024)));
        glds16(vb, d.vo[i], (unsigned)__builtin_amdgcn_readfirstlane((int)(unsigned)(uintptr_t)(c.V_lds + slot * TILE_B + (c.wid * 2 + i) * 1024))); }
}
#define ATT_BAR() do { asm volatile("s_waitcnt lgkmcnt(0)" ::: "memory"); __builtin_amdgcn_s_barrier(); asm volatile("" ::: "memory"); } while (0)
__device__ __forceinline__ void rescale_o(f32x16* o, float alpha, const Ctx& c) {
    if (__any(alpha < 1.f)) { if (c.hi == 0) c.wscr[32 + c.r32] = alpha; LDS_WAIT();
#pragma unroll
        for (int d = 0; d < 4; ++d)
#pragma unroll
            for (int r = 0; r < 16; ++r) o[d][r] *= c.wscr[32 + crow(r, c.hi)];
        LDS_WAIT(); }
}
template <int MODE>
__device__ __forceinline__ void attn_loop_simple(const Ctx& c, const bf16_t* Kg, int ldk, const bf16_t* Vg, int ldv, int j_lo, int NT, const bf16x8* qr,
                                          int qpos, int qlo, int W, unsigned sel_lo, unsigned sel_hi, int diag, f32x16* o, float& m_reg, float& l_reg) {
    f32x16 p0, p1; bf16x8 pa0, pa1, pa2, pa3; float alpha;
    const Dma d = make_dma(c, ldk, ldv);
    dma_tile(c, d, Kg, ldk, Vg, ldv, j_lo * 64, 0);
    if (NT > 1) dma_tile(c, d, Kg, ldk, Vg, ldv, j_lo * 64 + 64, 1);
    int slot = 0, slot2 = 2;
    for (int t = 0; t < NT; ++t) { const int jt = j_lo + t, kb_ = jt * 64, bo = slot * TILE_B;
        if (t + 1 < NT) asm volatile("s_waitcnt vmcnt(4)" ::: "memory"); else asm volatile("s_waitcnt vmcnt(0)" ::: "memory");
        ATT_BAR();
        if (t + 2 < NT) dma_tile(c, d, Kg, ldk, Vg, ldv, kb_ + 128, slot2);
        SBAR(); qkt(p0, p1, c.K_lds + bo, c.r32, c.hi, qr); bool keep = true;
        if (MODE == 0) { if (kb_ + 63 > qlo || kb_ <= qlo + 31 - W) mask_tile(p0, p1, qpos - kb_ - 4 * c.hi, (unsigned)W); }
        else { const unsigned bit = (jt < 32 ? (sel_lo >> jt) : (sel_hi >> (jt - 32))) & 1u; keep = bit != 0u;
               if (jt == diag) mask_tile(p0, p1, qpos - kb_ - 4 * c.hi, 0x40000000u); }
        if (MODE == 2) softmax_step_keep(p0, p1, m_reg, l_reg, alpha, keep); else softmax_step(p0, p1, m_reg, l_reg, alpha); pack_p(p0, p1, pa0, pa1, pa2, pa3); rescale_o(o, alpha, c);
        pv_tile(o, c.vb0 + bo, pa0, pa1, pa2, pa3);
        slot = slot == 2 ? 0 : slot + 1; slot2 = slot2 == 2 ? 0 : slot2 + 1; }
    ATT_BAR();
}
template <int MODE>
__device__ __forceinline__ void attn_loop(const Ctx& c, const bf16_t* Kg, int ldk, const bf16_t* Vg, int ldv, int j_lo, int NT, const bf16x8* qr,
                                          int qpos, int qlo, int W, unsigned sel_lo, unsigned sel_hi, int diag, f32x16* o, float& m_reg, float& l_reg) {
    f32x16 pA0, pA1, pB0, pB1; bf16x8 pa0, pa1, pa2, pa3; float alpha;
    const Dma d = make_dma(c, ldk, ldv);
    dma_tile(c, d, Kg, ldk, Vg, ldv, j_lo * 64, 0);
    if (NT > 1) { dma_tile(c, d, Kg, ldk, Vg, ldv, j_lo * 64 + 64, 1); asm volatile("s_waitcnt vmcnt(4)" ::: "memory"); } else asm volatile("s_waitcnt vmcnt(0)" ::: "memory");
    ATT_BAR();
    if (NT > 2) dma_tile(c, d, Kg, ldk, Vg, ldv, j_lo * 64 + 128, 2);
    SBAR(); qkt(pA0, pA1, c.K_lds, c.r32, c.hi, qr);
#define ATT_STEP(PX0, PX1, PY0, PY1, t_) do { const int t = (t_), jt = j_lo + t, kb_ = jt * 64;                                          \
        if (t + 1 < NT) { if (t + 2 < NT) asm volatile("s_waitcnt vmcnt(4)" ::: "memory"); else asm volatile("s_waitcnt vmcnt(0)" ::: "memory"); }     \
        ATT_BAR();                                                                           \
        if (t + 3 < NT) dma_tile(c, d, Kg, ldk, Vg, ldv, kb_ + 192, (t + 3) & 3);                           \
        SBAR(); if (t + 1 < NT) qkt(PY0, PY1, c.K_lds + ((t + 1) & 3) * TILE_B, c.r32, c.hi, qr);          \
        SBAR();                                                                                  \
        if (MODE == 0) { if (kb_ + 63 > qlo || kb_ <= qlo + 31 - W) mask_tile(PX0, PX1, qpos - kb_ - 4 * c.hi, (unsigned)W); }            \
        else { const unsigned bit = (jt < 32 ? (sel_lo >> jt) : (sel_hi >> (jt - 32))) & 1u; mask_all(PX0, PX1, bit != 0u);               \
               if (jt == diag) mask_tile(PX0, PX1, qpos - kb_ - 4 * c.hi, 0x40000000u); }                                                \
        softmax_step(PX0, PX1, m_reg, l_reg, alpha); pack_p(PX0, PX1, pa0, pa1, pa2, pa3); rescale_o(o, alpha, c);                        \
        pv_tile(o, c.vb0 + (t & 3) * TILE_B, pa0, pa1, pa2, pa3); } while (0)
    for (int t2 = 0; t2 < NT; t2 += 2) { ATT_STEP(pA0, pA1, pB0, pB1, t2); if (t2 + 1 < NT) ATT_STEP(pB0, pB1, pA0, pA1, t2 + 1); }
#undef ATT_STEP
    ATT_BAR();
}
__device__ __forceinline__ void load_q(bf16x8* qr, const bf16_t* qrow, int hi) {
#pragma unroll
    for (int d0 = 0; d0 < 8; ++d0) qr[d0] = *(const bf16x8*)(qrow + d0 * 16 + hi * 8);
    asm volatile("" :: "v"(qr[0]), "v"(qr[1]), "v"(qr[2]), "v"(qr[3]), "v"(qr[4]), "v"(qr[5]), "v"(qr[6]), "v"(qr[7]));
}
template <bool ADD, bool OUT8 = false>
__device__ __forceinline__ void store_o(const f32x16* o, float frow, const Ctx& c, bf16_t* Og, int ldo, float fold_row = 1.0f, bool has_fold = false, unsigned char* O8 = nullptr) {
    if (c.hi == 0) { c.wscr[c.r32] = frow; c.wscr[32 + c.r32] = fold_row; } LDS_WAIT();
    LAS float* stg = (LAS float*)(c.K_lds + c.wid * 16384);
#pragma unroll
    for (int r = 0; r < 16; ++r) { const int row = crow(r, c.hi); const float f = c.wscr[row];
#pragma unroll
        for (int d0 = 0; d0 < 4; ++d0) stg[row * 128 + d0 * 32 + c.r32] = o[d0][r] * f; }
    LDS_WAIT();
    const int cc = c.lane & 15, rq = c.lane >> 4;
#pragma unroll
    for (int hb = 0; hb < 8; hb += 4) {
        int hbv = hb; asm volatile("" : "+v"(hbv));
        u32x4 old[4];
        if (ADD) {
#pragma unroll
            for (int i = 0; i < 4; ++i) old[i] = *(const u32x4*)(Og + (size_t)(rq + 4 * (hbv + i)) * 1024 + cc * 8);
        }
#pragma unroll
        for (int i = 0; i < 4; ++i) { const int row = rq + 4 * (hbv + i);
            f32x4 v0 = *(const LAS f32x4*)(stg + row * 128 + cc * 8), v1 = *(const LAS f32x4*)(stg + row * 128 + cc * 8 + 4);
            if (ADD) { const float fo = has_fold ? c.wscr[32 + row] : 1.0f;
                v0[0] = fmaf(bf_lo(old[i].x), fo, v0[0]); v0[1] = fmaf(bf_hi(old[i].x), fo, v0[1]); v0[2] = fmaf(bf_lo(old[i].y), fo, v0[2]); v0[3] = fmaf(bf_hi(old[i].y), fo, v0[3]);
                v1[0] = fmaf(bf_lo(old[i].z), fo, v1[0]); v1[1] = fmaf(bf_hi(old[i].z), fo, v1[1]); v1[2] = fmaf(bf_lo(old[i].w), fo, v1[2]); v1[3] = fmaf(bf_hi(old[i].w), fo, v1[3]); }
            if constexpr (OUT8) { u32x2 w; w.x = cvt4_fp8(v0[0] * O8_SCALE, v0[1] * O8_SCALE, v0[2] * O8_SCALE, v0[3] * O8_SCALE); w.y = cvt4_fp8(v1[0] * O8_SCALE, v1[1] * O8_SCALE, v1[2] * O8_SCALE, v1[3] * O8_SCALE);
                *(u32x2*)(O8 + (size_t)row * ldo + cc * 8) = w; }
            else { u32x4 w; w.x = cvt_pk_bf16(v0[0], v0[1]); w.y = cvt_pk_bf16(v0[2], v0[3]); w.z = cvt_pk_bf16(v1[0], v1[1]); w.w = cvt_pk_bf16(v1[2], v1[3]);
                *(u32x4*)(Og + (size_t)row * ldo + cc * 8) = w; } }
        asm volatile("" ::: "memory");
    }
    LDS_WAIT();
}
}

struct Frame {
    LAS unsigned char* lds; volatile LAS unsigned* misc; unsigned* ctl;
    int tid, lane, wave, G, vcu;
    const float* const* in; float* out; unsigned char* ws;
};
__device__ __forceinline__ void launder(Frame& F) { unsigned long long w_ = (unsigned long long)F.ws; asm volatile("" : "+s"(w_)); F.ws = (unsigned char*)(GAS unsigned char*)w_; F.out = (float*)(GAS float*)F.out; F.ctl = (unsigned*)(GAS unsigned*)F.ctl; asm volatile("" : "+v"(F.tid)); F.lane = F.tid & 63; F.wave = __builtin_amdgcn_readfirstlane(F.tid >> 6); }
enum { IN_X = 0, IN_ANORM, IN_WIN, IN_SINK, IN_PEK, IN_PEV, IN_WK1, IN_WK2, IN_WV1, IN_WV2, IN_WUPA, IN_WUPB, IN_WO, IN_FNORM, IN_DWG, IN_DWU, IN_DWD, IN_RW, IN_MWG, IN_MWU, IN_MWD, IN_FINAL };
#define INP(i) ((const float*)(const GAS float*)F.in[i])
#define WSP(T_, off) ((T_*)(F.ws + (off)))
#define BGP(T_, off) ((T_*)(F.ws + WS_BIG + (off)))

__device__ __forceinline__ int queue_pop(Frame& F, int q) {
    __syncthreads();
    if (F.tid == 0) F.misc[2] = __hip_atomic_fetch_add(F.ctl + CW_QUEUE + 64 * q, 1u, RLX_AGENT);
    __syncthreads();
    return (int)F.misc[2];
}

__device__ __forceinline__ int tr_drow(int mode, int n, int nn) {
    if (mode == 0) return n;
    if (mode == 1) { if (n < 4096) { const int d = n & 127; return (n & ~127) + 32 * ((d >> 4) & 3) + 8 * ((d >> 2) & 3) + 4 * (d >> 6) + (d & 3); }
                     return n < 4120 ? 8192 + (n - 4096) : 4096 + (n - 4120); }
    return 256 * (n >> 7) + 128 * nn + (n & 127);
}
__device__ __forceinline__ void tr_item(int mode, int nn, const float* W, int ld, int nsrc, const float* gain, int K, bf16_t* WT, int item, int nblk, int lane) {
    const int kb = item / nblk, nb = item - kb * nblk, kg = lane & 7, nq = lane >> 3, k0 = 64 * kb + 8 * kg, n = 32 * nb + 4 * nq;
    if (n >= nsrc) return;
    const float* p = W + (size_t)k0 * ld + n; f32x4 v[8];
#pragma unroll
    for (int j = 0; j < 8; ++j) v[j] = __builtin_nontemporal_load((const f32x4*)(p + (size_t)j * ld));
    if (gain) { const f32x4 g0 = *(const f32x4*)(gain + k0), g1 = *(const f32x4*)(gain + k0 + 4);
#pragma unroll
        for (int j = 0; j < 4; ++j) { v[j] = v[j] * g0[j]; v[4 + j] = v[4 + j] * g1[j]; } }
    const int c = tr_drow(mode, n, nn);
#pragma unroll
    for (int q = 0; q < 4; ++q) { u32x4 o; o.x = cvt_pk_bf16(v[0][q], v[1][q]); o.y = cvt_pk_bf16(v[2][q], v[3][q]); o.z = cvt_pk_bf16(v[4][q], v[5][q]); o.w = cvt_pk_bf16(v[6][q], v[7][q]);
        *(u32x4*)(WT + (size_t)(c + q) * K + k0) = o; }
}
__device__ __forceinline__ void tr_item8(int mode, int nn, const float* W, int ld, int nsrc, const float* gain, float scale, int K, unsigned char* WT, int item, int nblk, int lane) {
    const int kb = item / nblk, nb = item - kb * nblk, kg = lane & 7, nq = lane >> 3, k0 = 128 * kb + 16 * kg, n = 32 * nb + 4 * nq;
    if (n >= nsrc) return;
    const float* p = W + (size_t)k0 * ld + n; f32x4 v[16];
#pragma unroll
    for (int j = 0; j < 16; ++j) v[j] = __builtin_nontemporal_load((const f32x4*)(p + (size_t)j * ld));
#pragma unroll
    for (int j4 = 0; j4 < 4; ++j4) { f32x4 g = {scale, scale, scale, scale}; if (gain) g = *(const f32x4*)(gain + k0 + 4 * j4) * scale;
#pragma unroll
        for (int j = 0; j < 4; ++j) v[4 * j4 + j] = v[4 * j4 + j] * g[j]; }
    const int c = tr_drow(mode, n, nn);
#pragma unroll
    for (int q = 0; q < 4; ++q) { u32x4 o; o.x = cvt4_fp8(v[0][q], v[1][q], v[2][q], v[3][q]); o.y = cvt4_fp8(v[4][q], v[5][q], v[6][q], v[7][q]); o.z = cvt4_fp8(v[8][q], v[9][q], v[10][q], v[11][q]); o.w = cvt4_fp8(v[12][q], v[13][q], v[14][q], v[15][q]);
        __builtin_nontemporal_store(o, (u32x4*)(WT + (size_t)(c + q) * K + k0)); }
}
__device__ __forceinline__ void p_prologue(Frame F) {
    launder(F);
    const int gw = F.vcu * NWAVES + F.wave, NGW = F.G * NWAVES, lane = F.lane;
    constexpr int NB_IN = (IN_DIM + 31) / 32;
    { long long* cb = WSP(long long, WS_CBIAS);
      for (int u = gw; u < 1024; u += NGW) { const int q = u >> 8, l = q >> 1, kv = q & 1, nb = (u >> 6) & 3, kc = u & 63, n = nb * 64 + lane;
          const float* pe = INP(kv ? IN_PEV : IN_PEK) + (size_t)l * 4096 + kc * 64; const float* w1 = INP(kv ? IN_WV1 : IN_WK1) + (size_t)l * 4096 * 256 + (size_t)kc * 64 * 256 + n;
          float wv[64];
#pragma unroll
          for (int k = 0; k < 64; ++k) wv[k] = w1[(size_t)k * 256];
          float a0 = 0.f, a1 = 0.f, a2 = 0.f, a3 = 0.f;
#pragma unroll
          for (int k = 0; k < 64; k += 4) { a0 = fmaf(pe[k], wv[k], a0); a1 = fmaf(pe[k + 1], wv[k + 1], a1); a2 = fmaf(pe[k + 2], wv[k + 2], a2); a3 = fmaf(pe[k + 3], wv[k + 3], a3); }
          const float sum = (a0 + a1) + (a2 + a3);
          atomicAdd((unsigned long long*)(cb + q * 256 + n), (unsigned long long)(long long)rintf(sum * CB_SCALE)); } }
    constexpr int I_WIN = (D / 128) * NB_IN, I_W1 = (4096 / 64) * (256 / 32), I_W2 = (256 / 64) * (128 / 32), I_WUP = (1024 / 128) * (D / 32), I_WO = (D / 128) * (D / 32);
    {   constexpr int BI_G = (D / 128) * (FF / 256), BI_D = (FF / 128) * (D / 256), NBI = 16 * BI_G + 9 * BI_D;
        LAS unsigned char* tile = F.lds;
        for (int bi = F.vcu; bi < NBI; bi += F.G) {
            const float* W; const float* gain = nullptr; float scale; unsigned char* dst; int ld, Kd, mode = 0, nn = 0, kb, nb;
            if (bi < 16 * BI_G) { const int q = bi / BI_G, r = bi - q * BI_G, e = q >> 1; nn = q & 1; mode = 2; W = INP(nn ? IN_MWU : IN_MWG) + (size_t)e * D * FF; ld = FF; gain = INP(IN_FNORM) + D; scale = WGU8_SCALE;
                dst = WSP(unsigned char, WS_WGUM + (size_t)e * SZ_WGU8); Kd = D; kb = r / (FF / 256); nb = r - kb * (FF / 256); }
            else { const int r0 = bi - 16 * BI_G, e = r0 / BI_D, r = r0 - e * BI_D; ld = D; scale = WD8_SCALE;
                if (e < 8) { W = INP(IN_MWD) + (size_t)e * FF * D; dst = WSP(unsigned char, WS_WDM + (size_t)e * SZ_WD8); } else { W = INP(IN_DWD); dst = WSP(unsigned char, WS_WDD); }
                Kd = FF; kb = r / (D / 256); nb = r - kb * (D / 256); }
            const int k0 = 128 * kb + 16 * F.wave, n = 256 * nb + 4 * lane;
            const float* p = W + (size_t)k0 * ld + n; f32x4 v[16];
#pragma unroll
            for (int j = 0; j < 16; ++j) v[j] = __builtin_nontemporal_load((const f32x4*)(p + (size_t)j * ld));
#pragma unroll
            for (int j = 0; j < 16; ++j) { const float g = gain ? gain[k0 + j] * scale : scale; v[j] = v[j] * g; }
#pragma unroll
            for (int q = 0; q < 4; ++q) { u32x4 o; o.x = cvt4_fp8(v[0][q], v[1][q], v[2][q], v[3][q]); o.y = cvt4_fp8(v[4][q], v[5][q], v[6][q], v[7][q]); o.z = cvt4_fp8(v[8][q], v[9][q], v[10][q], v[11][q]); o.w = cvt4_fp8(v[12][q], v[13][q], v[14][q], v[15][q]);
                *(LAS u32x4*)(tile + (4 * lane + q) * 144 + 16 * F.wave) = o; }
            __syncthreads();
#pragma unroll
            for (int i = 0; i < 4; ++i) { const int nrow = 32 * F.wave + 8 * i + (lane >> 3), ch = lane & 7;
                const u32x4 o = *(const LAS u32x4*)(tile + nrow * 144 + 16 * ch);
                __builtin_nontemporal_store(o, (u32x4*)(dst + (size_t)tr_drow(mode, 256 * nb + nrow, nn) * Kd + 128 * kb + 16 * ch)); }
            __syncthreads();
        }
    }
    constexpr int I_G = (D / 64) * (FF / 32);
    constexpr int NITEMS = 2 * I_WIN + 4 * I_W1 + 4 * I_W2 + 4 * I_WUP + 2 * I_WO + 2 * I_G;
    for (int it = gw; it < NITEMS; it += NGW) {
        int r = it;
        if (r < 2 * I_G) { const int nn = r / I_G; r -= nn * I_G;
            tr_item(2, nn, INP(nn ? IN_DWU : IN_DWG), FF, FF, INP(IN_FNORM), D, WSP(bf16_t, WS_WGUD), r, FF / 32, lane); continue; } r -= 2 * I_G;
        if (r < 2 * I_WIN) { const int l = r / I_WIN; r -= l * I_WIN;
            tr_item8(1, 0, INP(IN_WIN) + (size_t)l * D * IN_DIM, IN_DIM, IN_DIM, INP(IN_ANORM) + l * D, WIN8_SCALE, D, WSP(unsigned char, WS_WIN + l * SZ_WIN), r, NB_IN, lane); continue; } r -= 2 * I_WIN;
        if (r < 4 * I_W1) { const int q = r / I_W1; r -= q * I_W1; const int l = q >> 1, kv = q & 1;
            tr_item(0, 0, INP(kv ? IN_WV1 : IN_WK1) + (size_t)l * 4096 * 256, 256, 256, nullptr, 4096, WSP(bf16_t, WS_W1 + q * SZ_W1), r, 256 / 32, lane); continue; } r -= 4 * I_W1;
        if (r < 4 * I_W2) { const int q = r / I_W2; r -= q * I_W2; const int l = q >> 1, kv = q & 1;
            tr_item(0, 0, INP(kv ? IN_WV2 : IN_WK2) + (size_t)l * 256 * 128, 128, 128, nullptr, 256, WSP(bf16_t, WS_W2 + q * SZ_W2), r, 128 / 32, lane); continue; } r -= 4 * I_W2;
        if (r < 4 * I_WUP) { const int q = r / I_WUP; r -= q * I_WUP; const int l = q >> 1, ab = q & 1;
            tr_item8(0, 0, INP(ab ? IN_WUPB : IN_WUPA) + (size_t)l * 1024 * D, D, D, nullptr, WUP8_SCALE, 1024, WSP(unsigned char, WS_WUP + q * SZ_WUP), r, D / 32, lane); continue; } r -= 4 * I_WUP;
        { const int l = r / I_WO; r -= l * I_WO;
            tr_item8(0, 0, INP(IN_WO) + (size_t)l * D * D, D, D, nullptr, WO8_SCALE, D, WSP(unsigned char, WS_WO + l * SZ_WO), r, D / 32, lane); }
    }
    { const int gt = gw * 64 + lane, NGT = NGW * 64; const u32x4 z = {0u, 0u, 0u, 0u};
      for (int i = gt; i < 2 * (NIN - IN_DIM) * (D / 16); i += NGT) { const int l = i / ((NIN - IN_DIM) * (D / 16)), j = i - l * ((NIN - IN_DIM) * (D / 16)); *((u32x4*)(WSP(unsigned char, WS_WIN + l * SZ_WIN) + (size_t)IN_DIM * D) + j) = z; }
      for (int i = gt; i < 4 * 128 * (256 / 8); i += NGT) { const int q = i / (128 * 32), j = i - q * (128 * 32); *((u32x4*)(WSP(bf16_t, WS_W2 + q * SZ_W2) + (size_t)128 * 256) + j) = z; } }
    { const float* x = INP(IN_X); unsigned char* x8 = WSP(unsigned char, WS_X8); u64* rsq = WSP(u64, WS_RSQ);
      for (int m = gw; m < M; m += NGW) { const f32x4* xr = (const f32x4*)(x + (size_t)m * D) + lane; f32x4 v[8]; float s = 0.f;
#pragma unroll
          for (int j = 0; j < 8; ++j) { v[j] = xr[64 * j]; s += (v[j][0] * v[j][0] + v[j][1] * v[j][1]) + (v[j][2] * v[j][2] + v[j][3] * v[j][3]); }
          s = wave_sum(s); if (lane == 0) rsq[m] = (u64)(s * RSQ_SCALE + 0.5f);
          unsigned* o4 = (unsigned*)(x8 + (size_t)m * D) + lane;
#pragma unroll
          for (int j = 0; j < 8; ++j) o4[64 * j] = cvt4_fp8(v[j][0], v[j][1], v[j][2], v[j][3]); } }
    { float* cosT = WSP(float, WS_ROPE); float* sinT = cosT + T * 64; const int gt = gw * 64 + lane, NGT = NGW * 64;
      for (int i = gt; i < T * 64; i += NGT) { const int t = i >> 6, d = i & 63; const float inv = (float)exp(-9.210340371976184 * (double)d / 64.0); const float ang = (float)t * inv;
          cosT[i] = (float)cos((double)ang); sinT[i] = (float)sin((double)ang); } }
}

__device__ __forceinline__ void p_attn_a(Frame F, int layer) {
    launder(F);
    bf16_t* QKV = BGP(bf16_t, BG_QKV); const bf16_t* NGb = BGP(bf16_t, BG_NG);
#ifndef NO_CMP
    if (blockIdx.x < 16) {
        const int kv = blockIdx.x >> 3, pm = blockIdx.x & 7, q = layer * 2 + kv;
        bf16_t* H = BGP(bf16_t, BG_HC) + (size_t)kv * 2048 * 256;
        { pg8::SchedOne S{BGP(bf16_t, kv ? BG_VCB : BG_KCB), WSP(bf16_t, WS_W1 + q * SZ_W1), 2048 * 2, 4096 * 2, pm, 0};
          pg8::EpiCmp1 E{H, WSP(long long, WS_CBIAS) + q * 256};
          pg8::gemm_phase<false>(F.lds, 4096 * 2, S, E); }
        VM_WAIT(); __syncthreads(); __builtin_amdgcn_fence(__ATOMIC_ACQUIRE, "agent"); VM_WAIT(); __syncthreads();
        { pg8::SchedOne S{H, WSP(bf16_t, WS_W2 + q * SZ_W2), 256 * 2, 256 * 2, pm, 0};
          pg8::EpiCmp2 E{BGP(bf16_t, kv ? BG_VCMP : BG_KCMP)};
          pg8::gemm_phase<false>(F.lds, 256 * 2, S, E); }
        __syncthreads();
    }
#endif
    const att::Ctx c = att::make_ctx(F.lds);
    const float* sinks = INP(IN_SINK) + layer * 8;
    const int nstat = (int)F.G - 16; bool first = blockIdx.x >= 16;
    for (;;) {
        int u = first ? (int)blockIdx.x - 16 : nstat + queue_pop(F, layer * 2 + 0); first = false; if (u >= 1024 + 64) break;
        if (u < 64) {
            pg8::SchedOne S{WSP(unsigned char, WS_X8), WSP(unsigned char, WS_WIN + layer * SZ_WIN), D, D, u, 32};
            pg8::EpiIn E{BGP(bf16_t, BG_QKV), BGP(bf16_t, BG_KCB), BGP(bf16_t, BG_VCB), BGP(bf16_t, BG_GM), BGP(bf16_t, BG_NG), WSP(u64, WS_RSQ) + (2 * layer) * M, WSP(float, WS_ROPE), WSP(float, WS_ROPE) + T * 64, 1.0f / WIN8_SCALE, F.lds + LDS_WSCR};
            pg8::gemm_phase<true>(F.lds, D, S, E); __syncthreads(); continue; }
        u -= 64;
        const bool swa = u >= 512; const int v = u & 511, qt = 63 - (v >> 3), bg = v & 7, b = bg >> 1, g = bg & 1;
        const int t0 = qt * 64, h = 4 * g + (c.wid >> 1), trow = t0 + 32 * (c.wid & 1);
        const size_t rowbase = (size_t)b * T;
        const int qcol = (swa ? 0 : 1536) + h * HD, kcol = (swa ? 1024 : 3584) + g * HD, vcol = (swa ? 1280 : 3840) + g * HD, W = swa ? 128 : 512;
        bf16x8 qr[8]; att::load_q(qr, QKV + (rowbase + trow + c.r32) * 4096 + qcol, c.hi);
        const int j_lo = (t0 - W + 1) > 0 ? (t0 - W + 1) / 64 : 0, NT = qt - j_lo + 1;
        f32x16 o[4] = {}; float m_reg = -1e30f, l_reg = 0.f;
        if (c.wid >= 4) __builtin_amdgcn_s_setprio(1);
        att::attn_loop<0>(c, QKV + rowbase * 4096 + kcol, 4096, QKV + rowbase * 4096 + vcol, 4096, j_lo, NT, qr, trow + c.r32, trow, W, 0u, 0u, -1, o, m_reg, l_reg);
        if (c.wid >= 4) __builtin_amdgcn_s_setprio(0);
        float f;
        if (swa) { const float lt = l_reg + __builtin_amdgcn_exp2f(sinks[h] * att::LOG2E - m_reg * att::C2); f = 1.0f / lt; }
        else f = 1.0f / l_reg;
        if (swa) att::store_o<false, true>(o, f, c, nullptr, 1024, 1.0f, false, BGP(unsigned char, BG_OA) + (rowbase + trow) * 1024 + h * HD);
        else att::store_o<false>(o, f, c, BGP(bf16_t, BG_OB) + (rowbase + trow) * 1024 + h * HD, 1024);
    }
}

__device__ __forceinline__ void p_attn_b(Frame F, int layer) {
    launder(F);
    const bf16_t* QKV = BGP(bf16_t, BG_QKV); const bf16_t* NGb = BGP(bf16_t, BG_NG);
    const att::Ctx c = att::make_ctx(F.lds);
    LAS unsigned* IMP = (LAS unsigned*)(F.lds + LDS_IMP);
    volatile LAS unsigned* SELM = (volatile LAS unsigned*)(F.lds + LDS_SELM);
    bool first = true;
    for (;;) {
        const int u = first ? (int)blockIdx.x : (int)F.G + queue_pop(F, layer * 2 + 1); first = false; if (u >= 512) break;
        const int qt = 63 - (u >> 3), bg = u & 7, b = bg >> 1, g = bg & 1;
        const int t0 = qt * 64, h = 4 * g + (c.wid >> 1), trow = t0 + 32 * (c.wid & 1), tl = 32 * (c.wid & 1) + c.r32;
        const size_t rowbase = (size_t)b * T; const int pos = trow + c.r32;
        for (int i = c.tid; i < 64 * 65; i += NTHREADS) IMP[i] = 0u;
        bf16x8 qr[8]; att::load_q(qr, QKV + (rowbase + pos) * 4096 + 1536 + h * HD, c.hi);
        const int maxc = (t0 + 63 - 31) >> 4, NTc = (maxc >> 6) + 1;
        const bf16_t* Kc = BGP(bf16_t, BG_KCMP) + (size_t)bg * 256 * HD; const bf16_t* Vc = BGP(bf16_t, BG_VCMP) + (size_t)bg * 256 * HD;
        { const att::Dma dc = att::make_dma(c, HD, HD); for (int j = 0; j < NTc; ++j) att::dma_tile(c, dc, Kc, HD, Vc, HD, j * 64, j); }
        VM_WAIT(); __syncthreads();
        const int cpos = (pos - 31) >> 4;
        float m_reg = -1e30f, l_reg = 0.f;
        {
            f32x16 p0, p1; float alpha;
#pragma unroll 1
            for (int J = 0; J < NTc; ++J) { att::qkt(p0, p1, c.K_lds + J * att::TILE_B, c.r32, c.hi, qr); att::mask_tile(p0, p1, cpos - J * 64 - 4 * c.hi, 0x40000000u); att::softmax_step(p0, p1, m_reg, l_reg, alpha); }
        }
        f32x16 o[4] = {};
        {
            const float inv_l = l_reg > 0.f ? 1.0f / l_reg : 0.f, mnL = -m_reg * att::C2; f32x16 p0, p1; bf16x8 pa0, pa1, pa2, pa3;
#pragma unroll 1
            for (int J = 0; J < NTc; ++J) { att::qkt(p0, p1, c.K_lds + J * att::TILE_B, c.r32, c.hi, qr); att::mask_tile(p0, p1, cpos - J * 64 - 4 * c.hi, 0x40000000u);
#pragma unroll
                for (int r = 0; r < 16; ++r) { p0[r] = __builtin_amdgcn_exp2f(fmaf(p0[r], att::C2, mnL)) * inv_l; p1[r] = __builtin_amdgcn_exp2f(fmaf(p1[r], att::C2, mnL)) * inv_l; }
                LAS unsigned* irow = IMP + tl * 65 + J * 16 + c.hi; constexpr float IS = 67108864.0f;
#pragma unroll
                for (int jj = 0; jj < 4; ++jj) {
                    atomicAdd((unsigned*)(irow + 2 * jj), (unsigned)((p0[4 * jj] + p0[4 * jj + 1] + p0[4 * jj + 2] + 0.5f * p0[4 * jj + 3]) * IS + 0.5f)); atomicAdd((unsigned*)(irow + 2 * jj + 1), (unsigned)(0.5f * p0[4 * jj + 3] * IS + 0.5f));
                    atomicAdd((unsigned*)(irow + 2 * jj + 8), (unsigned)((p1[4 * jj] + p1[4 * jj + 1] + p1[4 * jj + 2] + 0.5f * p1[4 * jj + 3]) * IS + 0.5f)); atomicAdd((unsigned*)(irow + 2 * jj + 9), (unsigned)(0.5f * p1[4 * jj + 3] * IS + 0.5f)); }
                att::pack_p(p0, p1, pa0, pa1, pa2, pa3); att::pv_tile(o, c.vb0 + J * att::TILE_B, pa0, pa1, pa2, pa3); }
        }
        bf16_t* Og = BGP(bf16_t, BG_OB) + (rowbase + trow) * 1024 + h * HD;
        __syncthreads();
        { const float g0 = bf2f(NGb[(rowbase + pos) * 32 + h * 3 + 0]), g2 = bf2f(NGb[(rowbase + pos) * 32 + h * 3 + 2]); att::store_o<true>(o, g0, c, Og, 1024, g2, true); }
        for (int i = 0; i < 8; ++i) { const int tk = c.wid * 8 + i, s = c.lane; volatile LAS unsigned* row = (volatile LAS unsigned*)IMP + tk * 65;
            const unsigned raw = row[s]; const bool forced = (s == 0) | (s == qt) | (s == qt - 1), valid = s <= qt;
            unsigned key = ((((raw >> 6) + 1u) << 6) | (unsigned)(63 - s)); key = forced ? (0xFFFFFFC0u | (unsigned)(63 - s)) : key; key = valid ? key : 0u;
            row[s] = key; LDS_WAIT();
            int rank = 0;
#pragma unroll 16
            for (int j = 0; j < 64; ++j) rank += (row[j] > key) ? 1 : 0;
            const unsigned long long bal = __ballot(rank < 16 && key != 0u);
            if (c.lane == 0) { SELM[2 * tk] = (unsigned)bal; SELM[2 * tk + 1] = (unsigned)(bal >> 32); } }
        __syncthreads();
        const unsigned sel_lo = SELM[2 * tl], sel_hi = SELM[2 * tl + 1];
#pragma unroll
        for (int d = 0; d < 4; ++d) o[d] = f32x16{};
        m_reg = -1e30f; l_reg = 0.f;
if (c.wid >= 4) __builtin_amdgcn_s_setprio(1);
                att::attn_loop_simple<2>(c, QKV + rowbase * 4096 + 3072 + g * HD, 4096, QKV + rowbase * 4096 + 3328 + g * HD, 4096, 0, qt + 1, qr, pos, trow, 0, sel_lo, sel_hi, qt, o, m_reg, l_reg);
        if (c.wid >= 4) __builtin_amdgcn_s_setprio(0);
        { const float g1 = bf2f(NGb[(rowbase + pos) * 32 + h * 3 + 1]); VM_WAIT(); att::store_o<true, true>(o, g1 / l_reg, c, Og, 1024, 1.0f, false, BGP(unsigned char, BG_OA) + (size_t)M * 1024 + (rowbase + trow) * 1024 + h * HD); }
    }
}

__device__ __forceinline__ void p_router(Frame F) {
    launder(F);
    LAS float* wr = (LAS float*)F.lds;
    const float* rw = INP(IN_RW); const float* gain = INP(IN_FNORM) + D;
    for (int i = F.tid; i < D * 8; i += NTHREADS) wr[i] = rw[i] * gain[i >> 3];
    LAS int* te = (LAS int*)(F.lds + 65536); LAS float* tw = (LAS float*)(F.lds + 65536 + 1024);
    const bf16_t* XB = WSP(bf16_t, WS_XBF); const u64* rsq = WSP(u64, WS_RSQ) + 3 * M;
    int* ltok = WSP(int, WS_LTOK); float* lw = WSP(float, WS_LW); int* slot = WSP(int, WS_SLOT);
    for (int chunk = blockIdx.x; chunk < M / 64; chunk += F.G) {
        __syncthreads();
        for (int i = 0; i < 8; ++i) { const int tl = F.wave * 8 + i, tok = chunk * 64 + tl;
            const u32x2* xr = (const u32x2*)(XB + (size_t)tok * D) + F.lane; float a[8] = {0.f, 0.f, 0.f, 0.f, 0.f, 0.f, 0.f, 0.f};
#pragma unroll
            for (int j = 0; j < 8; ++j) { const u32x2 xw = xr[64 * j]; const f32x4 x = {bf_lo(xw.x), bf_hi(xw.x), bf_lo(xw.y), bf_hi(xw.y)}; const int k = 4 * (F.lane + 64 * j);
#pragma unroll
                for (int q = 0; q < 4; ++q) { const f32x4 w0 = *(const LAS f32x4*)(wr + (k + q) * 8), w1 = *(const LAS f32x4*)(wr + (k + q) * 8 + 4);
                    a[0] = fmaf(x[q], w0[0], a[0]); a[1] = fmaf(x[q], w0[1], a[1]); a[2] = fmaf(x[q], w0[2], a[2]); a[3] = fmaf(x[q], w0[3], a[3]);
                    a[4] = fmaf(x[q], w1[0], a[4]); a[5] = fmaf(x[q], w1[1], a[5]); a[6] = fmaf(x[q], w1[2], a[6]); a[7] = fmaf(x[q], w1[3], a[7]); } }
            const float rstd = rstd_of(rsq, tok);
#pragma unroll
            for (int e = 0; e < 8; ++e) a[e] = wave_sum(a[e]) * rstd;
            int e1 = 0; float l1 = a[0];
#pragma unroll
            for (int e = 1; e < 8; ++e) if (a[e] > l1) { l1 = a[e]; e1 = e; }
            int e2 = -1; float l2 = -3.0e38f;
#pragma unroll
            for (int e = 0; e < 8; ++e) if (e != e1 && a[e] > l2) { l2 = a[e]; e2 = e; }
            const float ex = __expf(l2 - l1), w1 = 1.0f / (1.0f + ex), w2 = ex * w1;
            if (F.lane == 0) { te[tl] = e1; te[64 + tl] = e2; tw[tl] = w1; tw[64 + tl] = w2; } }
        __syncthreads();
        if (F.wave == 0) { const int tl = F.lane, tok = chunk * 64 + tl, e1 = te[tl], e2 = te[64 + tl]; const float w1 = tw[tl], w2 = tw[64 + tl];
            const unsigned long long lt = (1ull << tl) - 1ull;
            int myn = 0;
#pragma unroll
            for (int e = 0; e < 8; ++e) { const int n = __popcll(__ballot(e1 == e)) + __popcll(__ballot(e2 == e)); if (tl == e) myn = n; }
            int mybase = 0; if (tl < 8 && myn > 0) mybase = (int)__hip_atomic_fetch_add(F.ctl + CW_ECNT + 64 * tl, (unsigned)myn, RLX_AGENT);
#pragma unroll
            for (int e = 0; e < 8; ++e) { const unsigned long long m1 = __ballot(e1 == e), m2 = __ballot(e2 == e); const int n1 = __popcll(m1);
                const int base = __shfl(mybase, e);
                if (e1 == e) { const int p = base + __popcll(m1 & lt); ltok[e * M + p] = tok; lw[e * M + p] = w1; slot[2 * tok] = (e << 20) | p; }
                if (e2 == e) { const int p = base + n1 + __popcll(m2 & lt); ltok[e * M + p] = tok; lw[e * M + p] = w2; slot[2 * tok + 1] = (e << 20) | p; } } }
    }
}
__device__ __forceinline__ void moe_counts(Frame& F) {
    __syncthreads();
    if (F.tid < 64) {
        int cnt = 0; if (F.tid < NE) cnt = (int)__hip_atomic_load(F.ctl + CW_ECNT + 64 * F.tid, RLX_AGENT);
        const int tiles = (cnt + 255) >> 8; int incl = tiles;
#pragma unroll
        for (int d = 1; d < 8; d <<= 1) { const int t = __shfl_up(incl, d); if (F.tid >= d) incl += t; }
        if (F.tid < NE) { F.misc[8 + F.tid] = (unsigned)cnt; F.misc[16 + F.tid] = (unsigned)(incl - tiles); }
        const int acc = __shfl(incl, NE - 1);
        if (F.tid == 0) { F.misc[24] = (unsigned)acc;
            int per_round = F.G / (D / 256); asm volatile("" : "+v"(per_round));
            const int tm = (acc / per_round) * per_round, tu = (acc - tm) * (D / 256);
            F.misc[25] = (unsigned)tm; F.misc[26] = (tu > 0 && tu * 4 <= F.G) ? 4u : ((tu > 0 && tu * 2 <= F.G) ? 2u : 1u); } }
    __syncthreads();
}
__device__ __forceinline__ void p_final(Frame F) {
    launder(F);
    moe_counts(F);
    const int gw = F.vcu * NWAVES + F.wave, NGW = F.G * NWAVES, lane = F.lane;
    const bf16_t* XB = WSP(bf16_t, WS_XBF); const bf16_t* YS = WSP(bf16_t, WS_YS); const int* slot = WSP(int, WS_SLOT); const float* gf = INP(IN_FINAL);
    const int Tm = (int)F.misc[25], S = (int)F.misc[26]; const bf16_t* YT = BGP(bf16_t, BG_YT);
    for (int m = gw; m < M; m += NGW) {
        const int s0 = slot[2 * m], s1 = slot[2 * m + 1];
        const size_t r0 = (size_t)F.misc[16 + (s0 >> 20)] * 256 + (s0 & 0xfffff), r1 = (size_t)F.misc[16 + (s1 >> 20)] * 256 + (s1 & 0xfffff);
        const u32x2* xr = (const u32x2*)(XB + (size_t)m * D) + lane;
        f32x4 v[8];
#pragma unroll
        for (int j = 0; j < 8; ++j) { const u32x2 a = xr[64 * j]; v[j] = f32x4{bf_lo(a.x), bf_hi(a.x), bf_lo(a.y), bf_hi(a.y)}; }
#pragma unroll
        for (int q = 0; q < 2; ++q) { const size_t r = q ? r1 : r0; const bool tail = (int)(r >> 8) >= Tm;
            const bf16_t* base = tail ? YT + (r - (size_t)Tm * 256) * D : YS + r * D; const int nrep = tail ? S : 1;
            for (int k = 0; k < nrep; ++k) { const u32x2* y = (const u32x2*)(base + (size_t)k * YT_ROWS * D) + lane;
#pragma unroll
                for (int j = 0; j < 8; ++j) { const u32x2 a = y[64 * j]; v[j][0] += bf_lo(a.x); v[j][1] += bf_hi(a.x); v[j][2] += bf_lo(a.y); v[j][3] += bf_hi(a.y); } } }
        float s = 0.f;
#pragma unroll
        for (int j = 0; j < 8; ++j) s += (v[j][0] * v[j][0] + v[j][1] * v[j][1]) + (v[j][2] * v[j][2] + v[j][3] * v[j][3]);
        const float rstd = rsqrtf(wave_sum(s) * (1.0f / D) + NORM_EPS);
        f32x4* o = (f32x4*)(F.out + (size_t)m * D) + lane; const f32x4* gp = (const f32x4*)gf + lane;
#pragma unroll
        for (int j = 0; j < 8; ++j) o[64 * j] = v[j] * rstd * gp[64 * j];
    }
}

#ifndef MK_SPLIT
#define MK_SPLIT 0
#endif
constexpr int NPHASE = 17;
struct Args { const float* in[22]; float* out; unsigned char* ws; int ph_lo, ph_hi, li, pad; };
__global__ void __launch_bounds__(NTHREADS, 2) mega_fwd(Args args) {
    extern __shared__ __attribute__((aligned(16))) unsigned char lds_raw[];
    Frame F0;
    F0.lds = (LAS unsigned char*)lds_raw; F0.misc = (volatile LAS unsigned*)(F0.lds + LDS_MISC);
    F0.tid = threadIdx.x; F0.lane = F0.tid & 63; F0.wave = __builtin_amdgcn_readfirstlane(F0.tid >> 6);
    F0.G = gridDim.x; { const int bx = blockIdx.x; F0.vcu = (F0.G % 8 == 0) ? (bx % 8) * (F0.G / 8) + bx / 8 : bx; }
    F0.in = args.in;
    F0.out = args.out; F0.ws = args.ws; F0.ctl = (unsigned*)(args.ws + WS_CTL);
    if (F0.tid < 64) F0.misc[F0.tid] = 0u;
    __syncthreads();
    XcdBarrier bar = xcd_barrier_post(F0.ctl + CW_BAR + args.li * XCD_BAR_WORDS, F0.misc);
    const int lo = args.ph_lo, hi = args.ph_hi;
#ifndef PHMASK
#define PHMASK 0x1ffff
#endif
#define IN(k) (((PHMASK >> ((k) > 7 && (k) < 13 ? (k) - 7 : (k))) & 1) && lo <= (k) && (k) < hi)
#define SEAM(k) do { if (IN(k) && IN((k) + 1)) { XcdBarrier b2 = bar; asm volatile("" : "+s"(b2.bar)); xcd_barrier(b2); } } while (0)

    if (IN(0)) p_prologue(F0);
    SEAM(0);
    for (int layer = 0; layer < 2; ++layer) {
        const int pb = 1 + 7 * layer;
        if (IN(pb)) { Frame F = F0; launder(F); u64* rsq = WSP(u64, WS_RSQ);
            pg8::SchedDense S{WSP(unsigned char, WS_X8), WSP(unsigned char, WS_WIN + layer * SZ_WIN), D, D, M / 256, 32, F.G, (int)blockIdx.x};
            pg8::EpiIn E{BGP(bf16_t, BG_QKV), BGP(bf16_t, BG_KCB), BGP(bf16_t, BG_VCB), BGP(bf16_t, BG_GM), BGP(bf16_t, BG_NG), rsq + (2 * layer) * M, WSP(float, WS_ROPE), WSP(float, WS_ROPE) + T * 64, 1.0f / WIN8_SCALE, F.lds + LDS_WSCR};
            pg8::gemm_phase<true>(F.lds, D, S, E);
        }
        SEAM(pb);
        if (IN(pb + 1)) p_attn_a(F0, layer);
        SEAM(pb + 1);
        if (IN(pb + 2)) p_attn_b(F0, layer);
        SEAM(pb + 2);
        if (IN(pb + 3)) { Frame F = F0; launder(F);
            pg8::SchedSeg2 S{BGP(unsigned char, BG_OA), WSP(unsigned char, WS_WUP + (2 * layer) * SZ_WUP), BGP(unsigned char, BG_OA) + (size_t)M * 1024, WSP(unsigned char, WS_WUP + (2 * layer + 1) * SZ_WUP), 1024, M / 256, D / 256, F.G, (int)blockIdx.x};
            pg8::EpiMerge E{BGP(bf16_t, BG_GM), BGP(unsigned char, BG_Z), Z8_SCALE / (O8_SCALE * WUP8_SCALE)};
            pg8::gemm_phase<true>(F.lds, 1024, S, E);
        }
        SEAM(pb + 3);
        if (IN(pb + 4)) { Frame F = F0; launder(F); u64* rsq = WSP(u64, WS_RSQ);
            pg8::SchedDense S{BGP(unsigned char, BG_Z), WSP(unsigned char, WS_WO + layer * SZ_WO), D, D, M / 256, D / 256, F.G, (int)blockIdx.x};
            pg8::EpiResid E{layer == 0 ? (const void*)INP(IN_X) : (const void*)WSP(bf16_t, WS_XBF), layer != 0, WSP(bf16_t, WS_XBF), rsq + (2 * layer + 1) * M, layer == 1 ? WSP(unsigned char, WS_X8) : nullptr, 1.0f / (Z8_SCALE * WO8_SCALE)};
            pg8::gemm_phase<true>(F.lds, D, S, E);
        }
        SEAM(pb + 4);
        if (layer == 0) {
            if (IN(pb + 5)) { Frame F = F0; launder(F); u64* rsq = WSP(u64, WS_RSQ);
                pg8::SchedDense S{WSP(bf16_t, WS_XBF), WSP(bf16_t, WS_WGUD), D * 2, D * 2, M / 256, 2 * FF / 256, F.G, (int)blockIdx.x};
                pg8::EpiGateUp<false, true, false> E{BGP(bf16_t, 0), rsq + 1 * M, nullptr, F.misc};
                pg8::gemm_phase<false>(F.lds, D * 2, S, E);
            }
            SEAM(pb + 5);
            if (IN(pb + 6)) { Frame F = F0; launder(F); u64* rsq = WSP(u64, WS_RSQ);
                pg8::SchedDense S{BGP(unsigned char, 0), WSP(unsigned char, WS_WDD), FF, FF, M / 256, D / 256, F.G, (int)blockIdx.x};
                pg8::EpiResid E{WSP(bf16_t, WS_XBF), 1, WSP(bf16_t, WS_XBF), rsq + 2 * M, WSP(unsigned char, WS_X8), 1.0f / WD8_SCALE};
                pg8::gemm_phase<true>(F.lds, FF, S, E);
            }
            SEAM(pb + 6);
        } else {
            if (IN(pb + 5)) p_router(F0);
            SEAM(pb + 5);
            if (IN(pb + 6)) { Frame F = F0; launder(F); u64* rsq = WSP(u64, WS_RSQ);
                moe_counts(F);
                pg8::SchedMoE<true> S{WSP(unsigned char, WS_X8), WSP(unsigned char, WS_WGUM), WSP(int, WS_LTOK), D, D, 2 * FF / 256, F.G, (int)blockIdx.x, SZ_WGU8, F.misc, 24};
                pg8::EpiGateUp<true> E{BGP(bf16_t, 0), rsq + 3 * M, WSP(int, WS_LTOK), F.misc};
                pg8::gemm_phase<true>(F.lds, D, S, E);
            }
            SEAM(pb + 6);
            if (IN(pb + 7)) { Frame F = F0; launder(F);
                moe_counts(F);
                pg8::SchedMoE<false> S{BGP(unsigned char, 0), WSP(unsigned char, WS_WDM), nullptr, FF, FF, D / 256, F.G, (int)blockIdx.x, SZ_WD8, F.misc, 25};
                pg8::EpiMoeDown E{WSP(bf16_t, WS_YS), WSP(float, WS_LW), F.misc};
                pg8::gemm_phase<true>(F.lds, FF, S, E);
                { const int kpart = FF / (int)F.misc[26];
                  pg8::SchedMoETail St{BGP(unsigned char, 0), WSP(unsigned char, WS_WDM), FF, FF, D / 256, (int)blockIdx.x, kpart, SZ_WD8, F.misc};
                  pg8::EpiMoeDownTail Et{BGP(bf16_t, BG_YT), WSP(float, WS_LW), F.misc};
                  pg8::gemm_phase<true>(F.lds, kpart, St, Et); }
            }
            SEAM(pb + 7);
        }
    }
    if (IN(16)) p_final(F0);
#undef IN
#undef SEAM
}

extern "C" void kernel_launch(void* const* d_in, const int* in_sizes, int n_in, void* d_out, int out_size, void* d_ws, size_t ws_size, hipStream_t stream) {
    static int grid = 0;
    if (grid == 0) {
        if (n_in != 22 || in_sizes[0] != M * D || out_size != M * D || ws_size < WS_END) { fprintf(stderr, "kernel_launch: unexpected shapes (n_in %d, in0 %d, out %d, ws %zu < %zu); nothing launched\n", n_in, n_in > 0 ? in_sizes[0] : -1, out_size, ws_size, (size_t)WS_END); grid = -1; return; }
        int dev = 0, cus = 0, per_cu = 0;
        if (hipGetDevice(&dev) != hipSuccess || hipDeviceGetAttribute(&cus, hipDeviceAttributeMultiprocessorCount, dev) != hipSuccess) { grid = -1; return; }
        if (hipFuncSetAttribute((const void*)mega_fwd, hipFuncAttributeMaxDynamicSharedMemorySize, LDS_BYTES) != hipSuccess) { fprintf(stderr, "kernel_launch: hipFuncSetAttribute failed\n"); grid = -1; return; }
        if (hipOccupancyMaxActiveBlocksPerMultiprocessor(&per_cu, (const void*)mega_fwd, NTHREADS, LDS_BYTES) != hipSuccess || per_cu < 1) fprintf(stderr, "kernel_launch: occupancy query reports %d\n", per_cu);
        (void)hipGetLastError();
        grid = cus;
    }
    if (grid < 0) return;
    (void)hipMemsetAsync((char*)d_ws + WS_CTL, 0, CTL_ZERO_BYTES, stream);
    Args a{};
    for (int i = 0; i < 22; ++i) a.in[i] = (const float*)d_in[i];
    a.out = (float*)d_out; a.ws = (unsigned char*)d_ws; a.pad = 0;
#if MK_SPLIT
    for (int p = 0; p < NPHASE; ++p) { a.ph_lo = p; a.ph_hi = p + 1; a.li = p; hipLaunchKernelGGL(mega_fwd, dim3(grid), dim3(NTHREADS), LDS_BYTES, stream, a); }
#else
    a.ph_lo = 0; a.ph_hi = NPHASE; a.li = 0;
    hipLaunchKernelGGL(mega_fwd, dim3(grid), dim3(NTHREADS), LDS_BYTES, stream, a);
#endif
}
```

```cpp
#include <hip/hip_runtime.h>
#include <cstdio>
#include <cstdint>

#define LAS __attribute__((address_space(3)))
#define GAS __attribute__((address_space(1)))
typedef unsigned short bf16_t;
typedef short bf16x8 __attribute__((ext_vector_type(8)));
typedef short s16x4 __attribute__((ext_vector_type(4)));
typedef float f32x4 __attribute__((ext_vector_type(4)));
typedef float f32x2 __attribute__((ext_vector_type(2)));
typedef float f32x16 __attribute__((ext_vector_type(16)));
typedef unsigned u32x4 __attribute__((ext_vector_type(4)));
typedef unsigned u32x2 __attribute__((ext_vector_type(2)));

constexpr int NB = 4, T = 4096, D = 2048, M = NB * T, HD = 128, FF = 7168, NE = 8;
constexpr int IN_DIM = 8216, NIN = 8448;
constexpr int NCMP = 255, CMPH = 256;
constexpr float NORM_EPS = 1e-6f;
constexpr int MAXSLOT = 34816;
constexpr int YT_ROWS = 31 * 256;

constexpr size_t MiB = 1u << 20;
constexpr size_t WS_CTL = 0, CTL_ZERO_BYTES = 2 * MiB;
constexpr int CW_TMO = 0, CW_QUEUE = 1024, CW_ECNT = 2048, CW_BAR = 4096;
constexpr size_t WS_RSQ = 1 * MiB;
constexpr size_t WS_ROPE = 2 * MiB;
constexpr size_t WS_MISC = 4 * MiB;
constexpr size_t WS_CBIAS = 512 * 1024;
constexpr float CB_SCALE = 1099511627776.0f;
constexpr size_t WS_LTOK = WS_MISC + 64 * 1024;
constexpr size_t WS_LW = WS_LTOK + (size_t)NE * M * 4;
constexpr size_t WS_SLOT = WS_LW + (size_t)NE * M * 4;
constexpr size_t WS_W = 6 * MiB;
constexpr size_t SZ_WIN = (size_t)NIN * D * 2, SZ_W1 = (size_t)CMPH * 4096 * 2, SZ_W2 = (size_t)256 * 256 * 2, SZ_WUP = (size_t)D * 1024 * 2, SZ_WO = (size_t)D * D * 2;
constexpr size_t SZ_WGU = (size_t)2 * FF * D * 2, SZ_WD = (size_t)D * FF * 2;
constexpr size_t SZ_WGU8 = (size_t)2 * FF * D, SZ_WD8 = (size_t)D * FF;
constexpr float WGU8_SCALE = 32.0f, WD8_SCALE = 64.0f, WIN8_SCALE = 32.0f, WUP8_SCALE = 32.0f, WO8_SCALE = 32.0f, O8_SCALE = 16.0f, Z8_SCALE = 16.0f;
constexpr size_t WS_WIN = WS_W;
constexpr size_t WS_W1 = WS_WIN + 2 * SZ_WIN;
constexpr size_t WS_W2 = WS_W1 + 4 * SZ_W1;
constexpr size_t WS_WUP = WS_W2 + 4 * SZ_W2;
constexpr size_t WS_WO = WS_WUP + 4 * SZ_WUP;
constexpr size_t WS_WGUD = WS_WO + 2 * SZ_WO;
constexpr size_t WS_WDD = WS_WGUD + SZ_WGU;
constexpr size_t WS_WGUM = WS_WDD + SZ_WD;
constexpr size_t WS_WDM = WS_WGUM + 8 * SZ_WGU8;
constexpr size_t WS_X8 = WS_WDM + 8 * SZ_WD8;
constexpr size_t WS_XR = WS_X8 + (size_t)M * D;
constexpr size_t WS_XBF = WS_XR + (size_t)M * D * 4;
constexpr size_t WS_YS = WS_XBF + (size_t)M * D * 2;
constexpr size_t WS_BIG = WS_YS + (size_t)MAXSLOT * D * 2;
constexpr size_t SZ_BIG = (size_t)MAXSLOT * FF * 2;
constexpr size_t WS_END = WS_BIG + SZ_BIG;
constexpr size_t BG_QKV = 0;
constexpr size_t BG_GM = BG_QKV + (size_t)M * 4096 * 2;
constexpr size_t BG_NG = BG_GM + (size_t)M * 4096 * 2;
constexpr size_t BG_KCB = BG_NG + (size_t)M * 32 * 2;
constexpr size_t BG_VCB = BG_KCB + (size_t)M * 256 * 2 + 65536;
constexpr size_t BG_HC = BG_VCB + (size_t)M * 256 * 2 + 65536;
constexpr size_t BG_KCMP = BG_HC + (size_t)2 * 2048 * 256 * 2;
constexpr size_t BG_VCMP = BG_KCMP + (size_t)8 * 256 * 128 * 2;
constexpr size_t BG_OA = BG_VCMP + (size_t)8 * 256 * 128 * 2;
constexpr size_t BG_OB = BG_OA + (size_t)M * 1024 * 2;
constexpr size_t BG_Z = BG_OB + (size_t)M * 1024 * 2;
constexpr size_t BG_END = BG_Z + (size_t)M * D * 2;
static_assert(BG_END <= SZ_BIG, "attention-phase tensors fit the aliased region");
constexpr size_t BG_YT = 256 * MiB;
static_assert((size_t)MAXSLOT * FF <= BG_YT && BG_YT + (size_t)4 * YT_ROWS * D * 2 <= SZ_BIG, "tail partials fit");
static_assert(WS_SLOT + (size_t)M * 8 <= WS_W, "misc region");

constexpr int LDS_K = 0, LDS_V = 65536, LDS_WSCR = 131072  , LDS_IMP = LDS_WSCR + 2048  , LDS_SELM = LDS_IMP + 64 * 65 * 4  ;
constexpr int LDS_MISC = LDS_SELM + 512;
constexpr int LDS_BYTES = LDS_MISC + 256;
static_assert(LDS_BYTES <= 163840, "LDS");
static_assert(LDS_WSCR + 32 * 528 <= LDS_MISC, "epilogue slab fits beside the GEMM buffers");
constexpr int NWAVES = 8, NTHREADS = 512;

#define RLX_AGENT __ATOMIC_RELAXED, __HIP_MEMORY_SCOPE_AGENT
#define LDS_WAIT() asm volatile("s_waitcnt lgkmcnt(0)" ::: "memory")
#define VM_WAIT() asm volatile("s_waitcnt vmcnt(0)" ::: "memory")

typedef __bf16 bf16x2_t __attribute__((ext_vector_type(2)));
__device__ __forceinline__ unsigned cvt_pk_bf16(float lo, float hi) { f32x2 v = {lo, hi}; bf16x2_t b = __builtin_convertvector(v, bf16x2_t); return __builtin_bit_cast(unsigned, b); }
__device__ __forceinline__ float bf_lo(unsigned w) { return __uint_as_float(w << 16); }
__device__ __forceinline__ float bf_hi(unsigned w) { return __uint_as_float(w & 0xffff0000u); }
__device__ __forceinline__ float bf2f(bf16_t b) { return __uint_as_float(((unsigned)b) << 16); }
__device__ __forceinline__ float fast_sigmoid(float x) { return __builtin_amdgcn_rcpf(1.0f + __builtin_amdgcn_exp2f(-1.4426950408889634f * x)); }
__device__ __forceinline__ f32x4 sigmoid4_scaled(const f32x4& x, float c1) { const f32x4 t = x * c1; f32x4 e, sg;
#pragma unroll
    for (int j = 0; j < 4; ++j) e[j] = __builtin_amdgcn_exp2f(t[j]);
    const f32x4 d = e + 1.0f;
#pragma unroll
    for (int j = 0; j < 4; ++j) sg[j] = __builtin_amdgcn_rcpf(d[j]);
    return sg; }
__device__ __forceinline__ int opaque_tid() { int t; asm volatile("v_mov_b32 %0, %1" : "=v"(t) : "v"((int)threadIdx.x)); return t; }
typedef unsigned long long u64;
typedef int v8i __attribute__((ext_vector_type(8)));
typedef int v4i __attribute__((ext_vector_type(4)));
__device__ __forceinline__ unsigned cvt4_fp8(float a, float b, float c, float d) { unsigned w = 0u; w = __builtin_amdgcn_cvt_pk_fp8_f32(a, b, w, false); w = __builtin_amdgcn_cvt_pk_fp8_f32(c, d, w, true); return w; }
constexpr float RSQ_SCALE = 1048576.0f;
__device__ __forceinline__ float rstd_of(const u64* rsq, int row) { return rsqrtf((float)rsq[row] * (1.0f / (RSQ_SCALE * D)) + NORM_EPS); }
__device__ __forceinline__ float wave_sum(float v) {
#pragma unroll
    for (int o = 1; o < 64; o <<= 1) v += __shfl_xor(v, o);
    return v;
}

#define XB_TMO      128
#define XB_XCNT(j)  (256  + 64 * (j))
#define XB_XSUB(j)  (1280 + 64 * (j))
#define XB_XGEN(j)  (2304 + 64 * (j))
#define XB_TOP      3328
#define XB_TOPGEN   3392
#define XCD_BAR_WORDS 3456
#define XB_SPIN_CAP (1u << 18)
__device__ __forceinline__ unsigned xb_ld(unsigned* p)              { return __hip_atomic_load(p, __ATOMIC_RELAXED, __HIP_MEMORY_SCOPE_AGENT); }
__device__ __forceinline__ unsigned xb_add(unsigned* p, unsigned v) { return __hip_atomic_fetch_add(p, v, __ATOMIC_RELAXED, __HIP_MEMORY_SCOPE_AGENT); }
__device__ __forceinline__ unsigned xb_xcc_id() { return (unsigned)__builtin_amdgcn_s_getreg((3 << 11) | 20) & 0xFu; }
#define XB_SPIN(cond, bar) do { unsigned _sp = 0; while (cond) { __builtin_amdgcn_s_sleep(1); \
    if ((++_sp & 255u) == 0u) { if (xb_ld(&(bar)[XB_TMO])) break; if (_sp > XB_SPIN_CAP) { atomicAdd(&(bar)[XB_TMO], 1u); break; } } } } while (0)
struct XcdBarrier { unsigned* bar; unsigned x; volatile LAS unsigned* st; };
__device__ __forceinline__ XcdBarrier xcd_barrier_post(unsigned* bar, volatile LAS unsigned* st) {
    XcdBarrier b; b.bar = bar; b.x = xb_xcc_id(); b.st = st;
    if (threadIdx.x == 0) (void)xb_add(&bar[XB_XCNT(b.x)], 1u);
    return b;
}
__device__ __forceinline__ void xcd_barrier_complete(unsigned* bar, unsigned x, unsigned& nloc, unsigned& nx) {
    const unsigned G = gridDim.x * gridDim.y * gridDim.z;
    unsigned sum, cnt, mine, sp = 0u;
    for (;;) {
        sum = 0u; cnt = 0u; mine = 0u;
#pragma unroll
        for (unsigned j = 0; j < 16; ++j) { const unsigned c = xb_ld(&bar[XB_XCNT(j)]); sum += c; cnt += (c > 0u) ? 1u : 0u; mine = (j == x) ? c : mine; }
        if (sum == G) break;
        __builtin_amdgcn_s_sleep(1);
        if ((++sp & 255u) == 0u) { if (xb_ld(&bar[XB_TMO])) break; if (sp > XB_SPIN_CAP) { atomicAdd(&bar[XB_TMO], 1u); break; } }
    }
    nloc = mine > 0u ? mine : 1u; nx = cnt > 0u ? cnt : 1u;
}
__device__ __forceinline__ void xcd_barrier(const XcdBarrier& b) {
    asm volatile("s_waitcnt vmcnt(0)" ::: "memory");
    __syncthreads();
    if (threadIdx.x == 0) {
        unsigned* bar = b.bar;
        __builtin_amdgcn_s_waitcnt(0);
        unsigned nloc = b.st[0], nx = b.st[1];
        if (nloc == 0u) { xcd_barrier_complete(bar, b.x, nloc, nx); b.st[0] = nloc; b.st[1] = nx; }
        const unsigned old = xb_add(&bar[XB_XSUB(b.x)], 1u);
        const unsigned gen = old / nloc;
        if (old + 1u == (gen + 1u) * nloc) {
            __builtin_amdgcn_fence(__ATOMIC_RELEASE, "agent");
            asm volatile("s_waitcnt vmcnt(0)" ::: "memory");
            const unsigned og = xb_add(&bar[XB_TOP], 1u);
            const unsigned tg = og / nx;
            if (og + 1u == (tg + 1u) * nx) xb_add(&bar[XB_TOPGEN], 1u);
            else XB_SPIN(xb_ld(&bar[XB_TOPGEN]) == tg, bar);
            __builtin_amdgcn_fence(__ATOMIC_ACQUIRE, "agent");
            xb_add(&bar[XB_XGEN(b.x)], 1u);
            asm volatile("s_waitcnt vmcnt(0)" ::: "memory");
        } else {
            XB_SPIN(xb_ld(&bar[XB_XGEN(b.x)]) == gen, bar);
            __builtin_amdgcn_fence(__ATOMIC_ACQUIRE, "agent");
            asm volatile("s_waitcnt vmcnt(0)" ::: "memory");
        }
    }
    __syncthreads();
}

namespace pg8 {
constexpr int BM = 256, BK = 64, HALF = 128, HTB = HALF * BK * 2, STAGE_BYTES = 8 * HTB, NXCD = 8, WGM = 4;
__host__ __device__ __forceinline__ int lds_byte(int r, int c) { const int st = (r >> 4) * 2 + (c >> 5), rr = r & 15, cc = c & 31, ob = rr * 64 + cc * 2; return st * 1024 + (ob ^ (((ob >> 9) & 1) << 5)); }
__host__ __device__ __forceinline__ void stage_rc(int b, int& R, int& C) { const int st = b / 1024, sb = b % 1024, swz = sb ^ (((sb >> 9) & 1) << 5); R = (st >> 1) * 16 + swz / 64; C = (st & 1) * 32 + (swz % 64) / 2; }
__host__ __device__ __forceinline__ int perm32(int rho) { const int n = rho >> 4, i = rho & 15; return 8 * (i >> 2) + 4 * n + (i & 3); }

struct Unit { int pm, pn, aux; };
typedef f32x4 Acc[2][2][4][2];

__device__ __forceinline__ bool static_tile(int L, int nM, int nN, int& pm, int& pn) {
    const int nwg = nM * nN; if (L >= nwg) return false;
    int wgid = L; { const int q = nwg / NXCD, r = nwg % NXCD, xcd = wgid % NXCD, off = wgid / NXCD; wgid = (xcd < r ? xcd * (q + 1) : r * (q + 1) + (xcd - r) * q) + off; }
    const int nig = WGM * nN, gid = wgid / nig, fm = gid * WGM, gsz = (nM - fm) < WGM ? (nM - fm) : WGM;
    pm = fm + ((wgid % nig) % gsz); pn = (wgid % nig) / gsz; return true;
}

__device__ __forceinline__ void glds_s(const void* sbase, unsigned voff, unsigned lds_dst) { unsigned keep;
    asm volatile("s_mov_b32 %0, m0\n\ts_mov_b32 m0, %3\n\ts_nop 0\n\tglobal_load_lds_dwordx4 %1, %2\n\ts_mov_b32 m0, %0" : "=&s"(keep) : "v"(voff), "s"(sbase), "s"(lds_dst) : "memory"); }
__device__ __forceinline__ const char* uni_ptr(const char* p) { const unsigned long long v = (unsigned long long)p; const unsigned lo = __builtin_amdgcn_readfirstlane((unsigned)v), hi = __builtin_amdgcn_readfirstlane((unsigned)(v >> 32));
    return (const char*)(GAS const char*)(((unsigned long long)hi << 32) | lo); }
template <bool FP8, class Epi, class Sched>
__device__ __forceinline__ void gemm_phase(LAS unsigned char* lds, const int Kb, const Sched& S, const Epi& E) {
    const int tid = opaque_tid(), wid = __builtin_amdgcn_readfirstlane(tid >> 6), lane = tid & 63, wr = wid >> 2, wc = wid & 3, fr = lane & 15, fq = lane >> 4;
    const int nt = Kb / 128;
    int Rr[2], Cc[2]; unsigned voffB[2];
#pragma unroll
    for (int i = 0; i < 2; ++i) { stage_rc(tid * 16 + i * 8192, Rr[i], Cc[i]); const int Rb = Epi::PERM ? ((Rr[i] & ~31) + perm32(Rr[i] & 31)) : Rr[i];
        voffB[i] = (unsigned)(Rb * S.ldb() + Cc[i] * 2); }
    const size_t kstep = (size_t)(BK * 2);
    const size_t hstepB = (size_t)HALF * S.ldb();
    const unsigned ldsw = (unsigned)wid * 1024u;
    const unsigned ldsb = (unsigned)__builtin_amdgcn_readfirstlane((int)((unsigned)(uintptr_t)lds + ldsw));
    const int aoff = lds_byte(wr * 64 + fr, fq * 8), boff = lds_byte(wc * 32 + fr, fq * 8);
#define PG8_SA(b, h) (((b) * 2 + (h)) * HTB)
#define PG8_SB(b, h) ((4 + (b) * 2 + (h)) * HTB)
#define PG8_STAGE(bufoff, gbase, voff) do { const void* sb_ = (const void*)(gbase); _Pragma("unroll") for (int _i = 0; _i < 2; ++_i) \
        glds_s(sb_, (voff)[_i], ldsb + (unsigned)((bufoff) + _i * 8192)); } while (0)
#define PG8_LD8(p_) __builtin_shufflevector(*(const LAS v4i*)(p_), *(const LAS v4i*)((p_) + 1024), 0, 1, 2, 3, 4, 5, 6, 7)
#define PG8_LDA(dst, b, h) do { _Pragma("unroll") for (int m = 0; m < 4; ++m) dst[m] = PG8_LD8(lds + PG8_SA(b, h) + aoff + m * 2048); } while (0)
#define PG8_LDB(dst, b, h) do { _Pragma("unroll") for (int n = 0; n < 2; ++n) dst[n] = PG8_LD8(lds + PG8_SB(b, h) + boff + n * 2048); } while (0)
#define PG8_H(v_, k_) __builtin_bit_cast(bf16x8, __builtin_shufflevector(v_, v_, 4 * (k_), 4 * (k_) + 1, 4 * (k_) + 2, 4 * (k_) + 3))
#define PG8_MMA(ai, bj, At, Bt) do { __builtin_amdgcn_s_setprio(1); _Pragma("unroll") for (int m = 0; m < 4; ++m) _Pragma("unroll") for (int n = 0; n < 2; ++n) { \
        if constexpr (FP8) asm volatile("v_mfma_f32_16x16x128_f8f6f4 %0, %1, %2, %0" : "+v"(acc[ai][bj][m][n]) : "v"(Bt[n]), "v"(At[m]));   \
        else { acc[ai][bj][m][n] = __builtin_amdgcn_mfma_f32_16x16x32_bf16(PG8_H(Bt[n], 0), PG8_H(At[m], 0), acc[ai][bj][m][n], 0, 0, 0); \
               acc[ai][bj][m][n] = __builtin_amdgcn_mfma_f32_16x16x32_bf16(PG8_H(Bt[n], 1), PG8_H(At[m], 1), acc[ai][bj][m][n], 0, 0, 0); } } \
        __builtin_amdgcn_s_setprio(0); } while (0)
#define PG8_WAIT_V(n) asm volatile("s_waitcnt vmcnt(" #n ")" ::: "memory")
#define PG8_WAIT_L(n) asm volatile("s_waitcnt lgkmcnt(" #n ")" ::: "memory")
#define PG8_BAR __builtin_amdgcn_s_barrier()
#define PG8_SCHED __builtin_amdgcn_sched_barrier(0)
    Unit cur, nxt; int ui = 0;
    if (!S.next(0, cur)) return;
    Acc acc;
#pragma unroll
    for (int a = 0; a < 2; ++a)
#pragma unroll
        for (int b = 0; b < 2; ++b)
#pragma unroll
            for (int m = 0; m < 4; ++m)
#pragma unroll
                for (int n = 0; n < 2; ++n) acc[a][b][m][n] = (f32x4){0.f, 0.f, 0.f, 0.f};
    v8i At[4], B0[2], B1[2]; const int one8 = 0x7F7F7F7F;
    unsigned vA[2][2], vAn[2][2];
    S.a_off(cur, Rr, Cc, vA);
    const char* cA = uni_ptr(S.a_base(cur)); const char* cB = uni_ptr(S.b_base(cur));
    PG8_STAGE(PG8_SB(0, 0), cB, voffB); PG8_STAGE(PG8_SB(0, 1), cB + hstepB, voffB); PG8_STAGE(PG8_SA(0, 0), cA, vA[0]); PG8_STAGE(PG8_SA(0, 1), cA, vA[1]);
    if (wr == 1) PG8_BAR;
    PG8_WAIT_V(2); PG8_BAR;
    PG8_STAGE(PG8_SB(1, 0), cB + kstep, voffB); PG8_STAGE(PG8_SA(1, 0), cA + kstep, vA[0]); PG8_STAGE(PG8_SB(1, 1), cB + hstepB + kstep, voffB);
    PG8_WAIT_V(6); PG8_BAR;
    for (;;) {
        const bool has_next = S.next(ui + 1, nxt);
        const char* nA = cA; const char* nB = cB;
#pragma unroll
        for (int h = 0; h < 2; ++h)
#pragma unroll
            for (int i = 0; i < 2; ++i) vAn[h][i] = vA[h][i];
        if (has_next) { nA = uni_ptr(S.a_base(nxt)); nB = uni_ptr(S.b_base(nxt)); if (Sched::VARIES) S.a_off(nxt, Rr, Cc, vAn); }
        for (int t = 0; t < nt; t += 2) {
            const bool last = (t == nt - 2);
            const char* a1 = cA + (size_t)(t + 1) * kstep;
            const char* a2 = last ? nA : cA + (size_t)(t + 2) * kstep; const char* b2 = last ? nB : cB + (size_t)(t + 2) * kstep;
            const char* a3 = a2 + kstep; const char* b3 = b2 + kstep;
            unsigned v2[2][2];
#pragma unroll
            for (int h = 0; h < 2; ++h)
#pragma unroll
                for (int i = 0; i < 2; ++i) v2[h][i] = (Sched::VARIES && last) ? vAn[h][i] : vA[h][i];
            PG8_LDB(B0, 0, 0); PG8_LDB(B1, 0, 1); PG8_SCHED; PG8_LDA(At, 0, 0); PG8_STAGE(PG8_SA(1, 1), a1, vA[1]);
            if (!(FP8 && t == 0 && ui > 0)) PG8_WAIT_V(8);
            PG8_WAIT_L(0); PG8_BAR; PG8_MMA(0, 0, At, B0); PG8_MMA(0, 1, At, B1); PG8_BAR; PG8_SCHED;
            PG8_LDA(At, 0, 1); PG8_STAGE(PG8_SB(0, 0), b2, voffB); PG8_STAGE(PG8_SB(0, 1), b2 + hstepB, voffB); PG8_STAGE(PG8_SA(0, 0), a2, v2[0]);
            PG8_WAIT_V(8); PG8_WAIT_L(0); PG8_BAR; PG8_MMA(1, 0, At, B0); PG8_MMA(1, 1, At, B1); PG8_BAR; PG8_SCHED;
            PG8_LDB(B0, 1, 0); PG8_LDB(B1, 1, 1); PG8_SCHED; PG8_LDA(At, 1, 0); PG8_STAGE(PG8_SA(0, 1), a2, v2[1]);
            PG8_WAIT_V(8); PG8_WAIT_L(0); PG8_BAR; PG8_MMA(0, 0, At, B0); PG8_MMA(0, 1, At, B1); PG8_BAR; PG8_SCHED;
            PG8_LDA(At, 1, 1); PG8_STAGE(PG8_SB(1, 0), b3, voffB); PG8_STAGE(PG8_SB(1, 1), b3 + hstepB, voffB); PG8_STAGE(PG8_SA(1, 0), a3, v2[0]);
            PG8_WAIT_V(8); PG8_WAIT_L(0); PG8_BAR; PG8_MMA(1, 0, At, B0); PG8_MMA(1, 1, At, B1); PG8_BAR; PG8_SCHED;
        }
        PG8_WAIT_V(6);
        if (wr == 0) PG8_BAR;
        if constexpr (FP8) asm volatile("s_nop 15\n\ts_nop 15" ::: "memory");
        E(acc, cur, wr, wc, fr, fq);
        if (!has_next) break;
        if (!E.keep(cur)) {
#pragma unroll
            for (int a = 0; a < 2; ++a)
#pragma unroll
                for (int b = 0; b < 2; ++b)
#pragma unroll
                    for (int m = 0; m < 4; ++m)
#pragma unroll
                        for (int n = 0; n < 2; ++n) acc[a][b][m][n] = (f32x4){0.f, 0.f, 0.f, 0.f};
        }
        cur = nxt; cA = nA; cB = nB; ++ui;
#pragma unroll
        for (int h = 0; h < 2; ++h)
#pragma unroll
            for (int i = 0; i < 2; ++i) vA[h][i] = vAn[h][i];
        if (wr == 1) PG8_BAR;
    }
    PG8_WAIT_V(0);
    PG8_BAR;
#undef PG8_SA
#undef PG8_SB
#undef PG8_STAGE
#undef PG8_LDA
#undef PG8_LDB
#undef PG8_MMA
#undef PG8_WAIT_V
#undef PG8_WAIT_L
#undef PG8_BAR
#undef PG8_SCHED
}

struct SchedDense {
    static constexpr bool VARIES = false;
    const void* A; const void* Bt; int lda, ldb_, nM, nN, G, c;
    __device__ __forceinline__ int ldb() const { return ldb_; }
    __device__ __forceinline__ bool next(int i, Unit& u) const { u.aux = 0; return static_tile(i * G + c, nM, nN, u.pm, u.pn); }
    __device__ __forceinline__ const char* a_base(const Unit& u) const { return (const char*)A + (size_t)u.pm * BM * lda; }
    __device__ __forceinline__ const char* b_base(const Unit& u) const { return (const char*)Bt + (size_t)u.pn * BM * ldb_; }
    __device__ __forceinline__ void a_off(const Unit&, const int (&R)[2], const int (&C)[2], unsigned (&vo)[2][2]) const {
#pragma unroll
        for (int h = 0; h < 2; ++h)
#pragma unroll
            for (int i = 0; i < 2; ++i) vo[h][i] = (unsigned)((h * HALF + R[i]) * lda + C[i] * 2); }
};
struct SchedOne {
    static constexpr bool VARIES = false;
    const void* A; const void* Bt; int lda, ldb_, pm, pn;
    __device__ __forceinline__ int ldb() const { return ldb_; }
    __device__ __forceinline__ bool next(int i, Unit& u) const { u.aux = 0; u.pm = pm; u.pn = pn; return i == 0; }
    __device__ __forceinline__ const char* a_base(const Unit& u) const { return (const char*)A + (size_t)u.pm * BM * lda; }
    __device__ __forceinline__ const char* b_base(const Unit& u) const { return (const char*)Bt + (size_t)u.pn * BM * ldb_; }
    __device__ __forceinline__ void a_off(const Unit&, const int (&R)[2], const int (&C)[2], unsigned (&vo)[2][2]) const {
#pragma unroll
        for (int h = 0; h < 2; ++h)
#pragma unroll
            for (int i = 0; i < 2; ++i) vo[h][i] = (unsigned)((h * HALF + R[i]) * lda + C[i] * 2); }
};
struct SchedSeg2 {
    static constexpr bool VARIES = false;
    const void* A0; const void* B0; const void* A1; const void* B1; int ld, nM, nN, G, c;
    __device__ __forceinline__ int ldb() const { return ld; }
    __device__ __forceinline__ bool next(int i, Unit& u) const { u.aux = i & 1; return static_tile((i >> 1) * G + c, nM, nN, u.pm, u.pn); }
    __device__ __forceinline__ const char* a_base(const Unit& u) const { return (const char*)(u.aux ? A1 : A0) + (size_t)u.pm * BM * ld; }
    __device__ __forceinline__ const char* b_base(const Unit& u) const { return (const char*)(u.aux ? B1 : B0) + (size_t)u.pn * BM * ld; }
    __device__ __forceinline__ void a_off(const Unit&, const int (&R)[2], const int (&C)[2], unsigned (&vo)[2][2]) const {
#pragma unroll
        for (int h = 0; h < 2; ++h)
#pragma unroll
            for (int i = 0; i < 2; ++i) vo[h][i] = (unsigned)((h * HALF + R[i]) * ld + C[i] * 2); }
};
template <bool GATHER> struct SchedMoE {
    static constexpr bool VARIES = GATHER;
    const void* A; const void* Bt; const int* ltok; int lda, ldb_, nN, G, c; size_t bstride; const volatile LAS unsigned* misc; int nm_word;
    __device__ __forceinline__ int ldb() const { return ldb_; }
    __device__ __forceinline__ bool next(int i, Unit& u) const {
        const int nM = (int)misc[nm_word]; if (!static_tile(i * G + c, nM, nN, u.pm, u.pn)) return false;
        int e = 0;
#pragma unroll
        for (int j = 1; j < NE; ++j) e += ((int)misc[16 + j] <= u.pm) ? 1 : 0;
        u.aux = e; return true; }
    __device__ __forceinline__ const char* a_base(const Unit& u) const { return GATHER ? (const char*)A : (const char*)A + (size_t)u.pm * BM * lda; }
    __device__ __forceinline__ const char* b_base(const Unit& u) const { return (const char*)Bt + (size_t)u.aux * bstride + (size_t)u.pn * BM * ldb_; }
    __device__ __forceinline__ void a_off(const Unit& u, const int (&R)[2], const int (&C)[2], unsigned (&vo)[2][2]) const {
        if (GATHER) {
            const int cnt = (int)misc[8 + u.aux], r0 = (u.pm - (int)misc[16 + u.aux]) * BM;
#pragma unroll
            for (int h = 0; h < 2; ++h)
#pragma unroll
                for (int i = 0; i < 2; ++i) { const int r = r0 + h * HALF + R[i]; const int tok = r < cnt ? ltok[u.aux * M + r] : 0; vo[h][i] = (unsigned)(tok * lda + C[i] * 2); }
        } else {
#pragma unroll
            for (int h = 0; h < 2; ++h)
#pragma unroll
                for (int i = 0; i < 2; ++i) vo[h][i] = (unsigned)((h * HALF + R[i]) * lda + C[i] * 2);
        } }
};

struct SchedMoETail {
    static constexpr bool VARIES = false;
    const void* A; const void* Bt; int lda, ldb_, nN, c, kpart; size_t bstride; const volatile LAS unsigned* misc;
    __device__ __forceinline__ int ldb() const { return ldb_; }
    __device__ __forceinline__ bool next(int i, Unit& u) const {
        const int S = (int)misc[26], Tm = (int)misc[25], nt = ((int)misc[24] - Tm) * nN;
        if (i != 0 || c >= nt * S) return false;
        const int j = c / S, part = c - j * S; u.pm = Tm + j / nN; u.pn = j % nN;
        int e = 0;
#pragma unroll
        for (int q = 1; q < NE; ++q) e += ((int)misc[16 + q] <= u.pm) ? 1 : 0;
        u.aux = e | (part << 8); return true; }
    __device__ __forceinline__ const char* a_base(const Unit& u) const { return (const char*)A + (size_t)u.pm * BM * lda + (size_t)(u.aux >> 8) * kpart; }
    __device__ __forceinline__ const char* b_base(const Unit& u) const { return (const char*)Bt + (size_t)(u.aux & 255) * bstride + (size_t)u.pn * BM * ldb_ + (size_t)(u.aux >> 8) * kpart; }
    __device__ __forceinline__ void a_off(const Unit&, const int (&R)[2], const int (&C)[2], unsigned (&vo)[2][2]) const {
#pragma unroll
        for (int h = 0; h < 2; ++h)
#pragma unroll
            for (int i = 0; i < 2; ++i) vo[h][i] = (unsigned)((h * HALF + R[i]) * lda + C[i] * 2); }
};

struct EpiIn {
    static constexpr bool PERM = true;
    bf16_t* QKV; bf16_t* KCb; bf16_t* VCb; bf16_t* GMb; bf16_t* NGb; const u64* rsq; const float* cosT; const float* sinT; float wscale;
    LAS unsigned char* slab;
    __device__ __forceinline__ bool keep(const Unit&) const { return false; }
    __device__ __forceinline__ void operator()(const Acc& acc, const Unit& u, int wr, int wc, int fr, int fq) const {
        const int pn = u.pn, row0 = u.pm * BM + wr * 64 + fr;
        u64 rq[2][4];
#pragma unroll
        for (int ai = 0; ai < 2; ++ai)
#pragma unroll
            for (int m = 0; m < 4; ++m) rq[ai][m] = rsq[row0 + ai * HALF + m * 16];
        const float sc = (1.0f / (RSQ_SCALE * D));
        if (pn < 32) {
            const int wid = wr * 4 + wc, lane = fq * 16 + fr;
            LAS unsigned char* wrow = slab + (wr * 16 + fr) * 528;
            const int sr = wid * 4 + (lane >> 5), cb = (lane & 31) * 16;
            const LAS unsigned char* rp = slab + sr * 528 + cb;
            const int trow = (sr >> 4) * 64 + (sr & 15);
            const bool rope = pn < 16 && ((0x57DF >> pn) & 1); const int d0 = 16 * wc + 4 * fq;
            f32x4 csa[8], sna[8];
#pragma unroll
            for (int g = 0; g < 8; ++g) { csa[g] = f32x4{1.f, 1.f, 1.f, 1.f}; sna[g] = f32x4{0.f, 0.f, 0.f, 0.f}; }
            if (rope) {
#pragma unroll
                for (int g = 0; g < 8; ++g) { const int t = (row0 + (g >> 2) * HALF + (g & 3) * 16) & (T - 1); csa[g] = *(const f32x4*)(cosT + t * 64 + d0); sna[g] = *(const f32x4*)(sinT + t * 64 + d0); } }
#pragma unroll
            for (int g = 0; g < 8; ++g) { const int ai = g >> 2, m = g & 3; const f32x4 cs = csa[g], sn = sna[g];
                const float rstd = rsqrtf((float)rq[ai][m] * sc + NORM_EPS) * wscale;
#pragma unroll
                for (int bj = 0; bj < 2; ++bj) { const f32x4 v0 = acc[ai][bj][m][0] * rstd, v1 = acc[ai][bj][m][1] * rstd;
                    if (pn < 16) { const f32x4 o1 = v0 * cs - v1 * sn, o2 = v1 * cs + v0 * sn;
                        u32x2 w1, w2; w1.x = cvt_pk_bf16(o1[0], o1[1]); w1.y = cvt_pk_bf16(o1[2], o1[3]); w2.x = cvt_pk_bf16(o2[0], o2[1]); w2.y = cvt_pk_bf16(o2[2], o2[3]);
                        *(LAS u32x2*)(wrow + (bj * HD + d0) * 2) = w1; *(LAS u32x2*)(wrow + (bj * HD + 64 + d0) * 2) = w2; }
                    else { const float c1 = -1.4426950408889634f * rstd; const f32x4 s0 = sigmoid4_scaled(acc[ai][bj][m][0], c1), s1 = sigmoid4_scaled(acc[ai][bj][m][1], c1); u32x4 w;
                        w.x = cvt_pk_bf16(s0[0], s0[1]); w.y = cvt_pk_bf16(s0[2], s0[3]); w.z = cvt_pk_bf16(s1[0], s1[1]); w.w = cvt_pk_bf16(s1[2], s1[3]);
                        *(LAS u32x4*)(wrow + (bj * HD + wc * 32 + 8 * fq) * 2) = w; } }
                asm volatile("s_waitcnt lgkmcnt(0)" ::: "memory"); __builtin_amdgcn_s_barrier(); asm volatile("" ::: "memory");
                const u32x4 ra = *(const LAS u32x4*)rp, rb = *(const LAS u32x4*)(rp + 2 * 528);
                asm volatile("s_waitcnt lgkmcnt(0)" ::: "memory"); __builtin_amdgcn_s_barrier(); asm volatile("" ::: "memory");
                const int grow = u.pm * BM + ai * HALF + m * 16 + trow;
                unsigned char* dst; size_t rstride;
                if (pn == 10 || pn == 11) { bf16_t* cbuf = pn == 10 ? KCb : VCb; dst = (unsigned char*)(cbuf + ((size_t)((grow >> 12) * 2 + (cb >> 8)) * T + (grow & (T - 1))) * HD) + (cb & 255); rstride = (size_t)HD * 2; }
                else if (pn < 16) { dst = (unsigned char*)(QKV + (size_t)grow * 4096 + pn * 256) + cb; rstride = (size_t)4096 * 2; }
                else { dst = (unsigned char*)(GMb + (size_t)grow * 4096 + (pn - 16) * 256) + cb; rstride = (size_t)4096 * 2; }
                *(u32x4*)dst = ra; *(u32x4*)(dst + 2 * rstride) = rb; }
        } else {
            if (wc == 0) {
#pragma unroll
                for (int ai = 0; ai < 2; ++ai)
#pragma unroll
                    for (int m = 0; m < 4; ++m) { const int row = row0 + ai * HALF + m * 16; const float rstd = rsqrtf((float)rq[ai][m] * sc + NORM_EPS) * wscale;
                        const f32x4 v0 = acc[ai][0][m][0] * rstd, v1 = acc[ai][0][m][1] * rstd; u32x4 w;
                        w.x = cvt_pk_bf16(fast_sigmoid(v0[0]), fast_sigmoid(v0[1])); w.y = cvt_pk_bf16(fast_sigmoid(v0[2]), fast_sigmoid(v0[3]));
                        w.z = cvt_pk_bf16(fast_sigmoid(v1[0]), fast_sigmoid(v1[1])); w.w = cvt_pk_bf16(fast_sigmoid(v1[2]), fast_sigmoid(v1[3]));
                        *(u32x4*)(NGb + (size_t)row * 32 + 8 * fq) = w; }
            }
        }
    }
};
struct EpiCmp1 {
    static constexpr bool PERM = true;
    bf16_t* H; const long long* bias;
    __device__ __forceinline__ bool keep(const Unit&) const { return false; }
    __device__ __forceinline__ void operator()(const Acc& acc, const Unit& u, int wr, int wc, int fr, int fq) const {
        const int row0 = u.pm * BM + wr * 64 + fr, col0 = wc * 32 + 8 * fq;
        f32x4 bv[2][2];
#pragma unroll
        for (int bj = 0; bj < 2; ++bj)
#pragma unroll
            for (int n = 0; n < 2; ++n) { const long long* bp = bias + col0 + bj * HALF + 4 * n; bv[bj][n] = f32x4{(float)bp[0], (float)bp[1], (float)bp[2], (float)bp[3]} * (1.0f / CB_SCALE); }
#pragma unroll
        for (int ai = 0; ai < 2; ++ai)
#pragma unroll
            for (int m = 0; m < 4; ++m) { bf16_t* rowp = H + (size_t)(row0 + ai * HALF + m * 16) * 256 + col0;
#pragma unroll
                for (int bj = 0; bj < 2; ++bj) { f32x4 v0 = acc[ai][bj][m][0] + bv[bj][0], v1 = acc[ai][bj][m][1] + bv[bj][1];
#pragma unroll
                    for (int j = 0; j < 4; ++j) { v0[j] = v0[j] * fast_sigmoid(v0[j]); v1[j] = v1[j] * fast_sigmoid(v1[j]); }
                    u32x4 w; w.x = cvt_pk_bf16(v0[0], v0[1]); w.y = cvt_pk_bf16(v0[2], v0[3]); w.z = cvt_pk_bf16(v1[0], v1[1]); w.w = cvt_pk_bf16(v1[2], v1[3]);
                    *(u32x4*)(rowp + bj * HALF) = w; } }
    }
};
struct EpiCmp2 {
    static constexpr bool PERM = true;
    bf16_t* O;
    __device__ __forceinline__ bool keep(const Unit&) const { return false; }
    __device__ __forceinline__ void operator()(const Acc& acc, const Unit& u, int wr, int wc, int fr, int fq) const {
        const int row0 = u.pm * BM + wr * 64 + fr, col0 = wc * 32 + 8 * fq;
#pragma unroll
        for (int ai = 0; ai < 2; ++ai)
#pragma unroll
            for (int m = 0; m < 4; ++m) { const int row = row0 + ai * HALF + m * 16; const float z = ((row & 255) == 255) ? 0.f : 1.f;
                const f32x4 v0 = acc[ai][0][m][0] * z, v1 = acc[ai][0][m][1] * z;
                u32x4 w; w.x = cvt_pk_bf16(v0[0], v0[1]); w.y = cvt_pk_bf16(v0[2], v0[3]); w.z = cvt_pk_bf16(v1[0], v1[1]); w.w = cvt_pk_bf16(v1[2], v1[3]);
                *(u32x4*)(O + (size_t)row * HD + col0) = w; }
    }
};
struct EpiMerge {
    static constexpr bool PERM = true;
    const bf16_t* GMb; unsigned char* Z; float zscale;
    __device__ __forceinline__ bool keep(const Unit& u) const { return u.aux == 0; }
    __device__ __forceinline__ void operator()(Acc& acc, const Unit& u, int wr, int wc, int fr, int fq) const {
        const int row0 = u.pm * BM + wr * 64 + fr, col0 = u.pn * BM + wc * 32 + 8 * fq;
        if (u.aux == 0) {
#pragma unroll
            for (int ai = 0; ai < 2; ++ai)
#pragma unroll
                for (int m = 0; m < 4; ++m) { const int row = row0 + ai * HALF + m * 16;
#pragma unroll
                    for (int bj = 0; bj < 2; ++bj) { const int col = col0 + bj * HALF;
                        const u32x4 g1 = *(const u32x4*)(GMb + (size_t)row * 4096 + 2048 + col), g0 = *(const u32x4*)(GMb + (size_t)row * 4096 + col);
                        const f32x4 g1a = {bf_lo(g1.x), bf_hi(g1.x), bf_lo(g1.y), bf_hi(g1.y)}, g1b = {bf_lo(g1.z), bf_hi(g1.z), bf_lo(g1.w), bf_hi(g1.w)};
                        const f32x4 g0a = {bf_lo(g0.x), bf_hi(g0.x), bf_lo(g0.y), bf_hi(g0.y)}, g0b = {bf_lo(g0.z), bf_hi(g0.z), bf_lo(g0.w), bf_hi(g0.w)};
#pragma unroll
                        for (int j = 0; j < 4; ++j) { acc[ai][bj][m][0][j] *= g0a[j] * __builtin_amdgcn_rcpf(fmaxf(g1a[j], 1e-30f)); acc[ai][bj][m][1][j] *= g0b[j] * __builtin_amdgcn_rcpf(fmaxf(g1b[j], 1e-30f)); } } }
        } else {
            u32x4 ga[8][2];
#pragma unroll
            for (int g = 0; g < 8; ++g)
#pragma unroll
                for (int bj = 0; bj < 2; ++bj) ga[g][bj] = *(const u32x4*)(GMb + (size_t)(row0 + (g >> 2) * HALF + (g & 3) * 16) * 4096 + 2048 + col0 + bj * HALF);
#pragma unroll
            for (int g = 0; g < 8; ++g) { const int ai = g >> 2, m = g & 3, row = row0 + ai * HALF + m * 16;
#pragma unroll
                for (int bj = 0; bj < 2; ++bj) { const u32x4 g1 = ga[g][bj];
                    const f32x4 g1a = {bf_lo(g1.x), bf_hi(g1.x), bf_lo(g1.y), bf_hi(g1.y)}, g1b = {bf_lo(g1.z), bf_hi(g1.z), bf_lo(g1.w), bf_hi(g1.w)};
                    const f32x4 v0 = acc[ai][bj][m][0] * g1a * zscale, v1 = acc[ai][bj][m][1] * g1b * zscale;
                    u32x2 w; w.x = cvt4_fp8(v0[0], v0[1], v0[2], v0[3]); w.y = cvt4_fp8(v1[0], v1[1], v1[2], v1[3]);
                    *(u32x2*)(Z + (size_t)row * D + col0 + bj * HALF) = w; } }
        }
    }
};
struct EpiResid {
    static constexpr bool PERM = true;
    const void* xin; int xin16; bf16_t* XB; u64* rsq_out; unsigned char* X8; float ascale;
    __device__ __forceinline__ bool keep(const Unit&) const { return false; }
    __device__ __forceinline__ void ldx(size_t off, f32x4& a, f32x4& b) const {
        if (xin16) { const u32x4 w = *(const u32x4*)((const bf16_t*)xin + off); a = f32x4{bf_lo(w.x), bf_hi(w.x), bf_lo(w.y), bf_hi(w.y)}; b = f32x4{bf_lo(w.z), bf_hi(w.z), bf_lo(w.w), bf_hi(w.w)}; }
        else { a = *(const f32x4*)((const float*)xin + off); b = *(const f32x4*)((const float*)xin + off + 4); } }
    __device__ __forceinline__ void operator()(const Acc& acc, const Unit& u, int wr, int wc, int fr, int fq) const {
        const int row0 = u.pm * BM + wr * 64 + fr, col0 = u.pn * BM + wc * 32 + 8 * fq;
        if (xin16) {
            u32x4 xa[8][2];
#pragma unroll
            for (int g = 0; g < 8; ++g)
#pragma unroll
                for (int bj = 0; bj < 2; ++bj) xa[g][bj] = *(const u32x4*)((const bf16_t*)xin + (size_t)(row0 + (g >> 2) * HALF + (g & 3) * 16) * D + col0 + bj * HALF);
#pragma unroll
            for (int g = 0; g < 8; ++g) { const int ai = g >> 2, m = g & 3, row = row0 + ai * HALF + m * 16; const size_t off = (size_t)row * D + col0; float ss = 0.f;
#pragma unroll
                for (int bj = 0; bj < 2; ++bj) { const size_t o = off + bj * HALF; const u32x4 w_ = xa[g][bj];
                    const f32x4 x0 = f32x4{bf_lo(w_.x), bf_hi(w_.x), bf_lo(w_.y), bf_hi(w_.y)} + acc[ai][bj][m][0] * ascale, x1 = f32x4{bf_lo(w_.z), bf_hi(w_.z), bf_lo(w_.w), bf_hi(w_.w)} + acc[ai][bj][m][1] * ascale;
                    { u32x4 w; w.x = cvt_pk_bf16(x0[0], x0[1]); w.y = cvt_pk_bf16(x0[2], x0[3]); w.z = cvt_pk_bf16(x1[0], x1[1]); w.w = cvt_pk_bf16(x1[2], x1[3]); *(u32x4*)(XB + o) = w; }
                    if (X8) { u32x2 w; w.x = cvt4_fp8(x0[0], x0[1], x0[2], x0[3]); w.y = cvt4_fp8(x1[0], x1[1], x1[2], x1[3]); *(u32x2*)(X8 + o) = w; }
                    ss += (x0[0] * x0[0] + x0[1] * x0[1]) + (x0[2] * x0[2] + x0[3] * x0[3]) + (x1[0] * x1[0] + x1[1] * x1[1]) + (x1[2] * x1[2] + x1[3] * x1[3]); }
                ss += __shfl_xor(ss, 16); ss += __shfl_xor(ss, 32);
                if (fq == 0) atomicAdd(rsq_out + row, (u64)(ss * RSQ_SCALE + 0.5f)); }
            return; }
        f32x4 xc[2][2], xn[2][2];
#pragma unroll
        for (int bj = 0; bj < 2; ++bj) ldx((size_t)row0 * D + col0 + bj * HALF, xc[bj][0], xc[bj][1]);
#pragma unroll
        for (int g = 0; g < 8; ++g) { const int ai = g >> 2, m = g & 3, row = row0 + ai * HALF + m * 16; const size_t off = (size_t)row * D + col0; float ss = 0.f;
            if (g < 7) { const size_t offn = (size_t)(row0 + ((g + 1) >> 2) * HALF + ((g + 1) & 3) * 16) * D + col0;
#pragma unroll
                for (int bj = 0; bj < 2; ++bj) ldx(offn + bj * HALF, xn[bj][0], xn[bj][1]); }
#pragma unroll
            for (int bj = 0; bj < 2; ++bj) { const size_t o = off + bj * HALF; const f32x4 x0 = xc[bj][0] + acc[ai][bj][m][0] * ascale, x1 = xc[bj][1] + acc[ai][bj][m][1] * ascale;
                { u32x4 w; w.x = cvt_pk_bf16(x0[0], x0[1]); w.y = cvt_pk_bf16(x0[2], x0[3]); w.z = cvt_pk_bf16(x1[0], x1[1]); w.w = cvt_pk_bf16(x1[2], x1[3]); *(u32x4*)(XB + o) = w; }
                if (X8) { u32x2 w; w.x = cvt4_fp8(x0[0], x0[1], x0[2], x0[3]); w.y = cvt4_fp8(x1[0], x1[1], x1[2], x1[3]); *(u32x2*)(X8 + o) = w; }
                ss += (x0[0] * x0[0] + x0[1] * x0[1]) + (x0[2] * x0[2] + x0[3] * x0[3]) + (x1[0] * x1[0] + x1[1] * x1[1]) + (x1[2] * x1[2] + x1[3] * x1[3]); }
            ss += __shfl_xor(ss, 16); ss += __shfl_xor(ss, 32);
            if (fq == 0) atomicAdd(rsq_out + row, (u64)(ss * RSQ_SCALE + 0.5f));
#pragma unroll
            for (int bj = 0; bj < 2; ++bj)
#pragma unroll
                for (int n = 0; n < 2; ++n) xc[bj][n] = xn[bj][n]; }
    }
};
template <bool MOE, bool OUT8 = MOE, bool W8 = MOE> struct EpiGateUp {
    static constexpr bool PERM = true;
    bf16_t* ACT; const u64* rsq; const int* ltok; const volatile LAS unsigned* misc;
    __device__ __forceinline__ bool keep(const Unit&) const { return false; }
    __device__ __forceinline__ void operator()(const Acc& acc, const Unit& u, int wr, int wc, int fr, int fq) const {
        const int row0 = u.pm * BM + wr * 64 + fr, col0 = u.pn * 128 + wc * 32 + 8 * fq;
        int cnt = 0, r0 = 0; if (MOE) { cnt = (int)misc[8 + u.aux]; r0 = (u.pm - (int)misc[16 + u.aux]) * BM + wr * 64 + fr; }
        int srow[2][4]; u64 rq[2][4];
#pragma unroll
        for (int ai = 0; ai < 2; ++ai)
#pragma unroll
            for (int m = 0; m < 4; ++m) { srow[ai][m] = row0 + ai * HALF + m * 16; if (MOE) { const int r = r0 + ai * HALF + m * 16; srow[ai][m] = r < cnt ? ltok[u.aux * M + r] : 0; } }
#pragma unroll
        for (int ai = 0; ai < 2; ++ai)
#pragma unroll
            for (int m = 0; m < 4; ++m) rq[ai][m] = rsq[srow[ai][m]];
#pragma unroll
        for (int ai = 0; ai < 2; ++ai)
#pragma unroll
            for (int m = 0; m < 4; ++m) { const int row = row0 + ai * HALF + m * 16;
                const float rstd = rsqrtf((float)rq[ai][m] * (1.0f / (RSQ_SCALE * D)) + NORM_EPS) * (W8 ? 1.0f / WGU8_SCALE : 1.0f);
                const float c1 = -1.4426950408889634f * rstd, r2 = rstd * rstd;
                f32x4 a[2];
#pragma unroll
                for (int n = 0; n < 2; ++n) { const f32x4 g = acc[ai][0][m][n], up = acc[ai][1][m][n]; const f32x4 t = g * c1, gu = g * up; f32x4 e, sg;
#pragma unroll
                    for (int j = 0; j < 4; ++j) e[j] = __builtin_amdgcn_exp2f(t[j]);
                    const f32x4 d = e + 1.0f;
#pragma unroll
                    for (int j = 0; j < 4; ++j) sg[j] = __builtin_amdgcn_rcpf(d[j]);
                    a[n] = gu * (sg * r2); }
                if (OUT8) { u32x2 w; w.x = cvt4_fp8(a[0][0], a[0][1], a[0][2], a[0][3]); w.y = cvt4_fp8(a[1][0], a[1][1], a[1][2], a[1][3]); *(u32x2*)((unsigned char*)ACT + (size_t)row * FF + col0) = w; }
                else { u32x4 w; w.x = cvt_pk_bf16(a[0][0], a[0][1]); w.y = cvt_pk_bf16(a[0][2], a[0][3]); w.z = cvt_pk_bf16(a[1][0], a[1][1]); w.w = cvt_pk_bf16(a[1][2], a[1][3]); *(u32x4*)(ACT + (size_t)row * FF + col0) = w; } }
    }
};
struct EpiMoeDown {
    static constexpr bool PERM = true;
    bf16_t* YS; const float* lw; const volatile LAS unsigned* misc;
    __device__ __forceinline__ bool keep(const Unit&) const { return false; }
    __device__ __forceinline__ void operator()(const Acc& acc, const Unit& u, int wr, int wc, int fr, int fq) const {
        const int row0 = u.pm * BM + wr * 64 + fr, col0 = u.pn * BM + wc * 32 + 8 * fq;
        const int cnt = (int)misc[8 + u.aux], r0 = (u.pm - (int)misc[16 + u.aux]) * BM + wr * 64 + fr;
        float wg[2][4];
#pragma unroll
        for (int ai = 0; ai < 2; ++ai)
#pragma unroll
            for (int m = 0; m < 4; ++m) { const int r = r0 + ai * HALF + m * 16; wg[ai][m] = r < cnt ? lw[u.aux * M + r] * (1.0f / WD8_SCALE) : 0.f; }
#pragma unroll
        for (int ai = 0; ai < 2; ++ai)
#pragma unroll
            for (int m = 0; m < 4; ++m) { const int row = row0 + ai * HALF + m * 16; const float wgt = wg[ai][m];
#pragma unroll
                for (int bj = 0; bj < 2; ++bj) { const f32x4 v0 = acc[ai][bj][m][0] * wgt, v1 = acc[ai][bj][m][1] * wgt;
                    u32x4 w; w.x = cvt_pk_bf16(v0[0], v0[1]); w.y = cvt_pk_bf16(v0[2], v0[3]); w.z = cvt_pk_bf16(v1[0], v1[1]); w.w = cvt_pk_bf16(v1[2], v1[3]);
                    *(u32x4*)(YS + (size_t)row * D + col0 + bj * HALF) = w; } }
    }
};
struct EpiMoeDownTail {
    static constexpr bool PERM = true;
    bf16_t* YT; const float* lw; const volatile LAS unsigned* misc;
    __device__ __forceinline__ bool keep(const Unit&) const { return false; }
    __device__ __forceinline__ void operator()(const Acc& acc, const Unit& u, int wr, int wc, int fr, int fq) const {
        const int e = u.aux & 255, part = u.aux >> 8, Tm = (int)misc[25];
        const int row0 = (u.pm - Tm) * BM + wr * 64 + fr, col0 = u.pn * BM + wc * 32 + 8 * fq;
        const int cnt = (int)misc[8 + e], r0 = (u.pm - (int)misc[16 + e]) * BM + wr * 64 + fr;
        float wg[2][4];
#pragma unroll
        for (int ai = 0; ai < 2; ++ai)
#pragma unroll
            for (int m = 0; m < 4; ++m) { const int r = r0 + ai * HALF + m * 16; wg[ai][m] = r < cnt ? lw[e * M + r] * (1.0f / WD8_SCALE) : 0.f; }
        bf16_t* Y = YT + (size_t)part * YT_ROWS * D;
#pragma unroll
        for (int ai = 0; ai < 2; ++ai)
#pragma unroll
            for (int m = 0; m < 4; ++m) { const int row = row0 + ai * HALF + m * 16; const float wgt = wg[ai][m];
#pragma unroll
                for (int bj = 0; bj < 2; ++bj) { const f32x4 v0 = acc[ai][bj][m][0] * wgt, v1 = acc[ai][bj][m][1] * wgt;
                    u32x4 w; w.x = cvt_pk_bf16(v0[0], v0[1]); w.y = cvt_pk_bf16(v0[2], v0[3]); w.z = cvt_pk_bf16(v1[0], v1[1]); w.w = cvt_pk_bf16(v1[2], v1[3]);
                    *(u32x4*)(Y + (size_t)row * D + col0 + bj * HALF) = w; } }
    }
};
}

namespace att {
constexpr float SCALE = 0.08838834764831845f, LOG2E = 1.4426950408889634f, C2 = LOG2E * SCALE, THR = 8.f;
constexpr int TILE_B = 16384;
#define KSWZ(row, colB) ((row) * 256 + ((colB) ^ (((row) & 7) << 4)))
#define SBAR() __builtin_amdgcn_sched_barrier(0)
__device__ __forceinline__ int v_st(int k, int c) { const int kk = (k & ~0xC) | ((k & 4) << 1) | ((k & 8) >> 1); return ((kk >> 3) * 4 + (c >> 5)) * 512 + ((kk & 7) * 32 + (c & 31)) * 2; }
__device__ __forceinline__ int v_rd_base(int lane) { return ((lane & 3) << 3) | (((lane >> 2) & 3) << 6) | (((lane >> 4) & 1) << 5) | (((lane >> 5) & 1) << 8); }
constexpr int v_rd_off(int d0, int ks, int half) { return d0 * 512 + ks * 4096 + half * 2048; }
__device__ __forceinline__ int crow(int r, int hi) { return (r & 3) + 8 * (r >> 2) + 4 * hi; }

__device__ __forceinline__ void mask_tile(f32x16& p0, f32x16& p1, int dq, unsigned W) {
    const float NEG = -__builtin_inff();
#pragma unroll
    for (int r = 0; r < 16; ++r) { const int c = (r & 3) + 8 * (r >> 2);
        if ((unsigned)(dq - c) >= W) p0[r] = NEG;
        if ((unsigned)(dq - c - 32) >= W) p1[r] = NEG; }
}
__device__ __forceinline__ void mask_all(f32x16& p0, f32x16& p1, bool keep) {
    const float NEG = -__builtin_inff();
#pragma unroll
    for (int r = 0; r < 16; ++r) { p0[r] = keep ? p0[r] : NEG; p1[r] = keep ? p1[r] : NEG; }
}
__device__ __forceinline__ float rowmax32(const f32x16& p0, const f32x16& p1) {
    float pmax = p0[0];
#pragma unroll
    for (int r = 1; r < 16; ++r) pmax = fmaxf(pmax, p0[r]);
#pragma unroll
    for (int r = 0; r < 16; ++r) pmax = fmaxf(pmax, p1[r]);
    auto rr = __builtin_amdgcn_permlane32_swap(__float_as_uint(pmax), __float_as_uint(pmax), false, false);
    return fmaxf(__uint_as_float(rr[0]), __uint_as_float(rr[1]));
}
__device__ __forceinline__ float rowsum32(const f32x16& p0, const f32x16& p1) {
    float ps = 0.f;
#pragma unroll
    for (int r = 0; r < 16; ++r) ps += p0[r];
#pragma unroll
    for (int r = 0; r < 16; ++r) ps += p1[r];
    auto rr = __builtin_amdgcn_permlane32_swap(__float_as_uint(ps), __float_as_uint(ps), false, false);
    return __uint_as_float(rr[0]) + __uint_as_float(rr[1]);
}
__device__ __forceinline__ void pack_p(const f32x16& p0, const f32x16& p1, bf16x8& pa0, bf16x8& pa1, bf16x8& pa2, bf16x8& pa3) {
#define PK4(P, B_, OUT) do { unsigned a0 = cvt_pk_bf16(P[B_+0], P[B_+1]), a1 = cvt_pk_bf16(P[B_+2], P[B_+3]);                          \
        unsigned b0 = cvt_pk_bf16(P[B_+4], P[B_+5]), b1 = cvt_pk_bf16(P[B_+6], P[B_+7]);                                             \
        auto r0 = __builtin_amdgcn_permlane32_swap(a0, b0, false, false); auto r1 = __builtin_amdgcn_permlane32_swap(a1, b1, false, false); \
        u32x4 w = {r0[0], r1[0], r0[1], r1[1]}; OUT = *reinterpret_cast<bf16x8*>(&w); } while (0)
    PK4(p0, 0, pa0); PK4(p0, 8, pa1); PK4(p1, 0, pa2); PK4(p1, 8, pa3);
#undef PK4
}
__device__ __forceinline__ void softmax_step(f32x16& p0, f32x16& p1, float& m_reg, float& l_reg, float& alpha) {
    const float pmax = rowmax32(p0, p1); float mn;
    if (__builtin_expect(__all((pmax - m_reg) * SCALE <= THR), 1)) { mn = m_reg; alpha = 1.f; }
    else { mn = fmaxf(m_reg, pmax); alpha = __builtin_amdgcn_exp2f((m_reg - mn) * C2); m_reg = mn; }
    const float mnL = -mn * C2;
#pragma unroll
    for (int r = 0; r < 16; ++r) { p0[r] = __builtin_amdgcn_exp2f(fmaf(p0[r], C2, mnL)); p1[r] = __builtin_amdgcn_exp2f(fmaf(p1[r], C2, mnL)); }
    l_reg = l_reg * alpha + rowsum32(p0, p1);
}
__device__ __forceinline__ void softmax_step_keep(f32x16& p0, f32x16& p1, float& m_reg, float& l_reg, float& alpha, bool keep) {
    const float NEG = -__builtin_inff();
    const float pm = rowmax32(p0, p1), pmax = keep ? pm : NEG; float mn;
    if (__builtin_expect(__all((pmax - m_reg) * SCALE <= THR), 1)) { mn = m_reg; alpha = 1.f; }
    else { mn = fmaxf(m_reg, pmax); alpha = __builtin_amdgcn_exp2f((m_reg - mn) * C2); m_reg = mn; }
    const float c2 = keep ? C2 : 0.f, mnL = keep ? -mn * C2 : NEG;
#pragma unroll
    for (int r = 0; r < 16; ++r) { p0[r] = __builtin_amdgcn_exp2f(fmaf(p0[r], c2, mnL)); p1[r] = __builtin_amdgcn_exp2f(fmaf(p1[r], c2, mnL)); }
    l_reg = l_reg * alpha + rowsum32(p0, p1);
}
__device__ __forceinline__ void qkt(f32x16& p0, f32x16& p1, const LAS char* K_lds, int r32, int hi, const bf16x8* qr) {
    p0 = f32x16{}; p1 = f32x16{};
    const LAS char* kb[4];
#pragma unroll
    for (int dd = 0; dd < 4; ++dd) kb[dd] = K_lds + KSWZ(r32, (dd * 16 + hi * 8) * 2);
#pragma unroll
    for (int d0 = 0; d0 < 8; ++d0) { const LAS char* a = kb[d0 & 3] + (d0 >> 2) * 128;
        const bf16x8 b0 = *reinterpret_cast<const LAS bf16x8*>(a);
        const bf16x8 b1 = *reinterpret_cast<const LAS bf16x8*>(a + 32 * 256);
        p0 = __builtin_amdgcn_mfma_f32_32x32x16_bf16(b0, qr[d0], p0, 0, 0, 0);
        p1 = __builtin_amdgcn_mfma_f32_32x32x16_bf16(b1, qr[d0], p1, 0, 0, 0); }
}
__device__ __forceinline__ void pv_tile(f32x16* o, int vb0, bf16x8 pa0, bf16x8 pa1, bf16x8 pa2, bf16x8 pa3) {
#define TRRD(dst, off) asm volatile("ds_read_b64_tr_b16 %0, %1 offset:%2" : "=&v"(dst) : "v"(vb0), "i"(off) : "memory")
#define PV_D0(d0) do { s16x4 l0, l1, l2, l3, h0, h1, h2, h3; constexpr int b_ = v_rd_off(d0, 0, 0); \
        TRRD(l0, b_); TRRD(h0, b_ + 2048); TRRD(l1, b_ + 4096); TRRD(h1, b_ + 6144); TRRD(l2, b_ + 8192); TRRD(h2, b_ + 10240); TRRD(l3, b_ + 12288); TRRD(h3, b_ + 14336); \
        asm volatile("s_waitcnt lgkmcnt(0)" ::: "memory"); SBAR();   \
        o[d0] = __builtin_amdgcn_mfma_f32_32x32x16_bf16(pa0, (bf16x8){l0[0], l0[1], l0[2], l0[3], h0[0], h0[1], h0[2], h0[3]}, o[d0], 0, 0, 0);   \
        o[d0] = __builtin_amdgcn_mfma_f32_32x32x16_bf16(pa1, (bf16x8){l1[0], l1[1], l1[2], l1[3], h1[0], h1[1], h1[2], h1[3]}, o[d0], 0, 0, 0);   \
        o[d0] = __builtin_amdgcn_mfma_f32_32x32x16_bf16(pa2, (bf16x8){l2[0], l2[1], l2[2], l2[3], h2[0], h2[1], h2[2], h2[3]}, o[d0], 0, 0, 0);   \
        o[d0] = __builtin_amdgcn_mfma_f32_32x32x16_bf16(pa3, (bf16x8){l3[0], l3[1], l3[2], l3[3], h3[0], h3[1], h3[2], h3[3]}, o[d0], 0, 0, 0); } while (0)
    PV_D0(0); PV_D0(1); PV_D0(2); PV_D0(3);
#undef PV_D0
#undef TRRD
}

struct Ctx {
    int tid, wid, lane, r32, hi, sr, sc, kws, vst0, vst1, vb0;
    LAS char* K_lds; LAS char* V_lds; LAS float* wscr;
};
__device__ __forceinline__ Ctx make_ctx(LAS unsigned char* lds) {
    Ctx c; c.tid = opaque_tid(); c.wid = __builtin_amdgcn_readfirstlane(c.tid >> 6); c.lane = c.tid & 63; c.r32 = c.lane & 31; c.hi = c.lane >> 5;
    c.sr = c.tid >> 4; c.sc = (c.tid & 15) * 8; c.kws = KSWZ(c.sr, c.sc * 2); c.vst0 = v_st(c.sr, c.sc); c.vst1 = v_st(32 + c.sr, c.sc);
    c.K_lds = (LAS char*)(lds + LDS_K); c.V_lds = (LAS char*)(lds + LDS_V); c.wscr = (LAS float*)(lds + LDS_WSCR) + c.wid * 64;
    c.vb0 = (int)(unsigned)(uintptr_t)c.V_lds + v_rd_base(c.lane);
    return c;
}
__device__ __forceinline__ void glds16(const void* sbase, unsigned voff, unsigned lds_dst) { unsigned keep;
    asm volatile("s_mov_b32 %0, m0\n\ts_mov_b32 m0, %3\n\ts_nop 0\n\tglobal_load_lds_dwordx4 %1, %2\n\ts_mov_b32 m0, %0" : "=&s"(keep) : "v"(voff), "s"(sbase), "s"(lds_dst) : "memory"); }
__device__ __forceinline__ const void* uniform_ptr(const void* p) { const unsigned long long v = (unsigned long long)p; const unsigned lo = __builtin_amdgcn_readfirstlane((unsigned)v), hi = __builtin_amdgcn_readfirstlane((unsigned)(v >> 32));
    return (const void*)(GAS const void*)(((unsigned long long)hi << 32) | lo); }
struct Dma { unsigned ko[2], vo[2]; };
__device__ __forceinline__ Dma make_dma(const Ctx& c, int ldk, int ldv) {
    Dma d;
#pragma unroll
    for (int i = 0; i < 2; ++i) { const int p = c.wid * 2 + i, row = 4 * p + (c.lane >> 4); d.ko[i] = (unsigned)(row * ldk + (((c.lane & 15) ^ (row & 7)) * 8)) * 2u;
        const int st = 2 * p + (c.lane >> 5), kk = (st >> 2) * 8 + ((c.lane & 31) >> 2), k = (kk & ~0xC) | ((kk & 4) << 1) | ((kk & 8) >> 1); d.vo[i] = (unsigned)(k * ldv + (st & 3) * 32 + (c.lane & 3) * 8) * 2u; }
    return d;
}
__device__ __forceinline__ void dma_tile(const Ctx& c, const Dma& d, const bf16_t* Kg, int ldk, const bf16_t* Vg, int ldv, int key0, int slot) {
    const void* kb = uniform_ptr(Kg + (size_t)key0 * ldk); const void* vb = uniform_ptr(Vg + (size_t)key0 * ldv);
#pragma unroll
    for (int i = 0; i < 2; ++i) {
        glds16(kb, d.ko[i], (unsigned)__builtin_amdgcn_readfirstlane((int)(unsigned)(uintptr_t)(c.K_lds + slot * TILE_B + (c.wid * 2 + i) * 1024)));
        glds16(vb, d.vo[i], (unsigned)__builtin_amdgcn_readfirstlane((int)(unsigned)(uintptr_t)(c.V_lds + slot * TILE_B + (c.wid * 2 + i) * 1024))); }
}
#define ATT_BAR() do { asm volatile("s_waitcnt lgkmcnt(0)" ::: "memory"); __builtin_amdgcn_s_barrier(); asm volatile("" ::: "memory"); } while (0)
__device__ __forceinline__ void rescale_o(f32x16* o, float alpha, const Ctx& c) {
    if (__any(alpha < 1.f)) { if (c.hi == 0) c.wscr[32 + c.r32] = alpha; LDS_WAIT();
#pragma unroll
        for (int d = 0; d < 4; ++d)
#pragma unroll
            for (int r = 0; r < 16; ++r) o[d][r] *= c.wscr[32 + crow(r, c.hi)];
        LDS_WAIT(); }
}
template <int MODE>
__device__ __forceinline__ void attn_loop_simple(const Ctx& c, const bf16_t* Kg, int ldk, const bf16_t* Vg, int ldv, int j_lo, int NT, const bf16x8* qr,
                                          int qpos, int qlo, int W, unsigned sel_lo, unsigned sel_hi, int diag, f32x16* o, float& m_reg, float& l_reg) {
    f32x16 p0, p1; bf16x8 pa0, pa1, pa2, pa3; float alpha;
    const Dma d = make_dma(c, ldk, ldv);
    dma_tile(c, d, Kg, ldk, Vg, ldv, j_lo * 64, 0);
    if (NT > 1) dma_tile(c, d, Kg, ldk, Vg, ldv, j_lo * 64 + 64, 1);
    int slot = 0, slot2 = 2;
    for (int t = 0; t < NT; ++t) { const int jt = j_lo + t, kb_ = jt * 64, bo = slot * TILE_B;
        if (t + 1 < NT) asm volatile("s_waitcnt vmcnt(4)" ::: "memory"); else asm volatile("s_waitcnt vmcnt(0)" ::: "memory");
        ATT_BAR();
        if (t + 2 < NT) dma_tile(c, d, Kg, ldk, Vg, ldv, kb_ + 128, slot2);
        SBAR(); qkt(p0, p1, c.K_lds + bo, c.r32, c.hi, qr); bool keep = true;
        if (MODE == 0) { if (kb_ + 63 > qlo || kb_ <= qlo + 31 - W) mask_tile(p0, p1, qpos - kb_ - 4 * c.hi, (unsigned)W); }
        else { const unsigned bit = (jt < 32 ? (sel_lo >> jt) : (sel_hi >> (jt - 32))) & 1u; keep = bit != 0u;
               if (jt == diag) mask_tile(p0, p1, qpos - kb_ - 4 * c.hi, 0x40000000u); }
        if (MODE == 2) softmax_step_keep(p0, p1, m_reg, l_reg, alpha, keep); else softmax_step(p0, p1, m_reg, l_reg, alpha); pack_p(p0, p1, pa0, pa1, pa2, pa3); rescale_o(o, alpha, c);
        pv_tile(o, c.vb0 + bo, pa0, pa1, pa2, pa3);
        slot = slot == 2 ? 0 : slot + 1; slot2 = slot2 == 2 ? 0 : slot2 + 1; }
    ATT_BAR();
}
template <int MODE>
__device__ __forceinline__ void attn_loop(const Ctx& c, const bf16_t* Kg, int ldk, const bf16_t* Vg, int ldv, int j_lo, int NT, const bf16x8* qr,
                                          int qpos, int qlo, int W, unsigned sel_lo, unsigned sel_hi, int diag, f32x16* o, float& m_reg, float& l_reg) {
    f32x16 pA0, pA1, pB0, pB1; bf16x8 pa0, pa1, pa2, pa3; float alpha;
    const Dma d = make_dma(c, ldk, ldv);
    dma_tile(c, d, Kg, ldk, Vg, ldv, j_lo * 64, 0);
    if (NT > 1) { dma_tile(c, d, Kg, ldk, Vg, ldv, j_lo * 64 + 64, 1); asm volatile("s_waitcnt vmcnt(4)" ::: "memory"); } else asm volatile("s_waitcnt vmcnt(0)" ::: "memory");
    ATT_BAR();
    if (NT > 2) dma_tile(c, d, Kg, ldk, Vg, ldv, j_lo * 64 + 128, 2);
    SBAR(); qkt(pA0, pA1, c.K_lds, c.r32, c.hi, qr);
#define ATT_STEP(PX0, PX1, PY0, PY1, t_) do { const int t = (t_), jt = j_lo + t, kb_ = jt * 64;                                          \
        if (t + 1 < NT) { if (t + 2 < NT) asm volatile("s_waitcnt vmcnt(4)" ::: "memory"); else asm volatile("s_waitcnt vmcnt(0)" ::: "memory"); }     \
        ATT_BAR();                                                                           \
        if (t + 3 < NT) dma_tile(c, d, Kg, ldk, Vg, ldv, kb_ + 192, (t + 3) & 3);                           \
        SBAR(); if (t + 1 < NT) qkt(PY0, PY1, c.K_lds + ((t + 1) & 3) * TILE_B, c.r32, c.hi, qr);          \
        SBAR();                                                                                  \
        if (MODE == 0) { if (kb_ + 63 > qlo || kb_ <= qlo + 31 - W) mask_tile(PX0, PX1, qpos - kb_ - 4 * c.hi, (unsigned)W); }            \
        else { const unsigned bit = (jt < 32 ? (sel_lo >> jt) : (sel_hi >> (jt - 32))) & 1u; mask_all(PX0, PX1, bit != 0u);               \
               if (jt == diag) mask_tile(PX0, PX1, qpos - kb_ - 4 * c.hi, 0x40000000u); }                                                \
        softmax_step(PX0, PX1, m_reg, l_reg, alpha); pack_p(PX0, PX1, pa0, pa1, pa2, pa3); rescale_o(o, alpha, c);                        \
        pv_tile(o, c.vb0 + (t & 3) * TILE_B, pa0, pa1, pa2, pa3); } while (0)
    for (int t2 = 0; t2 < NT; t2 += 2) { ATT_STEP(pA0, pA1, pB0, pB1, t2); if (t2 + 1 < NT) ATT_STEP(pB0, pB1, pA0, pA1, t2 + 1); }
#undef ATT_STEP
    ATT_BAR();
}
__device__ __forceinline__ void load_q(bf16x8* qr, const bf16_t* qrow, int hi) {
#pragma unroll
    for (int d0 = 0; d0 < 8; ++d0) qr[d0] = *(const bf16x8*)(qrow + d0 * 16 + hi * 8);
    asm volatile("" :: "v"(qr[0]), "v"(qr[1]), "v"(qr[2]), "v"(qr[3]), "v"(qr[4]), "v"(qr[5]), "v"(qr[6]), "v"(qr[7]));
}
template <bool ADD, bool OUT8 = false>
__device__ __forceinline__ void store_o(const f32x16* o, float frow, const Ctx& c, bf16_t* Og, int ldo, float fold_row = 1.0f, bool has_fold = false, unsigned char* O8 = nullptr) {
    if (c.hi == 0) { c.wscr[c.r32] = frow; c.wscr[32 + c.r32] = fold_row; } LDS_WAIT();
    LAS float* stg = (LAS float*)(c.K_lds + c.wid * 16384);
#pragma unroll
    for (int r = 0; r < 16; ++r) { const int row = crow(r, c.hi); const float f = c.wscr[row];
#pragma unroll
        for (int d0 = 0; d0 < 4; ++d0) stg[row * 128 + d0 * 32 + c.r32] = o[d0][r] * f; }
    LDS_WAIT();
    const int cc = c.lane & 15, rq = c.lane >> 4;
#pragma unroll
    for (int hb = 0; hb < 8; hb += 4) {
        int hbv = hb; asm volatile("" : "+v"(hbv));
        u32x4 old[4];
        if (ADD) {
#pragma unroll
            for (int i = 0; i < 4; ++i) old[i] = *(const u32x4*)(Og + (size_t)(rq + 4 * (hbv + i)) * 1024 + cc * 8);
        }
#pragma unroll
        for (int i = 0; i < 4; ++i) { const int row = rq + 4 * (hbv + i);
            f32x4 v0 = *(const LAS f32x4*)(stg + row * 128 + cc * 8), v1 = *(const LAS f32x4*)(stg + row * 128 + cc * 8 + 4);
            if (ADD) { const float fo = has_fold ? c.wscr[32 + row] : 1.0f;
                v0[0] = fmaf(bf_lo(old[i].x), fo, v0[0]); v0[1] = fmaf(bf_hi(old[i].x), fo, v0[1]); v0[2] = fmaf(bf_lo(old[i].y), fo, v0[2]); v0[3] = fmaf(bf_hi(old[i].y), fo, v0[3]);
                v1[0] = fmaf(bf_lo(old[i].z), fo, v1[0]); v1[1] = fmaf(bf_hi(old[i].z), fo, v1[1]); v1[2] = fmaf(bf_lo(old[i].w), fo, v1[2]); v1[3] = fmaf(bf_hi(old[i].w), fo, v1[3]); }
            if constexpr (OUT8) { u32x2 w; w.x = cvt4_fp8(v0[0] * O8_SCALE, v0[1] * O8_SCALE, v0[2] * O8_SCALE, v0[3] * O8_SCALE); w.y = cvt4_fp8(v1[0] * O8_SCALE, v1[1] * O8_SCALE, v1[2] * O8_SCALE, v1[3] * O8_SCALE);
                *(u32x2*)(O8 + (size_t)row * ldo + cc * 8) = w; }
            else { u32x4 w; w.x = cvt_pk_bf16(v0[0], v0[1]); w.y = cvt_pk_bf16(v0[2], v0[3]); w.z = cvt_pk_bf16(v1[0], v1[1]); w.w = cvt_pk_bf16(v1[2], v1[3]);
                *(u32x4*)(Og + (size_t)row * ldo + cc * 8) = w; } }
        asm volatile("" ::: "memory");
    }
    LDS_WAIT();
}
}

struct Frame {
    LAS unsigned char* lds; volatile LAS unsigned* misc; unsigned* ctl;
    int tid, lane, wave, G, vcu;
    const float* const* in; float* out; unsigned char* ws;
};
__device__ __forceinline__ void launder(Frame& F) { unsigned long long w_ = (unsigned long long)F.ws; asm volatile("" : "+s"(w_)); F.ws = (unsigned char*)(GAS unsigned char*)w_; F.out = (float*)(GAS float*)F.out; F.ctl = (unsigned*)(GAS unsigned*)F.ctl; asm volatile("" : "+v"(F.tid)); F.lane = F.tid & 63; F.wave = __builtin_amdgcn_readfirstlane(F.tid >> 6); }
enum { IN_X = 0, IN_ANORM, IN_WIN, IN_SINK, IN_PEK, IN_PEV, IN_WK1, IN_WK2, IN_WV1, IN_WV2, IN_WUPA, IN_WUPB, IN_WO, IN_FNORM, IN_DWG, IN_DWU, IN_DWD, IN_RW, IN_MWG, IN_MWU, IN_MWD, IN_FINAL };
#define INP(i) ((const float*)(const GAS float*)F.in[i])
#define WSP(T_, off) ((T_*)(F.ws + (off)))
#define BGP(T_, off) ((T_*)(F.ws + WS_BIG + (off)))

__device__ __forceinline__ int queue_pop(Frame& F, int q) {
    __syncthreads();
    if (F.tid == 0) F.misc[2] = __hip_atomic_fetch_add(F.ctl + CW_QUEUE + 64 * q, 1u, RLX_AGENT);
    __syncthreads();
    return (int)F.misc[2];
}

__device__ __forceinline__ int tr_drow(int mode, int n, int nn) {
    if (mode == 0) return n;
    if (mode == 1) { if (n < 4096) { const int d = n & 127; return (n & ~127) + 32 * ((d >> 4) & 3) + 8 * ((d >> 2) & 3) + 4 * (d >> 6) + (d & 3); }
                     return n < 4120 ? 8192 + (n - 4096) : 4096 + (n - 4120); }
    return 256 * (n >> 7) + 128 * nn + (n & 127);
}
__device__ __forceinline__ void tr_item(int mode, int nn, const float* W, int ld, int nsrc, const float* gain, int K, bf16_t* WT, int item, int nblk, int lane) {
    const int kb = item / nblk, nb = item - kb * nblk, kg = lane & 7, nq = lane >> 3, k0 = 64 * kb + 8 * kg, n = 32 * nb + 4 * nq;
    if (n >= nsrc) return;
    const float* p = W + (size_t)k0 * ld + n; f32x4 v[8];
#pragma unroll
    for (int j = 0; j < 8; ++j) v[j] = __builtin_nontemporal_load((const f32x4*)(p + (size_t)j * ld));
    if (gain) { const f32x4 g0 = *(const f32x4*)(gain + k0), g1 = *(const f32x4*)(gain + k0 + 4);
#pragma unroll
        for (int j = 0; j < 4; ++j) { v[j] = v[j] * g0[j]; v[4 + j] = v[4 + j] * g1[j]; } }
    const int c = tr_drow(mode, n, nn);
#pragma unroll
    for (int q = 0; q < 4; ++q) { u32x4 o; o.x = cvt_pk_bf16(v[0][q], v[1][q]); o.y = cvt_pk_bf16(v[2][q], v[3][q]); o.z = cvt_pk_bf16(v[4][q], v[5][q]); o.w = cvt_pk_bf16(v[6][q], v[7][q]);
        *(u32x4*)(WT + (size_t)(c + q) * K + k0) = o; }
}
__device__ __forceinline__ void tr_item8(int mode, int nn, const float* W, int ld, int nsrc, const float* gain, float scale, int K, unsigned char* WT, int item, int nblk, int lane) {
    const int kb = item / nblk, nb = item - kb * nblk, kg = lane & 7, nq = lane >> 3, k0 = 128 * kb + 16 * kg, n = 32 * nb + 4 * nq;
    if (n >= nsrc) return;
    const float* p = W + (size_t)k0 * ld + n; f32x4 v[16];
#pragma unroll
    for (int j = 0; j < 16; ++j) v[j] = __builtin_nontemporal_load((const f32x4*)(p + (size_t)j * ld));
#pragma unroll
    for (int j4 = 0; j4 < 4; ++j4) { f32x4 g = {scale, scale, scale, scale}; if (gain) g = *(const f32x4*)(gain + k0 + 4 * j4) * scale;
#pragma unroll
        for (int j = 0; j < 4; ++j) v[4 * j4 + j] = v[4 * j4 + j] * g[j]; }
    const int c = tr_drow(mode, n, nn);
#pragma unroll
    for (int q = 0; q < 4; ++q) { u32x4 o; o.x = cvt4_fp8(v[0][q], v[1][q], v[2][q], v[3][q]); o.y = cvt4_fp8(v[4][q], v[5][q], v[6][q], v[7][q]); o.z = cvt4_fp8(v[8][q], v[9][q], v[10][q], v[11][q]); o.w = cvt4_fp8(v[12][q], v[13][q], v[14][q], v[15][q]);
        __builtin_nontemporal_store(o, (u32x4*)(WT + (size_t)(c + q) * K + k0)); }
}
__device__ __forceinline__ void p_prologue(Frame F) {
    launder(F);
    const int gw = F.vcu * NWAVES + F.wave, NGW = F.G * NWAVES, lane = F.lane;
    constexpr int NB_IN = (IN_DIM + 31) / 32;
    { long long* cb = WSP(long long, WS_CBIAS);
      for (int u = gw; u < 1024; u += NGW) { const int q = u >> 8, l = q >> 1, kv = q & 1, nb = (u >> 6) & 3, kc = u & 63, n = nb * 64 + lane;
          const float* pe = INP(kv ? IN_PEV : IN_PEK) + (size_t)l * 4096 + kc * 64; const float* w1 = INP(kv ? IN_WV1 : IN_WK1) + (size_t)l * 4096 * 256 + (size_t)kc * 64 * 256 + n;
          float wv[64];
#pragma unroll
          for (int k = 0; k < 64; ++k) wv[k] = w1[(size_t)k * 256];
          float a0 = 0.f, a1 = 0.f, a2 = 0.f, a3 = 0.f;
#pragma unroll
          for (int k = 0; k < 64; k += 4) { a0 = fmaf(pe[k], wv[k], a0); a1 = fmaf(pe[k + 1], wv[k + 1], a1); a2 = fmaf(pe[k + 2], wv[k + 2], a2); a3 = fmaf(pe[k + 3], wv[k + 3], a3); }
          const float sum = (a0 + a1) + (a2 + a3);
          atomicAdd((unsigned long long*)(cb + q * 256 + n), (unsigned long long)(long long)rintf(sum * CB_SCALE)); } }
    constexpr int I_WIN = (D / 128) * NB_IN, I_W1 = (4096 / 64) * (256 / 32), I_W2 = (256 / 64) * (128 / 32), I_WUP = (1024 / 128) * (D / 32), I_WO = (D / 128) * (D / 32);
    {   constexpr int BI_G = (D / 128) * (FF / 256), BI_D = (FF / 128) * (D / 256), NBI = 16 * BI_G + 9 * BI_D;
        LAS unsigned char* tile = F.lds;
        for (int bi = F.vcu; bi < NBI; bi += F.G) {
            const float* W; const float* gain = nullptr; float scale; unsigned char* dst; int ld, Kd, mode = 0, nn = 0, kb, nb;
            if (bi < 16 * BI_G) { const int q = bi / BI_G, r = bi - q * BI_G, e = q >> 1; nn = q & 1; mode = 2; W = INP(nn ? IN_MWU : IN_MWG) + (size_t)e * D * FF; ld = FF; gain = INP(IN_FNORM) + D; scale = WGU8_SCALE;
                dst = WSP(unsigned char, WS_WGUM + (size_t)e * SZ_WGU8); Kd = D; kb = r / (FF / 256); nb = r - kb * (FF / 256); }
            else { const int r0 = bi - 16 * BI_G, e = r0 / BI_D, r = r0 - e * BI_D; ld = D; scale = WD8_SCALE;
                if (e < 8) { W = INP(IN_MWD) + (size_t)e * FF * D; dst = WSP(unsigned char, WS_WDM + (size_t)e * SZ_WD8); } else { W = INP(IN_DWD); dst = WSP(unsigned char, WS_WDD); }
                Kd = FF; kb = r / (D / 256); nb = r - kb * (D / 256); }
            const int k0 = 128 * kb + 16 * F.wave, n = 256 * nb + 4 * lane;
            const float* p = W + (size_t)k0 * ld + n; f32x4 v[16];
#pragma unroll
            for (int j = 0; j < 16; ++j) v[j] = __builtin_nontemporal_load((const f32x4*)(p + (size_t)j * ld));
#pragma unroll
            for (int j = 0; j < 16; ++j) { const float g = gain ? gain[k0 + j] * scale : scale; v[j] = v[j] * g; }
#pragma unroll
            for (int q = 0; q < 4; ++q) { u32x4 o; o.x = cvt4_fp8(v[0][q], v[1][q], v[2][q], v[3][q]); o.y = cvt4_fp8(v[4][q], v[5][q], v[6][q], v[7][q]); o.z = cvt4_fp8(v[8][q], v[9][q], v[10][q], v[11][q]); o.w = cvt4_fp8(v[12][q], v[13][q], v[14][q], v[15][q]);
                *(LAS u32x4*)(tile + (4 * lane + q) * 144 + 16 * F.wave) = o; }
            __syncthreads();
#pragma unroll
            for (int i = 0; i < 4; ++i) { const int nrow = 32 * F.wave + 8 * i + (lane >> 3), ch = lane & 7;
                const u32x4 o = *(const LAS u32x4*)(tile + nrow * 144 + 16 * ch);
                __builtin_nontemporal_store(o, (u32x4*)(dst + (size_t)tr_drow(mode, 256 * nb + nrow, nn) * Kd + 128 * kb + 16 * ch)); }
            __syncthreads();
        }
    }
    constexpr int I_G = (D / 64) * (FF / 32);
    constexpr int NITEMS = 2 * I_WIN + 4 * I_W1 + 4 * I_W2 + 4 * I_WUP + 2 * I_WO + 2 * I_G;
    for (int it = gw; it < NITEMS; it += NGW) {
        int r = it;
        if (r < 2 * I_G) { const int nn = r / I_G; r -= nn * I_G;
            tr_item(2, nn, INP(nn ? IN_DWU : IN_DWG), FF, FF, INP(IN_FNORM), D, WSP(bf16_t, WS_WGUD), r, FF / 32, lane); continue; } r -= 2 * I_G;
        if (r < 2 * I_WIN) { const int l = r / I_WIN; r -= l * I_WIN;
            tr_item8(1, 0, INP(IN_WIN) + (size_t)l * D * IN_DIM, IN_DIM, IN_DIM, INP(IN_ANORM) + l * D, WIN8_SCALE, D, WSP(unsigned char, WS_WIN + l * SZ_WIN), r, NB_IN, lane); continue; } r -= 2 * I_WIN;
        if (r < 4 * I_W1) { const int q = r / I_W1; r -= q * I_W1; const int l = q >> 1, kv = q & 1;
            tr_item(0, 0, INP(kv ? IN_WV1 : IN_WK1) + (size_t)l * 4096 * 256, 256, 256, nullptr, 4096, WSP(bf16_t, WS_W1 + q * SZ_W1), r, 256 / 32, lane); continue; } r -= 4 * I_W1;
        if (r < 4 * I_W2) { const int q = r / I_W2; r -= q * I_W2; const int l = q >> 1, kv = q & 1;
            tr_item(0, 0, INP(kv ? IN_WV2 : IN_WK2) + (size_t)l * 256 * 128, 128, 128, nullptr, 256, WSP(bf16_t, WS_W2 + q * SZ_W2), r, 128 / 32, lane); continue; } r -= 4 * I_W2;
        if (r < 4 * I_WUP) { const int q = r / I_WUP; r -= q * I_WUP; const int l = q >> 1, ab = q & 1;
            tr_item8(0, 0, INP(ab ? IN_WUPB : IN_WUPA) + (size_t)l * 1024 * D, D, D, nullptr, WUP8_SCALE, 1024, WSP(unsigned char, WS_WUP + q * SZ_WUP), r, D / 32, lane); continue; } r -= 4 * I_WUP;
        { const int l = r / I_WO; r -= l * I_WO;
            tr_item8(0, 0, INP(IN_WO) + (size_t)l * D * D, D, D, nullptr, WO8_SCALE, D, WSP(unsigned char, WS_WO + l * SZ_WO), r, D / 32, lane); }
    }
    { const int gt = gw * 64 + lane, NGT = NGW * 64; const u32x4 z = {0u, 0u, 0u, 0u};
      for (int i = gt; i < 2 * (NIN - IN_DIM) * (D / 16); i += NGT) { const int l = i / ((NIN - IN_DIM) * (D / 16)), j = i - l * ((NIN - IN_DIM) * (D / 16)); *((u32x4*)(WSP(unsigned char, WS_WIN + l * SZ_WIN) + (size_t)IN_DIM * D) + j) = z; }
      for (int i = gt; i < 4 * 128 * (256 / 8); i += NGT) { const int q = i / (128 * 32), j = i - q * (128 * 32); *((u32x4*)(WSP(bf16_t, WS_W2 + q * SZ_W2) + (size_t)128 * 256) + j) = z; } }
    { const float* x = INP(IN_X); unsigned char* x8 = WSP(unsigned char, WS_X8); u64* rsq = WSP(u64, WS_RSQ);
      for (int m = gw; m < M; m += NGW) { const f32x4* xr = (const f32x4*)(x + (size_t)m * D) + lane; f32x4 v[8]; float s = 0.f;
#pragma unroll
          for (int j = 0; j < 8; ++j) { v[j] = xr[64 * j]; s += (v[j][0] * v[j][0] + v[j][1] * v[j][1]) + (v[j][2] * v[j][2] + v[j][3] * v[j][3]); }
          s = wave_sum(s); if (lane == 0) rsq[m] = (u64)(s * RSQ_SCALE + 0.5f);
          unsigned* o4 = (unsigned*)(x8 + (size_t)m * D) + lane;
#pragma unroll
          for (int j = 0; j < 8; ++j) o4[64 * j] = cvt4_fp8(v[j][0], v[j][1], v[j][2], v[j][3]); } }
    { float* cosT = WSP(float, WS_ROPE); float* sinT = cosT + T * 64; const int gt = gw * 64 + lane, NGT = NGW * 64;
      for (int i = gt; i < T * 64; i += NGT) { const int t = i >> 6, d = i & 63; const float inv = (float)exp(-9.210340371976184 * (double)d / 64.0); const float ang = (float)t * inv;
          cosT[i] = (float)cos((double)ang); sinT[i] = (float)sin((double)ang); } }
}

__device__ __forceinline__ void p_attn_a(Frame F, int layer) {
    launder(F);
    bf16_t* QKV = BGP(bf16_t, BG_QKV); const bf16_t* NGb = BGP(bf16_t, BG_NG);
#ifndef NO_CMP
    if (blockIdx.x < 16) {
        const int kv = blockIdx.x >> 3, pm = blockIdx.x & 7, q = layer * 2 + kv;
        bf16_t* H = BGP(bf16_t, BG_HC) + (size_t)kv * 2048 * 256;
        { pg8::SchedOne S{BGP(bf16_t, kv ? BG_VCB : BG_KCB), WSP(bf16_t, WS_W1 + q * SZ_W1), 2048 * 2, 4096 * 2, pm, 0};
          pg8::EpiCmp1 E{H, WSP(long long, WS_CBIAS) + q * 256};
          pg8::gemm_phase<false>(F.lds, 4096 * 2, S, E); }
        VM_WAIT(); __syncthreads(); __builtin_amdgcn_fence(__ATOMIC_ACQUIRE, "agent"); VM_WAIT(); __syncthreads();
        { pg8::SchedOne S{H, WSP(bf16_t, WS_W2 + q * SZ_W2), 256 * 2, 256 * 2, pm, 0};
          pg8::EpiCmp2 E{BGP(bf16_t, kv ? BG_VCMP : BG_KCMP)};
          pg8::gemm_phase<false>(F.lds, 256 * 2, S, E); }
        __syncthreads();
    }
#endif
    const att::Ctx c = att::make_ctx(F.lds);
    const float* sinks = INP(IN_SINK) + layer * 8;
    const int nstat = (int)F.G - 16; bool first = blockIdx.x >= 16;
    for (;;) {
        int u = first ? (int)blockIdx.x - 16 : nstat + queue_pop(F, layer * 2 + 0); first = false; if (u >= 1024 + 64) break;
        if (u < 64) {
            pg8::SchedOne S{WSP(unsigned char, WS_X8), WSP(unsigned char, WS_WIN + layer * SZ_WIN), D, D, u, 32};
            pg8::EpiIn E{BGP(bf16_t, BG_QKV), BGP(bf16_t, BG_KCB), BGP(bf16_t, BG_VCB), BGP(bf16_t, BG_GM), BGP(bf16_t, BG_NG), WSP(u64, WS_RSQ) + (2 * layer) * M, WSP(float, WS_ROPE), WSP(float, WS_ROPE) + T * 64, 1.0f / WIN8_SCALE, F.lds + LDS_WSCR};
            pg8::gemm_phase<true>(F.lds, D, S, E); __syncthreads(); continue; }
        u -= 64;
        const bool swa = u >= 512; const int v = u & 511, qt = 63 - (v >> 3), bg = v & 7, b = bg >> 1, g = bg & 1;
        const int t0 = qt * 64, h = 4 * g + (c.wid >> 1), trow = t0 + 32 * (c.wid & 1);
        const size_t rowbase = (size_t)b * T;
        const int qcol = (swa ? 0 : 1536) + h * HD, kcol = (swa ? 1024 : 3584) + g * HD, vcol = (swa ? 1280 : 3840) + g * HD, W = swa ? 128 : 512;
        bf16x8 qr[8]; att::load_q(qr, QKV + (rowbase + trow + c.r32) * 4096 + qcol, c.hi);
        const int j_lo = (t0 - W + 1) > 0 ? (t0 - W + 1) / 64 : 0, NT = qt - j_lo + 1;
        f32x16 o[4] = {}; float m_reg = -1e30f, l_reg = 0.f;
        if (c.wid >= 4) __builtin_amdgcn_s_setprio(1);
        att::attn_loop<0>(c, QKV + rowbase * 4096 + kcol, 4096, QKV + rowbase * 4096 + vcol, 4096, j_lo, NT, qr, trow + c.r32, trow, W, 0u, 0u, -1, o, m_reg, l_reg);
        if (c.wid >= 4) __builtin_amdgcn_s_setprio(0);
        float f;
        if (swa) { const float lt = l_reg + __builtin_amdgcn_exp2f(sinks[h] * att::LOG2E - m_reg * att::C2); f = 1.0f / lt; }
        else f = 1.0f / l_reg;
        if (swa) att::store_o<false, true>(o, f, c, nullptr, 1024, 1.0f, false, BGP(unsigned char, BG_OA) + (rowbase + trow) * 1024 + h * HD);
        else att::store_o<false>(o, f, c, BGP(bf16_t, BG_OB) + (rowbase + trow) * 1024 + h * HD, 1024);
    }
}

__device__ __forceinline__ void p_attn_b(Frame F, int layer) {
    launder(F);
    const bf16_t* QKV = BGP(bf16_t, BG_QKV); const bf16_t* NGb = BGP(bf16_t, BG_NG);
    const att::Ctx c = att::make_ctx(F.lds);
    LAS unsigned* IMP = (LAS unsigned*)(F.lds + LDS_IMP);
    volatile LAS unsigned* SELM = (volatile LAS unsigned*)(F.lds + LDS_SELM);
    bool first = true;
    for (;;) {
        const int u = first ? (int)blockIdx.x : (int)F.G + queue_pop(F, layer * 2 + 1); first = false; if (u >= 512) break;
        const int qt = 63 - (u >> 3), bg = u & 7, b = bg >> 1, g = bg & 1;
        const int t0 = qt * 64, h = 4 * g + (c.wid >> 1), trow = t0 + 32 * (c.wid & 1), tl = 32 * (c.wid & 1) + c.r32;
        const size_t rowbase = (size_t)b * T; const int pos = trow + c.r32;
        for (int i = c.tid; i < 64 * 65; i += NTHREADS) IMP[i] = 0u;
        bf16x8 qr[8]; att::load_q(qr, QKV + (rowbase + pos) * 4096 + 1536 + h * HD, c.hi);
        const int maxc = (t0 + 63 - 31) >> 4, NTc = (maxc >> 6) + 1;
        const bf16_t* Kc = BGP(bf16_t, BG_KCMP) + (size_t)bg * 256 * HD; const bf16_t* Vc = BGP(bf16_t, BG_VCMP) + (size_t)bg * 256 * HD;
        { const att::Dma dc = att::make_dma(c, HD, HD); for (int j = 0; j < NTc; ++j) att::dma_tile(c, dc, Kc, HD, Vc, HD, j * 64, j); }
        VM_WAIT(); __syncthreads();
        const int cpos = (pos - 31) >> 4;
        float m_reg = -1e30f, l_reg = 0.f;
        {
            f32x16 p0, p1; float alpha;
#pragma unroll 1
            for (int J = 0; J < NTc; ++J) { att::qkt(p0, p1, c.K_lds + J * att::TILE_B, c.r32, c.hi, qr); att::mask_tile(p0, p1, cpos - J * 64 - 4 * c.hi, 0x40000000u); att::softmax_step(p0, p1, m_reg, l_reg, alpha); }
        }
        f32x16 o[4] = {};
        {
            const float inv_l = l_reg > 0.f ? 1.0f / l_reg : 0.f, mnL = -m_reg * att::C2; f32x16 p0, p1; bf16x8 pa0, pa1, pa2, pa3;
#pragma unroll 1
            for (int J = 0; J < NTc; ++J) { att::qkt(p0, p1, c.K_lds + J * att::TILE_B, c.r32, c.hi, qr); att::mask_tile(p0, p1, cpos - J * 64 - 4 * c.hi, 0x40000000u);
#pragma unroll
                for (int r = 0; r < 16; ++r) { p0[r] = __builtin_amdgcn_exp2f(fmaf(p0[r], att::C2, mnL)) * inv_l; p1[r] = __builtin_amdgcn_exp2f(fmaf(p1[r], att::C2, mnL)) * inv_l; }
                LAS unsigned* irow = IMP + tl * 65 + J * 16 + c.hi; constexpr float IS = 67108864.0f;
#pragma unroll
                for (int jj = 0; jj < 4; ++jj) {
                    atomicAdd((unsigned*)(irow + 2 * jj), (unsigned)((p0[4 * jj] + p0[4 * jj + 1] + p0[4 * jj + 2] + 0.5f * p0[4 * jj + 3]) * IS + 0.5f)); atomicAdd((unsigned*)(irow + 2 * jj + 1), (unsigned)(0.5f * p0[4 * jj + 3] * IS + 0.5f));
                    atomicAdd((unsigned*)(irow + 2 * jj + 8), (unsigned)((p1[4 * jj] + p1[4 * jj + 1] + p1[4 * jj + 2] + 0.5f * p1[4 * jj + 3]) * IS + 0.5f)); atomicAdd((unsigned*)(irow + 2 * jj + 9), (unsigned)(0.5f * p1[4 * jj + 3] * IS + 0.5f)); }
                att::pack_p(p0, p1, pa0, pa1, pa2, pa3); att::pv_tile(o, c.vb0 + J * att::TILE_B, pa0, pa1, pa2, pa3); }
        }
        bf16_t* Og = BGP(bf16_t, BG_OB) + (rowbase + trow) * 1024 + h * HD;
        __syncthreads();
        { const float g0 = bf2f(NGb[(rowbase + pos) * 32 + h * 3 + 0]), g2 = bf2f(NGb[(rowbase + pos) * 32 + h * 3 + 2]); att::store_o<true>(o, g0, c, Og, 1024, g2, true); }
        for (int i = 0; i < 8; ++i) { const int tk = c.wid * 8 + i, s = c.lane; volatile LAS unsigned* row = (volatile LAS unsigned*)IMP + tk * 65;
            const unsigned raw = row[s]; const bool forced = (s == 0) | (s == qt) | (s == qt - 1), valid = s <= qt;
            unsigned key = ((((raw >> 6) + 1u) << 6) | (unsigned)(63 - s)); key = forced ? (0xFFFFFFC0u | (unsigned)(63 - s)) : key; key = valid ? key : 0u;
            row[s] = key; LDS_WAIT();
            int rank = 0;
#pragma unroll 16
            for (int j = 0; j < 64; ++j) rank += (row[j] > key) ? 1 : 0;
            const unsigned long long bal = __ballot(rank < 16 && key != 0u);
            if (c.lane == 0) { SELM[2 * tk] = (unsigned)bal; SELM[2 * tk + 1] = (unsigned)(bal >> 32); } }
        __syncthreads();
        const unsigned sel_lo = SELM[2 * tl], sel_hi = SELM[2 * tl + 1];
#pragma unroll
        for (int d = 0; d < 4; ++d) o[d] = f32x16{};
        m_reg = -1e30f; l_reg = 0.f;
if (c.wid >= 4) __builtin_amdgcn_s_setprio(1);
                att::attn_loop_simple<2>(c, QKV + rowbase * 4096 + 3072 + g * HD, 4096, QKV + rowbase * 4096 + 3328 + g * HD, 4096, 0, qt + 1, qr, pos, trow, 0, sel_lo, sel_hi, qt, o, m_reg, l_reg);
        if (c.wid >= 4) __builtin_amdgcn_s_setprio(0);
        { const float g1 = bf2f(NGb[(rowbase + pos) * 32 + h * 3 + 1]); VM_WAIT(); att::store_o<true, true>(o, g1 / l_reg, c, Og, 1024, 1.0f, false, BGP(unsigned char, BG_OA) + (size_t)M * 1024 + (rowbase + trow) * 1024 + h * HD); }
    }
}

__device__ __forceinline__ void p_router(Frame F) {
    launder(F);
    LAS float* wr = (LAS float*)F.lds;
    const float* rw = INP(IN_RW); const float* gain = INP(IN_FNORM) + D;
    for (int i = F.tid; i < D * 8; i += NTHREADS) wr[i] = rw[i] * gain[i >> 3];
    LAS int* te = (LAS int*)(F.lds + 65536); LAS float* tw = (LAS float*)(F.lds + 65536 + 1024);
    const bf16_t* XB = WSP(bf16_t, WS_XBF); const u64* rsq = WSP(u64, WS_RSQ) + 3 * M;
    int* ltok = WSP(int, WS_LTOK); float* lw = WSP(float, WS_LW); int* slot = WSP(int, WS_SLOT);
    for (int chunk = blockIdx.x; chunk < M / 64; chunk += F.G) {
        __syncthreads();
        for (int i = 0; i < 8; ++i) { const int tl = F.wave * 8 + i, tok = chunk * 64 + tl;
            const u32x2* xr = (const u32x2*)(XB + (size_t)tok * D) + F.lane; float a[8] = {0.f, 0.f, 0.f, 0.f, 0.f, 0.f, 0.f, 0.f};
#pragma unroll
            for (int j = 0; j < 8; ++j) { const u32x2 xw = xr[64 * j]; const f32x4 x = {bf_lo(xw.x), bf_hi(xw.x), bf_lo(xw.y), bf_hi(xw.y)}; const int k = 4 * (F.lane + 64 * j);
#pragma unroll
                for (int q = 0; q < 4; ++q) { const f32x4 w0 = *(const LAS f32x4*)(wr + (k + q) * 8), w1 = *(const LAS f32x4*)(wr + (k + q) * 8 + 4);
                    a[0] = fmaf(x[q], w0[0], a[0]); a[1] = fmaf(x[q], w0[1], a[1]); a[2] = fmaf(x[q], w0[2], a[2]); a[3] = fmaf(x[q], w0[3], a[3]);
                    a[4] = fmaf(x[q], w1[0], a[4]); a[5] = fmaf(x[q], w1[1], a[5]); a[6] = fmaf(x[q], w1[2], a[6]); a[7] = fmaf(x[q], w1[3], a[7]); } }
            const float rstd = rstd_of(rsq, tok);
#pragma unroll
            for (int e = 0; e < 8; ++e) a[e] = wave_sum(a[e]) * rstd;
            int e1 = 0; float l1 = a[0];
#pragma unroll
            for (int e = 1; e < 8; ++e) if (a[e] > l1) { l1 = a[e]; e1 = e; }
            int e2 = -1; float l2 = -3.0e38f;
#pragma unroll
            for (int e = 0; e < 8; ++e) if (e != e1 && a[e] > l2) { l2 = a[e]; e2 = e; }
            const float ex = __expf(l2 - l1), w1 = 1.0f / (1.0f + ex), w2 = ex * w1;
            if (F.lane == 0) { te[tl] = e1; te[64 + tl] = e2; tw[tl] = w1; tw[64 + tl] = w2; } }
        __syncthreads();
        if (F.wave == 0) { const int tl = F.lane, tok = chunk * 64 + tl, e1 = te[tl], e2 = te[64 + tl]; const float w1 = tw[tl], w2 = tw[64 + tl];
            const unsigned long long lt = (1ull << tl) - 1ull;
            int myn = 0;
#pragma unroll
            for (int e = 0; e < 8; ++e) { const int n = __popcll(__ballot(e1 == e)) + __popcll(__ballot(e2 == e)); if (tl == e) myn = n; }
            int mybase = 0; if (tl < 8 && myn > 0) mybase = (int)__hip_atomic_fetch_add(F.ctl + CW_ECNT + 64 * tl, (unsigned)myn, RLX_AGENT);
#pragma unroll
            for (int e = 0; e < 8; ++e) { const unsigned long long m1 = __ballot(e1 == e), m2 = __ballot(e2 == e); const int n1 = __popcll(m1);
                const int base = __shfl(mybase, e);
                if (e1 == e) { const int p = base + __popcll(m1 & lt); ltok[e * M + p] = tok; lw[e * M + p] = w1; slot[2 * tok] = (e << 20) | p; }
                if (e2 == e) { const int p = base + n1 + __popcll(m2 & lt); ltok[e * M + p] = tok; lw[e * M + p] = w2; slot[2 * tok + 1] = (e << 20) | p; } } }
    }
}
__device__ __forceinline__ void moe_counts(Frame& F) {
    __syncthreads();
    if (F.tid < 64) {
        int cnt = 0; if (F.tid < NE) cnt = (int)__hip_atomic_load(F.ctl + CW_ECNT + 64 * F.tid, RLX_AGENT);
        const int tiles = (cnt + 255) >> 8; int incl = tiles;
#pragma unroll
        for (int d = 1; d < 8; d <<= 1) { const int t = __shfl_up(incl, d); if (F.tid >= d) incl += t; }
        if (F.tid < NE) { F.misc[8 + F.tid] = (unsigned)cnt; F.misc[16 + F.tid] = (unsigned)(incl - tiles); }
        const int acc = __shfl(incl, NE - 1);
        if (F.tid == 0) { F.misc[24] = (unsigned)acc;
            int per_round = F.G / (D / 256); asm volatile("" : "+v"(per_round));
            const int tm = (acc / per_round) * per_round, tu = (acc - tm) * (D / 256);
            F.misc[25] = (unsigned)tm; F.misc[26] = (tu > 0 && tu * 4 <= F.G) ? 4u : ((tu > 0 && tu * 2 <= F.G) ? 2u : 1u); } }
    __syncthreads();
}
__device__ __forceinline__ void p_final(Frame F) {
    launder(F);
    moe_counts(F);
    const int gw = F.vcu * NWAVES + F.wave, NGW = F.G * NWAVES, lane = F.lane;
    const bf16_t* XB = WSP(bf16_t, WS_XBF); const bf16_t* YS = WSP(bf16_t, WS_YS); const int* slot = WSP(int, WS_SLOT); const float* gf = INP(IN_FINAL);
    const int Tm = (int)F.misc[25], S = (int)F.misc[26]; const bf16_t* YT = BGP(bf16_t, BG_YT);
    for (int m = gw; m < M; m += NGW) {
        const int s0 = slot[2 * m], s1 = slot[2 * m + 1];
        const size_t r0 = (size_t)F.misc[16 + (s0 >> 20)] * 256 + (s0 & 0xfffff), r1 = (size_t)F.misc[16 + (s1 >> 20)] * 256 + (s1 & 0xfffff);
        const u32x2* xr = (const u32x2*)(XB + (size_t)m * D) + lane;
        f32x4 v[8];
#pragma unroll
        for (int j = 0; j < 8; ++j) { const u32x2 a = xr[64 * j]; v[j] = f32x4{bf_lo(a.x), bf_hi(a.x), bf_lo(a.y), bf_hi(a.y)}; }
#pragma unroll
        for (int q = 0; q < 2; ++q) { const size_t r = q ? r1 : r0; const bool tail = (int)(r >> 8) >= Tm;
            const bf16_t* base = tail ? YT + (r - (size_t)Tm * 256) * D : YS + r * D; const int nrep = tail ? S : 1;
            for (int k = 0; k < nrep; ++k) { const u32x2* y = (const u32x2*)(base + (size_t)k * YT_ROWS * D) + lane;
#pragma unroll
                for (int j = 0; j < 8; ++j) { const u32x2 a = y[64 * j]; v[j][0] += bf_lo(a.x); v[j][1] += bf_hi(a.x); v[j][2] += bf_lo(a.y); v[j][3] += bf_hi(a.y); } } }
        float s = 0.f;
#pragma unroll
        for (int j = 0; j < 8; ++j) s += (v[j][0] * v[j][0] + v[j][1] * v[j][1]) + (v[j][2] * v[j][2] + v[j][3] * v[j][3]);
        const float rstd = rsqrtf(wave_sum(s) * (1.0f / D) + NORM_EPS);
        f32x4* o = (f32x4*)(F.out + (size_t)m * D) + lane; const f32x4* gp = (const f32x4*)gf + lane;
#pragma unroll
        for (int j = 0; j < 8; ++j) o[64 * j] = v[j] * rstd * gp[64 * j];
    }
}

#ifndef MK_SPLIT
#define MK_SPLIT 0
#endif
constexpr int NPHASE = 17;
struct Args { const float* in[22]; float* out; unsigned char* ws; int ph_lo, ph_hi, li, pad; };
__global__ void __launch_bounds__(NTHREADS, 2) mega_fwd(Args args) {
    extern __shared__ __attribute__((aligned(16))) unsigned char lds_raw[];
    Frame F0;
    F0.lds = (LAS unsigned char*)lds_raw; F0.misc = (volatile LAS unsigned*)(F0.lds + LDS_MISC);
    F0.tid = threadIdx.x; F0.lane = F0.tid & 63; F0.wave = __builtin_amdgcn_readfirstlane(F0.tid >> 6);
    F0.G = gridDim.x; { const int bx = blockIdx.x; F0.vcu = (F0.G % 8 == 0) ? (bx % 8) * (F0.G / 8) + bx / 8 : bx; }
    F0.in = args.in;
    F0.out = args.out; F0.ws = args.ws; F0.ctl = (unsigned*)(args.ws + WS_CTL);
    if (F0.tid < 64) F0.misc[F0.tid] = 0u;
    __syncthreads();
    XcdBarrier bar = xcd_barrier_post(F0.ctl + CW_BAR + args.li * XCD_BAR_WORDS, F0.misc);
    const int lo = args.ph_lo, hi = args.ph_hi;
#ifndef PHMASK
#define PHMASK 0x1ffff
#endif
#define IN(k) (((PHMASK >> ((k) > 7 && (k) < 13 ? (k) - 7 : (k))) & 1) && lo <= (k) && (k) < hi)
#define SEAM(k) do { if (IN(k) && IN((k) + 1)) { XcdBarrier b2 = bar; asm volatile("" : "+s"(b2.bar)); xcd_barrier(b2); } } while (0)

    if (IN(0)) p_prologue(F0);
    SEAM(0);
    for (int layer = 0; layer < 2; ++layer) {
        const int pb = 1 + 7 * layer;
        if (IN(pb)) { Frame F = F0; launder(F); u64* rsq = WSP(u64, WS_RSQ);
            pg8::SchedDense S{WSP(unsigned char, WS_X8), WSP(unsigned char, WS_WIN + layer * SZ_WIN), D, D, M / 256, 32, F.G, (int)blockIdx.x};
            pg8::EpiIn E{BGP(bf16_t, BG_QKV), BGP(bf16_t, BG_KCB), BGP(bf16_t, BG_VCB), BGP(bf16_t, BG_GM), BGP(bf16_t, BG_NG), rsq + (2 * layer) * M, WSP(float, WS_ROPE), WSP(float, WS_ROPE) + T * 64, 1.0f / WIN8_SCALE, F.lds + LDS_WSCR};
            pg8::gemm_phase<true>(F.lds, D, S, E);
        }
        SEAM(pb);
        if (IN(pb + 1)) p_attn_a(F0, layer);
        SEAM(pb + 1);
        if (IN(pb + 2)) p_attn_b(F0, layer);
        SEAM(pb + 2);
        if (IN(pb + 3)) { Frame F = F0; launder(F);
            pg8::SchedSeg2 S{BGP(unsigned char, BG_OA), WSP(unsigned char, WS_WUP + (2 * layer) * SZ_WUP), BGP(unsigned char, BG_OA) + (size_t)M * 1024, WSP(unsigned char, WS_WUP + (2 * layer + 1) * SZ_WUP), 1024, M / 256, D / 256, F.G, (int)blockIdx.x};
            pg8::EpiMerge E{BGP(bf16_t, BG_GM), BGP(unsigned char, BG_Z), Z8_SCALE / (O8_SCALE * WUP8_SCALE)};
            pg8::gemm_phase<true>(F.lds, 1024, S, E);
        }
        SEAM(pb + 3);
        if (IN(pb + 4)) { Frame F = F0; launder(F); u64* rsq = WSP(u64, WS_RSQ);
            pg8::SchedDense S{BGP(unsigned char, BG_Z), WSP(unsigned char, WS_WO + layer * SZ_WO), D, D, M / 256, D / 256, F.G, (int)blockIdx.x};
            pg8::EpiResid E{layer == 0 ? (const void*)INP(IN_X) : (const void*)WSP(bf16_t, WS_XBF), layer != 0, WSP(bf16_t, WS_XBF), rsq + (2 * layer + 1) * M, layer == 1 ? WSP(unsigned char, WS_X8) : nullptr, 1.0f / (Z8_SCALE * WO8_SCALE)};
            pg8::gemm_phase<true>(F.lds, D, S, E);
        }
        SEAM(pb + 4);
        if (layer == 0) {
            if (IN(pb + 5)) { Frame F = F0; launder(F); u64* rsq = WSP(u64, WS_RSQ);
                pg8::SchedDense S{WSP(bf16_t, WS_XBF), WSP(bf16_t, WS_WGUD), D * 2, D * 2, M / 256, 2 * FF / 256, F.G, (int)blockIdx.x};
                pg8::EpiGateUp<false, true, false> E{BGP(bf16_t, 0), rsq + 1 * M, nullptr, F.misc};
                pg8::gemm_phase<false>(F.lds, D * 2, S, E);
            }
            SEAM(pb + 5);
            if (IN(pb + 6)) { Frame F = F0; launder(F); u64* rsq = WSP(u64, WS_RSQ);
                pg8::SchedDense S{BGP(unsigned char, 0), WSP(unsigned char, WS_WDD), FF, FF, M / 256, D / 256, F.G, (int)blockIdx.x};
                pg8::EpiResid E{WSP(bf16_t, WS_XBF), 1, WSP(bf16_t, WS_XBF), rsq + 2 * M, WSP(unsigned char, WS_X8), 1.0f / WD8_SCALE};
                pg8::gemm_phase<true>(F.lds, FF, S, E);
            }
            SEAM(pb + 6);
        } else {
            if (IN(pb + 5)) p_router(F0);
            SEAM(pb + 5);
            if (IN(pb + 6)) { Frame F = F0; launder(F); u64* rsq = WSP(u64, WS_RSQ);
                moe_counts(F);
                pg8::SchedMoE<true> S{WSP(unsigned char, WS_X8), WSP(unsigned char, WS_WGUM), WSP(int, WS_LTOK), D, D, 2 * FF / 256, F.G, (int)blockIdx.x, SZ_WGU8, F.misc, 24};
                pg8::EpiGateUp<true> E{BGP(bf16_t, 0), rsq + 3 * M, WSP(int, WS_LTOK), F.misc};
                pg8::gemm_phase<true>(F.lds, D, S, E);
            }
            SEAM(pb + 6);
            if (IN(pb + 7)) { Frame F = F0; launder(F);
                moe_counts(F);
                pg8::SchedMoE<false> S{BGP(unsigned char, 0), WSP(unsigned char, WS_WDM), nullptr, FF, FF, D / 256, F.G, (int)blockIdx.x, SZ_WD8, F.misc, 25};
                pg8::EpiMoeDown E{WSP(bf16_t, WS_YS), WSP(float, WS_LW), F.misc};
                pg8::gemm_phase<true>(F.lds, FF, S, E);
                { const int kpart = FF / (int)F.misc[26];
                  pg8::SchedMoETail St{BGP(unsigned char, 0), WSP(unsigned char, WS_WDM), FF, FF, D / 256, (int)blockIdx.x, kpart, SZ_WD8, F.misc};
                  pg8::EpiMoeDownTail Et{BGP(bf16_t, BG_YT), WSP(float, WS_LW), F.misc};
                  pg8::gemm_phase<true>(F.lds, kpart, St, Et); }
            }
            SEAM(pb + 7);
        }
    }
    if (IN(16)) p_final(F0);
#undef IN
#undef SEAM
}

extern "C" void kernel_launch(void* const* d_in, const int* in_sizes, int n_in, void* d_out, int out_size, void* d_ws, size_t ws_size, hipStream_t stream) {
    static int grid = 0;
    if (grid == 0) {
        if (n_in != 22 || in_sizes[0] != M * D || out_size != M * D || ws_size < WS_END) { fprintf(stderr, "kernel_launch: unexpected shapes (n_in %d, in0 %d, out %d, ws %zu < %zu); nothing launched\n", n_in, n_in > 0 ? in_sizes[0] : -1, out_size, ws_size, (size_t)WS_END); grid = -1; return; }
        int dev = 0, cus = 0, per_cu = 0;
        if (hipGetDevice(&dev) != hipSuccess || hipDeviceGetAttribute(&cus, hipDeviceAttributeMultiprocessorCount, dev) != hipSuccess) { grid = -1; return; }
        if (hipFuncSetAttribute((const void*)mega_fwd, hipFuncAttributeMaxDynamicSharedMemorySize, LDS_BYTES) != hipSuccess) { fprintf(stderr, "kernel_launch: hipFuncSetAttribute failed\n"); grid = -1; return; }
        if (hipOccupancyMaxActiveBlocksPerMultiprocessor(&per_cu, (const void*)mega_fwd, NTHREADS, LDS_BYTES) != hipSuccess || per_cu < 1) fprintf(stderr, "kernel_launch: occupancy query reports %d\n", per_cu);
        (void)hipGetLastError();
        grid = cus;
    }
    if (grid < 0) return;
    (void)hipMemsetAsync((char*)d_ws + WS_CTL, 0, CTL_ZERO_BYTES, stream);
    Args a{};
    for (int i = 0; i < 22; ++i) a.in[i] = (const float*)d_in[i];
    a.out = (float*)d_out; a.ws = (unsigned char*)d_ws; a.pad = 0;
#if MK_SPLIT
    for (int p = 0; p < NPHASE; ++p) { a.ph_lo = p; a.ph_hi = p + 1; a.li = p; hipLaunchKernelGGL(mega_fwd, dim3(grid), dim3(NTHREADS), LDS_BYTES, stream, a); }
#else
    a.ph_lo = 0; a.ph_hi = NPHASE; a.li = 0;
    hipLaunchKernelGGL(mega_fwd, dim3(grid), dim3(NTHREADS), LDS_BYTES, stream, a);
#endif
}
```
